# Optimizing an MI355X kernel written in HIP

```python
import math
import jax, jax.numpy as jnp
from jax import lax
import numpy as np

D_MODEL = 4096
BATCH = 4
SEQ = 4096
DEPTH = 1

GRID_W = 64
CTX_LEN = 256
HEAD_DIM = 128
HEADS_A = D_MODEL // 256
KV_HEADS_A = HEADS_A // 4
GROUPS_A = HEADS_A // KV_HEADS_A
HEADS_B = D_MODEL // 256
WA_Q = HEADS_A * HEAD_DIM
WA_KV = KV_HEADS_A * HEAD_DIM
WB = HEADS_B * HEAD_DIM
N_IN = WA_Q + 2 * WA_KV + 3 * WB + 2 * D_MODEL
WIN_H = 8
WIN_W = 16
Q_BLOCK = 128
D_FF = ((8 * D_MODEL // 3 + 127) // 128) * 128
CONV_W = 3
ROPE_THETA = 10000.0
EPS = 1e-6

kernel_name = "hybrid_gqa_natten_convffn_block"


def rmsnorm(x, g):
    x32 = x.astype(jnp.float32)
    y = x32 * lax.rsqrt(jnp.mean(x32 * x32, axis=-1, keepdims=True) + EPS)
    return (y * g.astype(jnp.float32)).astype(x.dtype)


def rope_1d(x, pos):
    r = x.shape[-1] // 2
    freqs = ROPE_THETA ** (-jnp.arange(r, dtype=jnp.float32) / r)
    ang = pos[:, None] * freqs[None, :]
    cos = jnp.cos(ang)[None, :, None, :]
    sin = jnp.sin(ang)[None, :, None, :]
    x32 = x.astype(jnp.float32)
    x1, x2 = x32[..., :r], x32[..., r:]
    return jnp.concatenate([x1 * cos - x2 * sin, x2 * cos + x1 * sin], axis=-1).astype(x.dtype)


def rope_2d(x, row, col):
    h = x.shape[-1] // 2
    return jnp.concatenate([rope_1d(x[..., :h], row), rope_1d(x[..., h:], col)], axis=-1)


def in_proj(h, w_in):
    p = h @ w_in
    cuts = [WA_Q, WA_Q + WA_KV, WA_Q + 2 * WA_KV, WA_Q + 2 * WA_KV + WB,
            WA_Q + 2 * WA_KV + 2 * WB, WA_Q + 2 * WA_KV + 3 * WB,
            WA_Q + 2 * WA_KV + 3 * WB + D_MODEL]
    qa, ka, va, qb, kb, vb, ga, gb = jnp.split(p, cuts, axis=-1)
    B_, N_ = h.shape[:2]
    qa = qa.reshape(B_, N_, HEADS_A, HEAD_DIM)
    ka = ka.reshape(B_, N_, KV_HEADS_A, HEAD_DIM)
    va = va.reshape(B_, N_, KV_HEADS_A, HEAD_DIM)
    qb = qb.reshape(B_, N_, HEADS_B, HEAD_DIM)
    kb = kb.reshape(B_, N_, HEADS_B, HEAD_DIM)
    vb = vb.reshape(B_, N_, HEADS_B, HEAD_DIM)
    return qa, ka, va, qb, kb, vb, ga, gb


def ctx_attention(q, k, v):
    B_, L, H, hd = q.shape
    kvh = k.shape[2]
    qg = q.reshape(B_, L, kvh, H // kvh, hd)
    s = jnp.einsum('bqkgd,bskd->bkgqs', qg, k).astype(jnp.float32) * (hd ** -0.5)
    p = jax.nn.softmax(s, axis=-1).astype(v.dtype)
    o = jnp.einsum('bkgqs,bskd->bqkgd', p, v)
    return o.reshape(B_, L, H * hd)


def gqa_latent(q, k, v, k_ctx, v_ctx):
    B_, S_, H, hd = q.shape
    k_all = jnp.concatenate([k_ctx, k], axis=1)
    v_all = jnp.concatenate([v_ctx, v], axis=1)
    nblk = S_ // Q_BLOCK
    qb = q.reshape(B_, nblk, Q_BLOCK, KV_HEADS_A, GROUPS_A, hd).transpose(1, 0, 2, 3, 4, 5)

    def one_block(qblk):
        s = jnp.einsum('bqkgd,bskd->bkgqs', qblk, k_all).astype(jnp.float32) * (hd ** -0.5)
        p = jax.nn.softmax(s, axis=-1).astype(v_all.dtype)
        return jnp.einsum('bkgqs,bskd->bqkgd', p, v_all)

    o = lax.map(one_block, qb)
    return o.transpose(1, 0, 2, 3, 4, 5).reshape(B_, S_, H * hd)


def neighbourhood_latent(q, k, v, k_ctx, v_ctx, rpb):
    B_, S_, H, hd = q.shape
    rows = S_ // GRID_W
    kh = min(WIN_H, rows)
    kw = WIN_W
    qg = q.reshape(B_, rows, GRID_W, H, hd)
    kg = k.reshape(B_, rows, GRID_W, H, hd)
    vg = v.reshape(B_, rows, GRID_W, H, hd)
    col = jnp.arange(GRID_W)
    cs = jnp.clip(col - kw // 2, 0, GRID_W - kw)
    col_mask = (col[None, :] >= cs[:, None]) & (col[None, :] < cs[:, None] + kw)
    dc_idx = col[None, :] - col[:, None] + (WIN_W - 1)
    dc_idx = jnp.clip(dc_idx, 0, 2 * WIN_W - 2)
    scale = hd ** -0.5

    def one_row(args):
        r, q_row = args
        rs = jnp.clip(r - kh // 2, 0, rows - kh)
        k_rows = lax.dynamic_slice_in_dim(kg, rs, kh, axis=1)
        v_rows = lax.dynamic_slice_in_dim(vg, rs, kh, axis=1)
        dr_idx = rs + jnp.arange(kh) - r + (WIN_H - 1)
        bias = rpb[:, dr_idx][:, :, dc_idx].transpose(0, 2, 1, 3)
        s_loc = jnp.einsum('bqhd,bjkhd->bhqjk', q_row, k_rows).astype(jnp.float32) * scale
        s_loc = s_loc + bias[None].astype(jnp.float32)
        s_loc = jnp.where(col_mask[None, None, :, None, :], s_loc, -jnp.inf)
        s_loc = s_loc.reshape(B_, H, GRID_W, kh * GRID_W)
        s_ctx = jnp.einsum('bqhd,blhd->bhql', q_row, k_ctx).astype(jnp.float32) * scale
        p = jax.nn.softmax(jnp.concatenate([s_ctx, s_loc], axis=-1), axis=-1).astype(v.dtype)
        L = k_ctx.shape[1]
        o = jnp.einsum('bhql,blhd->bqhd', p[..., :L], v_ctx)
        o = o + jnp.einsum('bhqn,bnhd->bqhd', p[..., L:], v_rows.reshape(B_, kh * GRID_W, H, hd))
        return o

    o = lax.map(one_row, (jnp.arange(rows), qg.transpose(1, 0, 2, 3, 4)))
    return o.transpose(1, 0, 2, 3, 4).reshape(B_, S_, H * hd)


def merge_branches(o_a, o_b, g_a, g_b, w_br_a, w_br_b, w_out):
    y = jax.nn.sigmoid(g_a) * (o_a @ w_br_a) + jax.nn.sigmoid(g_b) * (o_b @ w_br_b)
    return y @ w_out


def conv_ffn(h, w_up, conv_w, conv_b, w_down):
    u = h @ w_up
    up = jnp.pad(u, ((0, 0), (1, 1), (0, 0)))
    u = up[:, :-2] * conv_w[0] + up[:, 1:-1] * conv_w[1] + up[:, 2:] * conv_w[2] + conv_b
    gate, val = jnp.split(u, 2, axis=-1)
    return (jax.nn.silu(gate) * val) @ w_down


def head_rms(x, g):
    return rmsnorm(x, g)


def setup_inputs(seed: int = 0) -> dict:
    key = jax.random.key(seed)
    ks = jax.random.split(key, 24)
    f32 = jnp.float32

    def nrm(k, shape, s):
        return jax.random.normal(k, shape, f32) * s

    return {
        "x": nrm(ks[0], (BATCH, SEQ, D_MODEL), 1.0),
        "c": nrm(ks[1], (BATCH, D_MODEL), 1.0),
        "ctx": nrm(ks[2], (BATCH, CTX_LEN, D_MODEL), 1.0),
        "c_ctx": nrm(ks[3], (D_MODEL,), 1.0),
        "ada_w": nrm(ks[4], (DEPTH, D_MODEL, 6 * D_MODEL), 0.5 * D_MODEL ** -0.5),
        "ada_b": nrm(ks[5], (DEPTH, 6 * D_MODEL), 0.01),
        "norm1_g": 1.0 + nrm(ks[6], (DEPTH, D_MODEL), 0.02),
        "w_in": nrm(ks[7], (DEPTH, D_MODEL, N_IN), D_MODEL ** -0.5),
        "qnorm_a": 1.0 + nrm(ks[8], (DEPTH, HEAD_DIM), 0.02),
        "knorm_a": 1.0 + nrm(ks[9], (DEPTH, HEAD_DIM), 0.02),
        "rpb_b": nrm(ks[10], (DEPTH, HEADS_B, 2 * WIN_H - 1, 2 * WIN_W - 1), 0.1),
        "w_br_a": nrm(ks[11], (DEPTH, WA_Q, D_MODEL), WA_Q ** -0.5),
        "w_br_b": nrm(ks[12], (DEPTH, WB, D_MODEL), WB ** -0.5),
        "w_out": nrm(ks[13], (DEPTH, D_MODEL, D_MODEL), D_MODEL ** -0.5),
        "norm2_g": 1.0 + nrm(ks[14], (DEPTH, D_MODEL), 0.02),
        "w_up": nrm(ks[15], (DEPTH, D_MODEL, 2 * D_FF), D_MODEL ** -0.5),
        "conv_w": nrm(ks[16], (DEPTH, CONV_W, 2 * D_FF), CONV_W ** -0.5),
        "conv_b": nrm(ks[17], (DEPTH, 2 * D_FF), 0.01),
        "w_down": nrm(ks[18], (DEPTH, D_FF, D_MODEL), D_FF ** -0.5),
        "final_g": 1.0 + nrm(ks[19], (D_MODEL,), 0.02),
    }


def reference(x, c, ctx, c_ctx, ada_w, ada_b, norm1_g, w_in, qnorm_a, knorm_a, rpb_b,
              w_br_a, w_br_b, w_out, norm2_g, w_up, conv_w, conv_b, w_down, final_g):
    B_, S_, _ = x.shape
    t = jnp.arange(S_)
    row = (t // GRID_W).astype(jnp.float32)
    col = (t % GRID_W).astype(jnp.float32)

    for layer in range(DEPTH):
        mod = jax.nn.silu(c) @ ada_w[layer] + ada_b[layer]
        sh1, sc1, g1, sh2, sc2, g2 = jnp.split(mod[:, None, :], 6, axis=-1)
        mod_c = jax.nn.silu(c_ctx) @ ada_w[layer] + ada_b[layer]
        csh1, csc1, cg1, csh2, csc2, cg2 = jnp.split(mod_c, 6, axis=-1)

        hc = rmsnorm(ctx, norm1_g[layer]) * (1 + csc1) + csh1
        qa_c, ka_c, va_c, qb_c, kb_c, vb_c, ga_c, gb_c = in_proj(hc, w_in[layer])
        ka_c = head_rms(ka_c, knorm_a[layer])

        h = rmsnorm(x, norm1_g[layer]) * (1 + sc1) + sh1
        qa, ka, va, qb, kb, vb, ga, gb = in_proj(h, w_in[layer])
        qa = rope_2d(head_rms(qa, qnorm_a[layer]), row, col)
        ka = rope_2d(head_rms(ka, knorm_a[layer]), row, col)
        o_a = gqa_latent(qa, ka, va, ka_c, va_c)
        o_b = neighbourhood_latent(qb, kb, vb, kb_c, vb_c, rpb_b[layer])
        x = x + g1 * merge_branches(o_a, o_b, ga, gb, w_br_a[layer], w_br_b[layer], w_out[layer])
        h2 = rmsnorm(x, norm2_g[layer]) * (1 + sc2) + sh2
        x = x + g2 * conv_ffn(h2, w_up[layer], conv_w[layer], conv_b[layer], w_down[layer])

        if layer < DEPTH - 1:
            qa_c = head_rms(qa_c, qnorm_a[layer])
            oa_c = ctx_attention(qa_c, ka_c, va_c)
            ob_c = ctx_attention(qb_c, kb_c, vb_c)
            ctx = ctx + cg1 * merge_branches(oa_c, ob_c, ga_c, gb_c, w_br_a[layer], w_br_b[layer], w_out[layer])
            hc2 = rmsnorm(ctx, norm2_g[layer]) * (1 + csc2) + csh2
            ctx = ctx + cg2 * conv_ffn(hc2, w_up[layer], conv_w[layer], conv_b[layer], w_down[layer])

    return rmsnorm(x, final_g)
```

```cpp
#define DEFER_UP_RUNS 768
#include <hip/hip_runtime.h>
#include <cstdio>
#include <cstdint>
namespace pg8 {
#define PG8_LAS __attribute__((address_space(3)))
typedef unsigned short bf16_t;
typedef short bf16x8 __attribute__((ext_vector_type(8)));
typedef float f32x4 __attribute__((ext_vector_type(4)));
typedef unsigned u32x4 __attribute__((ext_vector_type(4)));
typedef int i32x8 __attribute__((ext_vector_type(8)));
typedef short s16x16 __attribute__((ext_vector_type(16)));
template <bool FP8> struct Frag { bf16x8 h[2]; };
template <> struct Frag<true> { s16x16 v; };
__device__ __forceinline__ void fset(Frag<false>& f, int k, bf16x8 x) { f.h[k] = x; }
__device__ __forceinline__ void fset(Frag<true>& f, int k, bf16x8 x) { if (k == 0) f.v.lo = x; else f.v.hi = x; }
__device__ __forceinline__ f32x4 fmma(const Frag<false>& b, const Frag<false>& a, f32x4 c) { c = __builtin_amdgcn_mfma_f32_16x16x32_bf16(b.h[0], a.h[0], c, 0, 0, 0); return __builtin_amdgcn_mfma_f32_16x16x32_bf16(b.h[1], a.h[1], c, 0, 0, 0); }
typedef int i32x4 __attribute__((ext_vector_type(4)));
__device__ __forceinline__ f32x4 fmma_i8(const Frag<false>& b, const Frag<false>& a, f32x4 c) {
    i32x4 ci = __builtin_bit_cast(i32x4, c);
    ci = __builtin_amdgcn_mfma_i32_16x16x64_i8(__builtin_bit_cast(i32x4, b.h[0]), __builtin_bit_cast(i32x4, a.h[0]), ci, 0, 0, 0);
    ci = __builtin_amdgcn_mfma_i32_16x16x64_i8(__builtin_bit_cast(i32x4, b.h[1]), __builtin_bit_cast(i32x4, a.h[1]), ci, 0, 0, 0);
    return __builtin_bit_cast(f32x4, ci); }
__device__ __forceinline__ f32x4 fmma(const Frag<true>& b, const Frag<true>& a, f32x4 c) { const int one = 0x7F7F7F7F;
    asm volatile("v_mfma_scale_f32_16x16x128_f8f6f4 %0, %1, %2, %0, %3, %3 op_sel_hi:[0,0,0]" : "+v"(c) : "v"(__builtin_bit_cast(i32x8, b.v)), "v"(__builtin_bit_cast(i32x8, a.v)), "v"(one)); return c; }
constexpr int BM = 256, BK = 64, HALF = 128, HTB = HALF * BK * 2  , STAGE_BYTES = 8 * HTB, NXCD = 8, WGM = 8;

__host__ __device__ __forceinline__ int lds_byte(int r, int c) { const int st = (r >> 4) * 2 + (c >> 5), rr = r & 15, cc = c & 31, ob = rr * 64 + cc * 2; return st * 1024 + (ob ^ (((ob >> 9) & 1) << 5)); }
__host__ __device__ __forceinline__ void stage_rc(int b, int& R, int& C) { const int st = b / 1024, sb = b % 1024, swz = sb ^ (((sb >> 9) & 1) << 5); R = (st >> 1) * 16 + swz / 64; C = (st & 1) * 32 + (swz % 64) / 2; }
__host__ __device__ __forceinline__ int perm32(int rho) { const int n = rho >> 4, i = rho & 15; return 8 * (i >> 2) + 4 * n + (i & 3); }

struct Unit { int pm, pn; };
struct Gemm { const bf16_t* A; const bf16_t* Bt; int M, N, K, lda, ldb; unsigned ksA, ksB; size_t tsA, tsB; };
__host__ __device__ __forceinline__ Gemm gemm_rowmajor(const bf16_t* A, const bf16_t* Bt, int M, int N, int K, int lda, int ldb) { return Gemm{A, Bt, M, N, K, lda, ldb, 128u, 128u, (size_t)512 * lda, (size_t)512 * ldb}; }

struct StaticOrder {
    int nM, nN, nwg, G, c, wgm;
    __host__ __device__ void init(int M, int N, int G_, int c_, int wgm_ = WGM) { nM = M / BM; nN = N / BM; nwg = nM * nN; G = G_; c = c_; wgm = wgm_; }
    __host__ __device__ bool next(int i, Unit& u) const {
        const long L = (long)i * G + c; if (L >= nwg) return false;
        int wgid = (int)L; { const int q = nwg / NXCD, r = nwg % NXCD, xcd = wgid % NXCD, off = wgid / NXCD; wgid = (xcd < r ? xcd * (q + 1) : r * (q + 1) + (xcd - r) * q) + off; }
        const int nig = wgm * nN, gid = wgid / nig, fm = gid * wgm, gsz = (nM - fm) < wgm ? (nM - fm) : wgm;
        u.pm = fm + ((wgid % nig) % gsz); u.pn = (wgid % nig) / gsz; return true;
    }
    __device__ __forceinline__ void a_ready(const Unit&) const {}
    __device__ __forceinline__ void done(const Unit&) const {}
};

template <class Epi, class Sched, bool ALIGN_EPI = false, bool SP2 = false, int MODE = 0  >
__device__ __forceinline__ void gemm_phase(PG8_LAS unsigned char* lds, const Gemm g, const Sched& S, const Epi& E) {
    int tid_o = threadIdx.x; asm volatile("" : "+v"(tid_o));
    const int tid = tid_o, wid = __builtin_amdgcn_readfirstlane(tid >> 6), lane = tid & 63, wr = wid >> 2, wc = wid & 3, fr = lane & 15, fq = lane >> 4;
    const int K = g.K, nt = K / BK;
    unsigned voffA[2], voffB[2];
#pragma unroll
    for (int i = 0; i < 2; ++i) { int R, C; stage_rc(tid * 16 + i * 8192, R, C); const int Rb = Epi::PERM ? ((R & ~31) + perm32(R & 31)) : R;
        voffA[i] = (unsigned)(R * g.lda + C) * 2u; voffB[i] = (unsigned)(Rb * g.ldb + C) * 2u; }
    const size_t kstepA = g.ksA, kstepB = g.ksB;
    const size_t hstepA = (size_t)HALF * g.lda * 2, hstepB = (size_t)HALF * g.ldb * 2;
    const size_t tstepA = g.tsA, tstepB = g.tsB;
    const unsigned ldsw = (unsigned)wid * 1024u;
    const int aoff = lds_byte(wr * 64 + fr, fq * 8), boff = lds_byte(wc * 32 + fr, fq * 8);
#define PG8_SA(b, h) (((b) * 2 + (h)) * HTB)
#define PG8_SB(b, h) ((4 + (b) * 2 + (h)) * HTB)
#define PG8_STAGE(bufoff, gbase, voff) do { _Pragma("unroll") for (int _i = 0; _i < 2; ++_i) \
        __builtin_amdgcn_global_load_lds((const unsigned*)((const char*)(gbase) + (voff)[_i]), (PG8_LAS unsigned*)(lds + (bufoff) + ldsw + _i * 8192), 16, 0, 0); } while (0)
#define PG8_LDA(dst, b, h) do { _Pragma("unroll") for (int m = 0; m < 4; ++m) _Pragma("unroll") for (int k = 0; k < 2; ++k) fset(dst[m], k, *(const PG8_LAS bf16x8*)(lds + PG8_SA(b, h) + aoff + m * 2048 + k * 1024)); } while (0)
#define PG8_LDB(dst, b, h) do { _Pragma("unroll") for (int n = 0; n < 2; ++n) _Pragma("unroll") for (int k = 0; k < 2; ++k) fset(dst[n], k, *(const PG8_LAS bf16x8*)(lds + PG8_SB(b, h) + boff + n * 2048 + k * 1024)); } while (0)
#define PG8_MMA(ai, bj, At, Bt) do { __builtin_amdgcn_s_setprio(1); _Pragma("unroll") for (int m = 0; m < 4; ++m) _Pragma("unroll") for (int n = 0; n < 2; ++n) { if constexpr (MODE == 2) acc[ai][bj][m][n] = fmma_i8(Bt[n], At[m], acc[ai][bj][m][n]); else acc[ai][bj][m][n] = fmma(Bt[n], At[m], acc[ai][bj][m][n]); } __builtin_amdgcn_s_setprio(0); } while (0)
#define PG8_WAIT_V(n) asm volatile("s_waitcnt vmcnt(" #n ")" ::: "memory")
#define PG8_WAIT_L(n) asm volatile("s_waitcnt lgkmcnt(" #n ")" ::: "memory")
#define PG8_BAR __builtin_amdgcn_s_barrier()
#define PG8_SCHED __builtin_amdgcn_sched_barrier(0)
    Unit cur, nxt; int ui = 0;
    if (!S.next(0, cur)) return;
    f32x4 acc[2][2][4][2];
#pragma unroll
    for (int a = 0; a < 2; ++a)
#pragma unroll
        for (int b = 0; b < 2; ++b)
#pragma unroll
            for (int m = 0; m < 4; ++m)
#pragma unroll
                for (int n = 0; n < 2; ++n) acc[a][b][m][n] = (f32x4){0.f, 0.f, 0.f, 0.f};
    constexpr bool FP8 = (MODE == 1);
    Frag<FP8> At[4], B0[2], B1[2];
    const char* cA = (const char*)g.A + (size_t)cur.pm * tstepA; const char* cB = (const char*)g.Bt + (size_t)cur.pn * tstepB;
    S.a_ready(cur);
    if constexpr (SP2) {
        PG8_STAGE(PG8_SB(0, 0), cB, voffB); PG8_STAGE(PG8_SB(0, 1), cB + hstepB, voffB); PG8_STAGE(PG8_SA(0, 0), cA, voffA); PG8_STAGE(PG8_SA(0, 1), cA + hstepA, voffA);
        if (wr == 1) PG8_BAR;
        PG8_WAIT_V(2); PG8_BAR;
        PG8_STAGE(PG8_SB(1, 0), cB + kstepB, voffB); PG8_STAGE(PG8_SA(1, 0), cA + kstepA, voffA); PG8_STAGE(PG8_SB(1, 1), cB + hstepB + kstepB, voffB);
        PG8_WAIT_V(6); PG8_BAR;
    } else {
        PG8_STAGE(PG8_SB(0, 0), cB, voffB); PG8_STAGE(PG8_SA(0, 0), cA, voffA); PG8_STAGE(PG8_SB(0, 1), cB + hstepB, voffB); PG8_STAGE(PG8_SA(0, 1), cA + hstepA, voffA);
        if (wr == 1) PG8_BAR;
        PG8_WAIT_V(4); PG8_BAR;
        PG8_STAGE(PG8_SB(1, 0), cB + kstepB, voffB); PG8_STAGE(PG8_SA(1, 0), cA + kstepA, voffA); PG8_STAGE(PG8_SB(1, 1), cB + hstepB + kstepB, voffB);
        PG8_WAIT_V(6); PG8_BAR;
    }
    for (;;) {
        const bool has_next = S.next(ui + 1, nxt);
        const char* nA = has_next ? (const char*)g.A + (size_t)nxt.pm * tstepA : cA; const char* nB = has_next ? (const char*)g.Bt + (size_t)nxt.pn * tstepB : cB;
        constexpr int NPASS = Epi::MIDK ? 2 : 1;
#pragma unroll
        for (int hp = 0; hp < NPASS; ++hp) {
        const int t_lo = hp == 0 ? 0 : (nt >> 1), t_hi = (NPASS == 2 && hp == 0) ? (nt >> 1) : nt;
        if constexpr (Epi::MIDK) { if (hp == 1) { if constexpr (FP8) asm volatile("s_nop 15\n\ts_nop 15" ::: "memory"); E.mid(acc, cur, wr, wc, fr, fq); } }
        for (int t = t_lo; t < t_hi; t += 2) {
            const bool last = (t == nt - 2);
            const char* a1 = cA + (size_t)(t + 1) * kstepA;
            const char* a2 = last ? nA : cA + (size_t)(t + 2) * kstepA; const char* b2 = last ? nB : cB + (size_t)(t + 2) * kstepB;
            const char* a3 = a2 + kstepA; const char* b3 = b2 + kstepB;
            if (last && has_next) S.a_ready(nxt);
            if constexpr (SP2) {
            PG8_LDB(B0, 0, 0); PG8_LDB(B1, 0, 1); PG8_SCHED; PG8_LDA(At, 0, 0); PG8_STAGE(PG8_SA(1, 1), a1 + hstepA, voffA);
            PG8_WAIT_V(8); PG8_WAIT_L(0); PG8_BAR; PG8_MMA(0, 0, At, B0); PG8_MMA(0, 1, At, B1); PG8_BAR; PG8_SCHED;
            PG8_LDA(At, 0, 1); PG8_STAGE(PG8_SB(0, 0), b2, voffB); PG8_STAGE(PG8_SB(0, 1), b2 + hstepB, voffB); PG8_STAGE(PG8_SA(0, 0), a2, voffA);
            PG8_WAIT_V(8); PG8_WAIT_L(0); PG8_BAR; PG8_MMA(1, 0, At, B0); PG8_MMA(1, 1, At, B1); PG8_BAR; PG8_SCHED;
            PG8_LDB(B0, 1, 0); PG8_LDB(B1, 1, 1); PG8_SCHED; PG8_LDA(At, 1, 0); PG8_STAGE(PG8_SA(0, 1), a2 + hstepA, voffA);
            PG8_WAIT_V(8); PG8_WAIT_L(0); PG8_BAR; PG8_MMA(0, 0, At, B0); PG8_MMA(0, 1, At, B1); PG8_BAR; PG8_SCHED;
            PG8_LDA(At, 1, 1); PG8_STAGE(PG8_SB(1, 0), b3, voffB); PG8_STAGE(PG8_SB(1, 1), b3 + hstepB, voffB); PG8_STAGE(PG8_SA(1, 0), a3, voffA);
            PG8_WAIT_V(8); PG8_WAIT_L(0); PG8_BAR; PG8_MMA(1, 0, At, B0); PG8_MMA(1, 1, At, B1); PG8_BAR; PG8_SCHED;
            } else {
            PG8_LDB(B0, 0, 0); PG8_SCHED; PG8_LDA(At, 0, 0); PG8_STAGE(PG8_SA(1, 1), a1 + hstepA, voffA);
            PG8_WAIT_L(8); PG8_BAR; PG8_WAIT_L(0); PG8_MMA(0, 0, At, B0); PG8_BAR; PG8_SCHED;
            PG8_LDB(B1, 0, 1); PG8_STAGE(PG8_SB(0, 0), b2, voffB);
            PG8_BAR; PG8_WAIT_L(0); PG8_MMA(0, 1, At, B1); PG8_BAR;
            PG8_LDA(At, 0, 1); PG8_STAGE(PG8_SA(0, 0), a2, voffA);
            PG8_BAR; PG8_WAIT_L(0); PG8_MMA(1, 0, At, B0); PG8_BAR; PG8_SCHED;
            PG8_STAGE(PG8_SB(0, 1), b2 + hstepB, voffB);
            PG8_WAIT_V(6); PG8_BAR; PG8_MMA(1, 1, At, B1); PG8_BAR;
            PG8_LDB(B0, 1, 0); PG8_SCHED; PG8_LDA(At, 1, 0); PG8_STAGE(PG8_SA(0, 1), a2 + hstepA, voffA);
            PG8_WAIT_L(8); PG8_BAR; PG8_WAIT_L(0); PG8_MMA(0, 0, At, B0); PG8_BAR; PG8_SCHED;
            PG8_LDB(B1, 1, 1); PG8_STAGE(PG8_SB(1, 0), b3, voffB);
            PG8_BAR; PG8_WAIT_L(0); PG8_MMA(0, 1, At, B1); PG8_BAR;
            PG8_LDA(At, 1, 1); PG8_STAGE(PG8_SA(1, 0), a3, voffA);
            PG8_BAR; PG8_WAIT_L(0); PG8_MMA(1, 0, At, B0); PG8_BAR; PG8_SCHED;
            PG8_STAGE(PG8_SB(1, 1), b3 + hstepB, voffB);
            PG8_WAIT_V(6); PG8_BAR; PG8_MMA(1, 1, At, B1); PG8_BAR;
            }
        }
        }
        if constexpr (ALIGN_EPI) { if (wr == 0) PG8_BAR; }
        if constexpr (FP8) asm volatile("s_nop 15\n\ts_nop 15" ::: "memory");
        if constexpr (!Epi::AFTER_DRAIN) { E(acc, cur, wr, wc, fr, fq); S.done(cur); }
        if (!has_next) break;
#pragma unroll
        for (int a = 0; a < 2; ++a)
#pragma unroll
            for (int b = 0; b < 2; ++b)
#pragma unroll
                for (int m = 0; m < 4; ++m)
#pragma unroll
                    for (int n = 0; n < 2; ++n) acc[a][b][m][n] = (f32x4){0.f, 0.f, 0.f, 0.f};
        cur = nxt; cA = nA; cB = nB; ++ui;
        if constexpr (ALIGN_EPI) { if (wr == 1) PG8_BAR; }
    }
    PG8_WAIT_V(0);
    if constexpr (!ALIGN_EPI) { if (wr == 0) PG8_BAR; }
    PG8_BAR;
    if constexpr (Epi::AFTER_DRAIN) { E.fused(acc, cur, wr, wc, fr, fq, lds, wid, lane); S.done(cur); }
#undef PG8_SA
#undef PG8_SB
#undef PG8_STAGE
#undef PG8_LDA
#undef PG8_LDB
#undef PG8_MMA
#undef PG8_WAIT_V
#undef PG8_WAIT_L
#undef PG8_BAR
#undef PG8_SCHED
}
}

constexpr int D = 4096, NB = 4, S = 4096, L = 256, HD = 128, HA = 16, KVA = 4, HB = 16, GQ = HA / KVA;
constexpr int NIN = 17408, DFF = 11008, F2 = 2 * DFF, GW = 64, KT = L + S;
constexpr int M = NB * S, MC = NB * L;
constexpr int MODN = 6 * D, MOD_SPLIT = 8, MOD_KC = D / MOD_SPLIT;
constexpr float EPS = 1e-6f;
constexpr float SCALE = 0.088388347648318440f;
constexpr int NT_IN = NIN / 256;
constexpr float SC_WIN = 64.f, SC_WOUT = 64.f, SC_Y = 16.f;
#ifndef INPROJ_MODE_DEF
#define INPROJ_MODE_DEF 2
#endif
constexpr int INPROJ_MODE = INPROJ_MODE_DEF;
#ifndef TILED_B
#define TILED_B 1
#endif
#ifndef QFIX_ATT_DEF
#define QFIX_ATT_DEF 1
#endif
constexpr bool QFIX_ATT = QFIX_ATT_DEF;
#ifndef BR_FP8_DEF
#define BR_FP8_DEF 1
#endif
constexpr bool BR_FP8 = BR_FP8_DEF;
constexpr float SC_OA = 32.f, SC_OB = 16.f, SC_WBR = 32.f;
#ifndef WOUT_MODE_DEF
#define WOUT_MODE_DEF 2
#endif
constexpr int WOUT_MODE = WOUT_MODE_DEF;
constexpr bool WOUT_FP8 = (WOUT_MODE == 1);
constexpr bool V_FP8 = true;
constexpr int NT_IN16 = V_FP8 ? 0 : 10, NT_IN8 = V_FP8 ? 68 : 58;
__host__ __device__ constexpr bool inproj_is_fp8(int pn) { return V_FP8 || !(pn == 10 || pn == 11 || (pn >= 28 && pn < 36)); }
__host__ __device__ constexpr int inproj_local_tile(int pn) { return V_FP8 ? pn : (inproj_is_fp8(pn) ? (pn < 10 ? pn : (pn < 28 ? pn - 2 : pn - 10)) : (pn < 12 ? pn - 10 : pn - 26)); }
__host__ __device__ constexpr int inproj_global_tile(bool fp8, int t) { return V_FP8 ? t : (fp8 ? (t < 10 ? t : (t < 26 ? t + 2 : t + 10)) : (t < 2 ? 10 + t : 26 + t)); }
constexpr size_t WIN8_OFF = (size_t)NT_IN16 * 256 * D * 2;

constexpr size_t MiB = 1u << 20;
constexpr size_t WS_CTL = 0, CTL_ZERO_BYTES = 1 * MiB;
constexpr size_t WS_MODP = 1 * MiB;
constexpr size_t WS_MODF = 5 * MiB;
constexpr size_t WS_ROPE = 6 * MiB;
constexpr size_t WS_RSH = 7 * MiB;
constexpr size_t WS_RSY = 7 * MiB + 256 * 1024;
constexpr size_t WS_WUP = 8 * MiB;
constexpr size_t WS_WDN = 180 * MiB;
constexpr size_t WS_QO = 266 * MiB;
constexpr size_t WS_WIN = 394 * MiB;
constexpr size_t WS_WBR = 530 * MiB;
constexpr size_t WS_WOUT = 562 * MiB;
constexpr size_t WS_H = 594 * MiB;
constexpr size_t WS_KA = 730 * MiB;
constexpr size_t WS_VA = 747 * MiB;
constexpr size_t WS_KB = 764 * MiB;
constexpr size_t WS_VB = 832 * MiB;
constexpr size_t WS_GA = 900 * MiB;
constexpr size_t WS_GB = 1028 * MiB;
constexpr size_t WS_U = 394 * MiB;
constexpr size_t WS_ACT = 1156 * MiB;
constexpr size_t WS_END = 1500 * MiB;
static_assert(WS_U + (size_t)M * F2 * 2 <= WS_ACT && WS_GB + (size_t)M * D * 2 <= WS_ACT && WS_ACT + (size_t)M * DFF * 2 <= WS_END, "d_ws map");
static_assert(WS_WUP + (size_t)F2 * D * 2 <= WS_WDN && WS_WDN + (size_t)D * DFF * 2 <= WS_QO && WS_QO + (size_t)M * 4096 * 2 <= WS_WIN && WS_WIN + (size_t)NIN * D * 2 <= WS_WBR, "d_ws map 2");
static_assert(WS_H + (size_t)(M + MC) * D * 2 <= WS_KA && WS_KA + (size_t)NB * KT * 512 * 2 <= WS_VA && WS_VA + (size_t)NB * KT * 512 * 2 <= WS_KB && WS_KB + (size_t)NB * KT * 2048 * 2 <= WS_VB && WS_VB + (size_t)NB * KT * 2048 * 2 <= WS_GA, "d_ws map 3");
constexpr int CW_BAR = 4096;
constexpr int CW_QUEUE = 8192;
constexpr int CW_QUEUE3 = 8448, CW_QUEUE4 = 8512;
constexpr int CW_QUEUE2 = 8256, CW_WMAX = 8320, CW_WMAX2 = 8384;

constexpr int RING_OFF = 0, RING_BYTES = 131072;
constexpr int LDSCTL_OFF = RING_BYTES, MISC_OFF = LDSCTL_OFF + 320;
constexpr int LDS_BYTES = 147456;
constexpr int NWAVES = 8;

#ifndef MK_N_LAUNCHES
#define MK_N_LAUNCHES 1
#endif
constexpr int N_PHASES = 13;
constexpr int N_LAUNCHES = MK_N_LAUNCHES;

#define GAS __attribute__((address_space(1)))
#define LAS __attribute__((address_space(3)))
typedef unsigned short bf16;
typedef unsigned v4u __attribute__((ext_vector_type(4)));
typedef unsigned v2u __attribute__((ext_vector_type(2)));
typedef float f32x4 __attribute__((ext_vector_type(4)));
typedef float f32x2 __attribute__((ext_vector_type(2)));
typedef GAS unsigned gu32;
#define RLX_AGENT __ATOMIC_RELAXED, __HIP_MEMORY_SCOPE_AGENT
#define LDS_WAIT() asm volatile("s_waitcnt lgkmcnt(0)" ::: "memory")
#define VM_WAIT() asm volatile("s_waitcnt vmcnt(0)" ::: "memory")
__device__ __forceinline__ unsigned pk2(float lo, float hi) { unsigned r; asm volatile("v_cvt_pk_bf16_f32 %0, %1, %2" : "=v"(r) : "v"(lo), "v"(hi)); return r; }
__device__ __forceinline__ unsigned pk4_fp8(float a, float b, float c, float d) { int w = 0; w = __builtin_amdgcn_cvt_pk_fp8_f32(a, b, w, false); w = __builtin_amdgcn_cvt_pk_fp8_f32(c, d, w, true); return (unsigned)w; }
__device__ __forceinline__ unsigned pk4_i8(float a, float b, float c, float d) {
    const int q0 = __float2int_rn(a), q1 = __float2int_rn(b), q2 = __float2int_rn(c), q3 = __float2int_rn(d);
    return (unsigned)(q0 & 255) | ((unsigned)(q1 & 255) << 8) | ((unsigned)(q2 & 255) << 16) | ((unsigned)q3 << 24); }
__device__ __forceinline__ float bf_lo(unsigned w) { return __uint_as_float(w << 16); }
__device__ __forceinline__ float bf_hi(unsigned w) { return __uint_as_float(w & 0xffff0000u); }
__device__ __forceinline__ float sigmoid_f(float x) { return __builtin_amdgcn_rcpf(1.0f + __expf(-x)); }
__device__ __forceinline__ float wave_sum(float v) {
#pragma unroll
    for (int o = 1; o < 64; o <<= 1) v += __shfl_xor(v, o);
    return v;
}

#define XB_TMO      128
#define XB_XCNT(j)  (256  + 64 * (j))
#define XB_XSUB(j)  (1280 + 64 * (j))
#define XB_XGEN(j)  (2304 + 64 * (j))
#define XB_TOP      3328
#define XB_TOPGEN   3392
#define XCD_BAR_WORDS 3456
#define XB_SPIN_CAP (1u << 18)
__device__ __forceinline__ unsigned xb_ld(unsigned* p)              { return __hip_atomic_load(p, __ATOMIC_RELAXED, __HIP_MEMORY_SCOPE_AGENT); }
__device__ __forceinline__ unsigned xb_add(unsigned* p, unsigned v) { return __hip_atomic_fetch_add(p, v, __ATOMIC_RELAXED, __HIP_MEMORY_SCOPE_AGENT); }
__device__ __forceinline__ unsigned xb_xcc_id() { return (unsigned)__builtin_amdgcn_s_getreg((3 << 11) | 20) & 0xFu; }
#define XB_SPIN(cond, bar) do { unsigned _sp = 0; while (cond) { __builtin_amdgcn_s_sleep(1); \
    if ((++_sp & 255u) == 0u) { if (xb_ld(&(bar)[XB_TMO])) break; if (_sp > XB_SPIN_CAP) { atomicAdd(&(bar)[XB_TMO], 1u); break; } } } } while (0)
struct XcdBarrier { unsigned* bar; unsigned x; volatile LAS unsigned* st; };
__device__ __forceinline__ XcdBarrier xcd_barrier_post(unsigned* bar, volatile LAS unsigned* st) {
    XcdBarrier b; b.bar = bar; b.x = xb_xcc_id(); b.st = st;
    if (threadIdx.x == 0) (void)xb_add(&bar[XB_XCNT(b.x)], 1u);
    return b;
}
__device__ __forceinline__ void xcd_barrier_complete(unsigned* bar, unsigned x, unsigned& nloc, unsigned& nx) {
    const unsigned G = gridDim.x * gridDim.y * gridDim.z;
    unsigned sum, cnt, mine, sp = 0u;
    for (;;) {
        sum = 0u; cnt = 0u; mine = 0u;
#pragma unroll
        for (unsigned j = 0; j < 16; ++j) { const unsigned c = xb_ld(&bar[XB_XCNT(j)]); sum += c; cnt += (c > 0u) ? 1u : 0u; mine = (j == x) ? c : mine; }
        if (sum == G) break;
        __builtin_amdgcn_s_sleep(1);
        if ((++sp & 255u) == 0u) { if (xb_ld(&bar[XB_TMO])) break; if (sp > XB_SPIN_CAP) { atomicAdd(&bar[XB_TMO], 1u); break; } }
    }
    nloc = mine > 0u ? mine : 1u; nx = cnt > 0u ? cnt : 1u;
}
__device__ __forceinline__ void xcd_barrier(const XcdBarrier& b) {
    asm volatile("s_waitcnt vmcnt(0)" ::: "memory");
    __syncthreads();
    if (threadIdx.x == 0) {
        unsigned* bar = b.bar;
        __builtin_amdgcn_s_waitcnt(0);
        unsigned nloc = b.st[0], nx = b.st[1];
        if (nloc == 0u) { xcd_barrier_complete(bar, b.x, nloc, nx); b.st[0] = nloc; b.st[1] = nx; }
        const unsigned old = xb_add(&bar[XB_XSUB(b.x)], 1u);
        const unsigned gen = old / nloc;
        if (old + 1u == (gen + 1u) * nloc) {
            __builtin_amdgcn_fence(__ATOMIC_RELEASE, "agent");
            asm volatile("s_waitcnt vmcnt(0)" ::: "memory");
            const unsigned og = xb_add(&bar[XB_TOP], 1u);
            const unsigned tg = og / nx;
            if (og + 1u == (tg + 1u) * nx) xb_add(&bar[XB_TOPGEN], 1u);
            else XB_SPIN(xb_ld(&bar[XB_TOPGEN]) == tg, bar);
            __builtin_amdgcn_fence(__ATOMIC_ACQUIRE, "agent");
            xb_add(&bar[XB_XGEN(b.x)], 1u);
            asm volatile("s_waitcnt vmcnt(0)" ::: "memory");
        } else {
            XB_SPIN(xb_ld(&bar[XB_XGEN(b.x)]) == gen, bar);
            __builtin_amdgcn_fence(__ATOMIC_ACQUIRE, "agent");
            asm volatile("s_waitcnt vmcnt(0)" ::: "memory");
        }
    }
    __syncthreads();
}

struct Args { const float* in[20]; float* out; unsigned char* ws; int ph_lo, ph_hi, li, pad; };
__device__ __forceinline__ const float* karg_in(int i) { return *(const float* const volatile __attribute__((address_space(4)))*)((const __attribute__((address_space(4))) char*)__builtin_amdgcn_kernarg_segment_ptr() + 8 * i); }
__device__ __forceinline__ unsigned char* karg_ws() { return (unsigned char*)karg_in(21); }
struct Frame {
    LAS unsigned char* lds;
    volatile LAS unsigned* MISC;
    gu32* ctl;
    int tid, lane, wave;
    int vcu, G;
#define KIN(name, i) __device__ __forceinline__ const float* name() const { return karg_in(i); }
    KIN(x, 0) KIN(c, 1) KIN(ctx, 2) KIN(cctx, 3) KIN(ada_w, 4) KIN(ada_b, 5) KIN(norm1_g, 6) KIN(w_in, 7) KIN(qnorm, 8) KIN(knorm, 9) KIN(rpb, 10) KIN(w_br_a, 11) KIN(w_br_b, 12) KIN(w_out, 13)
    KIN(norm2_g, 14) KIN(w_up, 15) KIN(conv_w, 16) KIN(conv_b, 17) KIN(w_down, 18) KIN(final_g, 19)
#undef KIN
    __device__ __forceinline__ float* out() const { return (float*)karg_in(20); }
#define KWS(T, name, off) __device__ __forceinline__ T* name() const { return (T*)(karg_ws() + (off)); }
    KWS(float, modp, WS_MODP) KWS(float, modf, WS_MODF) KWS(float2, rope, WS_ROPE) KWS(float, rsh, WS_RSH) KWS(float, rsy, WS_RSY)
    KWS(bf16, Wup, WS_WUP) KWS(bf16, Wdn, WS_WDN) KWS(bf16, QO, WS_QO) KWS(bf16, Win, WS_WIN) KWS(bf16, Wbr, WS_WBR) KWS(bf16, Wout, WS_WOUT) KWS(bf16, H, WS_H)
    KWS(bf16, KA, WS_KA) KWS(bf16, VA, WS_VA) KWS(bf16, KB, WS_KB) KWS(bf16, VB, WS_VB) KWS(bf16, GA, WS_GA) KWS(bf16, GB, WS_GB) KWS(bf16, U, WS_U) KWS(bf16, ACT, WS_ACT)
#undef KWS
};

__device__ __forceinline__ void p0_mod_item(Frame& F, LAS float* sv, int item) {
    const int kc = item / (MODN / 256), nb = item % (MODN / 256), k0 = kc * MOD_KC;
    const float* cc = F.c(); const float* cx = F.cctx();
    for (int i = F.lane; i < 5 * MOD_KC; i += 64) { const int r = i / MOD_KC, k = i % MOD_KC; const float v = (r < 4) ? cc[r * D + k0 + k] : cx[k0 + k]; sv[i] = v * sigmoid_f(v); }
    LDS_WAIT(); asm volatile("" ::: "memory");
    f32x4 a0 = {0.f, 0.f, 0.f, 0.f}, a1 = a0, a2 = a0, a3 = a0, a4 = a0;
    const GAS f32x4* wp = (const GAS f32x4*)(F.ada_w() + (size_t)k0 * MODN + 256 * nb) + F.lane;
#pragma unroll 16
    for (int k = 0; k < MOD_KC; ++k) { const f32x4 w = wp[(size_t)k * (MODN / 4)];
        a0 += sv[k] * w; a1 += sv[MOD_KC + k] * w; a2 += sv[2 * MOD_KC + k] * w; a3 += sv[3 * MOD_KC + k] * w; a4 += sv[4 * MOD_KC + k] * w; }
    GAS f32x4* o = (GAS f32x4*)(F.modp() + (size_t)kc * 5 * MODN + 256 * nb) + F.lane;
    o[0] = a0; o[MODN / 4] = a1; o[2 * (MODN / 4)] = a2; o[3 * (MODN / 4)] = a3; o[4 * (MODN / 4)] = a4;
    LDS_WAIT(); asm volatile("" ::: "memory");
}
struct TItem { const float* src; unsigned char* dst; int N, ldT, fp8; float scale; };
constexpr int P0_NBW = 8, P0_KBL = 16;
constexpr int P0_BLK_IN = (D / 64 / P0_KBL) * (NIN / 32 / P0_NBW), P0_BLK_BR = (2048 / 64 / P0_KBL) * (D / 32 / P0_NBW), P0_BLK_OUT = (D / 64 / P0_KBL) * (D / 32 / P0_NBW), P0_BLK_UP = (D / 64 / P0_KBL) * (F2 / 32 / P0_NBW), P0_BLK_DN = ((DFF / 64 + P0_KBL - 1) / P0_KBL) * (D / 32 / P0_NBW);
static_assert((NIN / 32) % P0_NBW == 0 && (F2 / 32) % P0_NBW == 0 && (D / 32) % P0_NBW == 0 && (2048 / 64) % P0_KBL == 0, "P0 block shape");
constexpr int P0_NBLK = P0_BLK_IN + 2 * P0_BLK_BR + P0_BLK_OUT + P0_BLK_UP + P0_BLK_DN;
struct TRun { int mat, kb0, nb; };
__device__ __forceinline__ void p0_run_of(int blk, int slot, TRun& r) {
    int nbg_per;
    if (blk < P0_BLK_IN) { r.mat = 0; nbg_per = NIN / 32 / P0_NBW; }
    else if ((blk -= P0_BLK_IN) < P0_BLK_BR) { r.mat = 1; nbg_per = D / 32 / P0_NBW; }
    else if ((blk -= P0_BLK_BR) < P0_BLK_BR) { r.mat = 2; nbg_per = D / 32 / P0_NBW; }
    else if ((blk -= P0_BLK_BR) < P0_BLK_OUT) { r.mat = 3; nbg_per = D / 32 / P0_NBW; }
    else if ((blk -= P0_BLK_OUT) < P0_BLK_UP) { r.mat = 4; nbg_per = F2 / 32 / P0_NBW; }
    else { blk -= P0_BLK_UP; r.mat = 5; nbg_per = D / 32 / P0_NBW; }
    r.kb0 = (blk / nbg_per) * P0_KBL; r.nb = (blk % nbg_per) * P0_NBW + slot;
}
__device__ __forceinline__ bool p0_decode(Frame& F, int mat, int kb, int nb, TItem& t, float win_qscale, float wout_qscale) {
    t.fp8 = 0; t.scale = 1.0f;
    if (mat == 0) { const int pn = nb >> 3, nbd = inproj_local_tile(pn) * 8 + (nb & 7);
        t.src = F.w_in() + (size_t)(64 * kb) * NIN + 32 * nb; t.N = NIN;
        if (inproj_is_fp8(pn)) { t.dst = (unsigned char*)F.Win() + WIN8_OFF + (size_t)(32 * nbd) * D + 64 * kb; t.ldT = D; t.fp8 = INPROJ_MODE; t.scale = INPROJ_MODE == 2 ? win_qscale : SC_WIN; }
        else { t.dst = (unsigned char*)F.Win() + ((size_t)(32 * nbd) * D + 64 * kb) * 2; t.ldT = 2 * D; }
        return true; }
    if (mat == 1 || mat == 2) { const int second = mat - 1;
        t.src = (second ? F.w_br_b() : F.w_br_a()) + (size_t)(64 * kb) * D + 32 * nb; t.N = D;
        if (BR_FP8) { t.dst = (unsigned char*)F.Wbr() + (size_t)(32 * nb) * 4096 + second * 2048 + 64 * kb; t.ldT = 4096; t.fp8 = 1; t.scale = SC_WBR; }
        else { t.dst = (unsigned char*)F.Wbr() + ((size_t)(32 * nb) * 4096 + second * 2048 + 64 * kb) * 2; t.ldT = 2 * 4096; }
        return true; }
    if (mat == 3) { t.src = F.w_out() + (size_t)(64 * kb) * D + 32 * nb; t.N = D;
        if (WOUT_MODE) { t.dst = (unsigned char*)F.Wout() + (size_t)(32 * nb) * D + 64 * kb; t.ldT = D; t.fp8 = WOUT_MODE; t.scale = WOUT_MODE == 2 ? wout_qscale : SC_WOUT; }
        else { t.dst = (unsigned char*)F.Wout() + ((size_t)(32 * nb) * D + 64 * kb) * 2; t.ldT = 2 * D; }
        return true; }
    if (mat == 4) { const int fb = nb < DFF / 32 ? nb : nb - DFF / 32, nbd = (fb >> 2) * 8 + (nb < DFF / 32 ? 0 : 4) + (fb & 3);
        t.src = F.w_up() + (size_t)(64 * kb) * F2 + 32 * nb; t.N = F2; t.dst = (unsigned char*)F.Wup() + ((size_t)(32 * nbd) * D + 64 * kb) * 2; t.ldT = 2 * D; return true; }
    if (kb >= DFF / 64) return false;
    t.src = F.w_down() + (size_t)(64 * kb) * D + 32 * nb; t.N = D; t.dst = (unsigned char*)F.Wdn() + ((size_t)(32 * nb) * DFF + 64 * kb) * 2; t.ldT = 2 * DFF; return true;
}
__device__ __forceinline__ void p0_load(const TItem& t, float (&v)[32], int lane) {
    const float* p = t.src + (size_t)(lane >> 5) * t.N + (lane & 31);
#pragma unroll
    for (int i = 0; i < 32; ++i) v[i] = p[(size_t)(2 * i) * t.N];
}
__device__ __forceinline__ void p0a_prologue(Frame& F) {
    LAS float* scr = (LAS float*)(F.lds + RING_OFF + F.wave * 16384);
    { const int gt = F.vcu * (NWAVES * 64) + F.tid; if (gt < 64 * 32) { const int pos = gt >> 5, i = gt & 31; const float fr = powf(10000.0f, -(float)i / 32.0f), a = (float)pos * fr; F.rope()[gt] = make_float2(cosf(a), sinf(a)); } }
    if (F.wave < 3) { const int item = F.wave * F.G + F.vcu; if (item < MOD_SPLIT * (MODN / 256)) p0_mod_item(F, scr, item); }
    if (INPROJ_MODE == 2 || WOUT_MODE == 2) {
        constexpr int NCH1 = INPROJ_MODE == 2 ? (int)((size_t)D * NIN / 16384) : 0, NCH2 = WOUT_MODE == 2 ? (int)((size_t)D * D / 16384) : 0;
        const GAS f32x4* w1 = (const GAS f32x4*)F.w_in(); const GAS f32x4* w2 = (const GAS f32x4*)F.w_out(); float m1 = 0.f, m2 = 0.f;
        for (;;) {
            int ch = 0; if (F.lane == 0) ch = (int)__hip_atomic_fetch_add((unsigned*)(F.ctl + CW_QUEUE2), 1u, RLX_AGENT);
            ch = __builtin_amdgcn_readfirstlane(ch);
            if (ch >= NCH1 + NCH2) break;
            const bool second = ch >= NCH1; const GAS f32x4* p = (second ? w2 + (size_t)(ch - NCH1) * 4096 : w1 + (size_t)ch * 4096) + F.lane; f32x4 v[8]; float m = 0.f;
#pragma unroll
            for (int h = 0; h < 8; ++h) {
#pragma unroll
                for (int i = 0; i < 8; ++i) v[i] = p[(h * 8 + i) * 64];
#pragma unroll
                for (int i = 0; i < 8; ++i) m = fmaxf(m, fmaxf(fmaxf(fabsf(v[i].x), fabsf(v[i].y)), fmaxf(fabsf(v[i].z), fabsf(v[i].w)))); }
            if (second) m2 = fmaxf(m2, m); else m1 = fmaxf(m1, m);
        }
#pragma unroll
        for (int o = 1; o < 64; o <<= 1) { m1 = fmaxf(m1, __shfl_xor(m1, o)); m2 = fmaxf(m2, __shfl_xor(m2, o)); }
        if (F.lane == 0) { if (NCH1) __hip_atomic_fetch_max((unsigned*)(F.ctl + CW_WMAX), __float_as_uint(m1), RLX_AGENT);
                           if (NCH2) __hip_atomic_fetch_max((unsigned*)(F.ctl + CW_WMAX2), __float_as_uint(m2), RLX_AGENT); }
    }
}
#ifndef DEFER_UP_RUNS
#define DEFER_UP_RUNS 1024
#endif
constexpr int P0_RUN_UP0 = (P0_BLK_IN + 2 * P0_BLK_BR + P0_BLK_OUT) * P0_NBW, P0_RUN_DN0 = P0_RUN_UP0 + P0_BLK_UP * P0_NBW, P0_RUN_END = P0_NBLK * P0_NBW, P0_RUN_SPLIT = P0_RUN_DN0 - DEFER_UP_RUNS;
static_assert(DEFER_UP_RUNS >= 0 && DEFER_UP_RUNS <= P0_BLK_UP * P0_NBW, "deferred w_up runs");
__device__ __forceinline__ void p0_transpose_runs(Frame& F, int qw, int run_lo, int run_hi) {
    LAS float* scr = (LAS float*)(F.lds + RING_OFF + F.wave * 16384);
    const float win_qscale = INPROJ_MODE == 2 ? 127.0f / fmaxf(__uint_as_float(__hip_atomic_load((unsigned*)(F.ctl + CW_WMAX), RLX_AGENT)), 1e-30f) : 1.0f;
    const float wout_qscale = WOUT_MODE == 2 ? 127.0f / fmaxf(__uint_as_float(__hip_atomic_load((unsigned*)(F.ctl + CW_WMAX2), RLX_AGENT)), 1e-30f) : 1.0f;
    int lane = F.lane; asm volatile("" : "+v"(lane));
    const int c = lane & 7;
    for (;;) {
        int run = 0; if (lane == 0) run = (int)__hip_atomic_fetch_add((unsigned*)(F.ctl + qw), 1u, RLX_AGENT);
        run = run_lo + __builtin_amdgcn_readfirstlane(run);
        if (run >= run_hi) break;
        TRun R; p0_run_of(run / P0_NBW, run % P0_NBW, R);
        TItem cur, nxt; float v[32];
        bool have = p0_decode(F, R.mat, R.kb0, R.nb, cur, win_qscale, wout_qscale); if (have) p0_load(cur, v, lane);
        for (int j = 0; j < P0_KBL; ++j) {
            if (have) {
#pragma unroll
                for (int i = 0; i < 32; ++i) scr[(2 * i + (lane >> 5)) * 33 + (lane & 31)] = v[i] * cur.scale;
                LDS_WAIT(); asm volatile("" ::: "memory"); }
            nxt = cur; const bool more = (j + 1 < P0_KBL) && p0_decode(F, R.mat, R.kb0 + j + 1, R.nb, nxt, win_qscale, wout_qscale);
            if (more) p0_load(nxt, v, lane);
            if (have) {
#pragma unroll
                for (int q = 0; q < 4; ++q) { const int n = (lane >> 3) + 8 * q; const LAS float* sp = scr + (8 * c) * 33 + n;
                    if (cur.fp8 == 2) { v2u o; o.x = pk4_i8(sp[0 * 33], sp[1 * 33], sp[2 * 33], sp[3 * 33]); o.y = pk4_i8(sp[4 * 33], sp[5 * 33], sp[6 * 33], sp[7 * 33]); *(GAS v2u*)(cur.dst + (size_t)n * cur.ldT + 8 * c) = o; }
                    else if (cur.fp8) { v2u o; o.x = pk4_fp8(sp[0 * 33], sp[1 * 33], sp[2 * 33], sp[3 * 33]); o.y = pk4_fp8(sp[4 * 33], sp[5 * 33], sp[6 * 33], sp[7 * 33]); *(GAS v2u*)(cur.dst + (size_t)n * cur.ldT + 8 * c) = o; }
                    else { v4u o; o.x = pk2(sp[0 * 33], sp[1 * 33]); o.y = pk2(sp[2 * 33], sp[3 * 33]); o.z = pk2(sp[4 * 33], sp[5 * 33]); o.w = pk2(sp[6 * 33], sp[7 * 33]); *(GAS v4u*)(cur.dst + (size_t)n * cur.ldT + 16 * c) = o; } }
                LDS_WAIT(); asm volatile("" ::: "memory"); }
            cur = nxt; have = more;
        }
    }
}

template <int OUT_MODE  , bool HAS_B>
__device__ __forceinline__ void norm_row(const float* xrow, void* orow, const LAS float* A, const LAS float* B, int lane, void* orow8 = nullptr, float* rs = nullptr) {
    const GAS f32x4* xr = (const GAS f32x4*)xrow + lane;
    f32x4 v[16]; float s = 0.f;
#pragma unroll
    for (int j = 0; j < 16; ++j) { v[j] = xr[64 * j]; s += (v[j].x * v[j].x + v[j].y * v[j].y) + (v[j].z * v[j].z + v[j].w * v[j].w); }
    const float rstd = 1.0f / sqrtf(wave_sum(s) * (1.0f / D) + EPS);
#pragma unroll
    for (int j = 0; j < 16; ++j) {
        const f32x4 a = ((const LAS f32x4*)A)[lane + 64 * j]; f32x4 o = v[j] * rstd * a;
        if (HAS_B) o += ((const LAS f32x4*)B)[lane + 64 * j];
        if (OUT_MODE == 4) { v[j] = o; continue; }
        if (OUT_MODE == 1 || OUT_MODE == 3) { v2u w; w.x = pk2(o.x, o.y); w.y = pk2(o.z, o.w); ((GAS v2u*)orow)[lane + 64 * j] = w; if (OUT_MODE == 3) ((GAS unsigned*)orow8)[lane + 64 * j] = pk4_fp8(o.x, o.y, o.z, o.w); }
        else if (OUT_MODE == 2) ((GAS unsigned*)orow)[lane + 64 * j] = pk4_fp8(o.x, o.y, o.z, o.w);
        else ((GAS f32x4*)orow)[lane + 64 * j] = o;
    }
    if (OUT_MODE == 4) {
        float m = 0.f;
#pragma unroll
        for (int j = 0; j < 16; ++j) m = fmaxf(m, fmaxf(fmaxf(fabsf(v[j].x), fabsf(v[j].y)), fmaxf(fabsf(v[j].z), fabsf(v[j].w))));
#pragma unroll
        for (int o = 1; o < 64; o <<= 1) m = fmaxf(m, __shfl_xor(m, o));
        const float inv = m > 0.f ? 127.0f / m : 0.f;
#pragma unroll
        for (int j = 0; j < 16; ++j) ((GAS unsigned*)orow)[lane + 64 * j] = pk4_i8(v[j].x * inv, v[j].y * inv, v[j].z * inv, v[j].w * inv);
        if (lane == 0) *rs = m * (1.0f / 127.0f);
    }
}
__device__ __forceinline__ float mod_sum(const float* ada_b, const float* modp, int r, int n) {
    float s = ada_b[n];
#pragma unroll
    for (int kc = 0; kc < MOD_SPLIT; ++kc) s += modp[(size_t)(kc * 5 + r) * MODN + n];
    return s;
}
__device__ __forceinline__ void p1_norm1(Frame& F) {
    LAS float* Al = (LAS float*)(F.lds + RING_OFF); LAS float* Bl = Al + D; LAS float* Ac = Bl + D; LAS float* Bc = Ac + D;
    const int c = blockIdx.x, b = c / 64;
    const float* ada_b = F.ada_b(); const float* modp = F.modp(); const float* n1g = F.norm1_g();
    for (int k = F.tid; k < D; k += NWAVES * 64) { const float g = n1g[k];
        Al[k] = g * (1.0f + mod_sum(ada_b, modp, b, D + k)); Bl[k] = mod_sum(ada_b, modp, b, k); Ac[k] = g * (1.0f + mod_sum(ada_b, modp, 4, D + k)); Bc[k] = mod_sum(ada_b, modp, 4, k); }
    { const int per = (5 * MODN) / 256; if (F.tid < per) { const int i = c * per + F.tid; F.modf()[i] = mod_sum(ada_b, modp, i / MODN, i % MODN); } }
    __syncthreads();
    const float* xp = F.x(); const float* cxp = F.ctx(); unsigned char* h8 = (unsigned char*)F.ACT(); bf16* h16 = F.H(); float* rsh = F.rsh();
    for (int j = F.wave; j < 68; j += NWAVES) {
        if (j < 64) { const size_t row = (size_t)c * 64 + j; if (V_FP8 && INPROJ_MODE == 2) norm_row<4, true>(xp + row * D, h8 + row * D, Al, Bl, F.lane, nullptr, rsh + row); else if (V_FP8) norm_row<2, true>(xp + row * D, h8 + row * D, Al, Bl, F.lane); else norm_row<3, true>(xp + row * D, h16 + row * D, Al, Bl, F.lane, h8 + row * D); }
        else { const size_t row = (size_t)c * 4 + (j - 64); if (V_FP8 && INPROJ_MODE == 2) norm_row<4, true>(cxp + row * D, h8 + ((size_t)M + row) * D, Ac, Bc, F.lane, nullptr, rsh + M + row); else if (V_FP8) norm_row<2, true>(cxp + row * D, h8 + ((size_t)M + row) * D, Ac, Bc, F.lane); else norm_row<3, true>(cxp + row * D, h16 + ((size_t)M + row) * D, Ac, Bc, F.lane, h8 + ((size_t)M + row) * D); }
    }
}
__device__ __forceinline__ void p7_norm2(Frame& F) {
    LAS float* Al = (LAS float*)(F.lds + RING_OFF); LAS float* Bl = Al + D;
    const int c = blockIdx.x, b = c / 64; const float* mb = F.modf() + (size_t)b * MODN;
    const float* n2g = F.norm2_g();
    for (int k = F.tid; k < D; k += NWAVES * 64) { Al[k] = n2g[k] * (1.0f + mb[4 * D + k]); Bl[k] = mb[3 * D + k]; }
    __syncthreads();
    const float* x1 = F.out(); bf16* h2 = F.QO();
    for (int j = F.wave; j < 64; j += NWAVES) { const size_t row = (size_t)c * 64 + j; norm_row<1, true>(x1 + row * D, h2 + row * D, Al, Bl, F.lane); }
}
__device__ __forceinline__ void p11_final(Frame& F) {
    LAS float* Al = (LAS float*)(F.lds + RING_OFF);
    const int c = blockIdx.x;
    const float* fg = F.final_g(); float* outp = F.out();
    for (int k = F.tid; k < D; k += NWAVES * 64) Al[k] = fg[k];
    __syncthreads();
    for (int j = F.wave; j < 64; j += NWAVES) { const size_t row = (size_t)c * 64 + j; norm_row<0, false>(outp + row * D, outp + row * D, Al, Al, F.lane); }
}

__device__ __forceinline__ void p6_quant_y(Frame& F) {
    const bf16* Y = F.H(); unsigned char* Y8 = (unsigned char*)F.KB(); float* rsy = F.rsy();
    for (int j = F.wave; j < 64; j += NWAVES) { const size_t row = (size_t)blockIdx.x * 64 + j;
        const GAS v4u* yr = (const GAS v4u*)(Y + row * D) + F.lane; v4u r[8]; float m = 0.f;
#pragma unroll
        for (int q = 0; q < 8; ++q) { r[q] = yr[64 * q]; const unsigned w[4] = {r[q].x, r[q].y, r[q].z, r[q].w};
#pragma unroll
            for (int e = 0; e < 4; ++e) m = fmaxf(m, fmaxf(fabsf(bf_lo(w[e])), fabsf(bf_hi(w[e])))); }
#pragma unroll
        for (int o = 1; o < 64; o <<= 1) m = fmaxf(m, __shfl_xor(m, o));
        const float inv = m > 0.f ? 127.0f / m : 0.f;
#pragma unroll
        for (int q = 0; q < 8; ++q) { v2u o; o.x = pk4_i8(bf_lo(r[q].x) * inv, bf_hi(r[q].x) * inv, bf_lo(r[q].y) * inv, bf_hi(r[q].y) * inv); o.y = pk4_i8(bf_lo(r[q].z) * inv, bf_hi(r[q].z) * inv, bf_lo(r[q].w) * inv, bf_hi(r[q].w) * inv);
            ((GAS v2u*)(Y8 + row * D))[F.lane + 64 * q] = o; }
        if (F.lane == 0) rsy[row] = m * (1.0f / 127.0f);
    }
}

__device__ __forceinline__ void p3_qkfix(Frame& F) {
    constexpr int NPQ = QFIX_ATT ? 0 : M * HA, NPK = M * KVA, NPC = MC * KVA, NP = NPQ + NPK + NPC;
    const int gw = F.vcu * NWAVES + F.wave, NGW = F.G * NWAVES, sub = F.lane & 15;
    bf16* QOp = F.QO(); bf16* KAp = F.KA(); const float* qn = F.qnorm(); const float* kn = F.knorm(); const float2* ropep = F.rope();
    for (int wi = gw; wi < NP / 4; wi += NGW) {
        int p = 4 * wi + (F.lane >> 4); bf16* ptr; const float* gain; int t; bool rope = true;
        if (p < NPQ) { const int row = p >> 4, h = p & 15; ptr = QOp + (size_t)row * 4096 + h * HD; gain = qn; t = row & (S - 1); }
        else if (p < NPQ + NPK) { p -= NPQ; const int row = p >> 2, h = p & 3, b = row >> 12; t = row & (S - 1); ptr = KAp + ((size_t)b * KT + L + t) * 512 + h * HD; gain = kn; }
        else { p -= NPQ + NPK; const int row = p >> 2, h = p & 3, b = row >> 8, j = row & (L - 1); ptr = KAp + ((size_t)b * KT + j) * 512 + h * HD; gain = kn; t = 0; rope = false; }
        const v4u raw = *(const GAS v4u*)(ptr + 8 * sub);
        float v[8] = {bf_lo(raw.x), bf_hi(raw.x), bf_lo(raw.y), bf_hi(raw.y), bf_lo(raw.z), bf_hi(raw.z), bf_lo(raw.w), bf_hi(raw.w)};
        float ss = 0.f;
#pragma unroll
        for (int e = 0; e < 8; ++e) ss += v[e] * v[e];
        ss += __shfl_xor(ss, 1); ss += __shfl_xor(ss, 2); ss += __shfl_xor(ss, 4); ss += __shfl_xor(ss, 8);
        const float rstd = 1.0f / sqrtf(ss * (1.0f / HD) + EPS);
        const f32x4 g0 = *(const GAS f32x4*)(gain + 8 * sub), g1 = *(const GAS f32x4*)(gain + 8 * sub + 4);
        v[0] *= rstd * g0.x; v[1] *= rstd * g0.y; v[2] *= rstd * g0.z; v[3] *= rstd * g0.w; v[4] *= rstd * g1.x; v[5] *= rstd * g1.y; v[6] *= rstd * g1.z; v[7] *= rstd * g1.w;
        const int pos = (sub < 8) ? (t >> 6) : (t & 63); const float2* rp = ropep + pos * 32 + 8 * (sub & 3);
        float o[8];
#pragma unroll
        for (int e = 0; e < 8; ++e) { const float q = __shfl_xor(v[e], 4); const float2 cs = rp[e]; o[e] = rope ? ((sub & 4) ? (v[e] * cs.x + q * cs.y) : (v[e] * cs.x - q * cs.y)) : v[e]; }
        v4u w; w.x = pk2(o[0], o[1]); w.y = pk2(o[2], o[3]); w.z = pk2(o[4], o[5]); w.w = pk2(o[6], o[7]);
        *(GAS v4u*)(ptr + 8 * sub) = w;
    }
}

__device__ __forceinline__ void ld8f(const float* p, float (&v)[8]) { const f32x4 a = *(const GAS f32x4*)p, b = *(const GAS f32x4*)(p + 4); v[0] = a.x; v[1] = a.y; v[2] = a.z; v[3] = a.w; v[4] = b.x; v[5] = b.y; v[6] = b.z; v[7] = b.w; }
__device__ __forceinline__ void p10_convfix(Frame& F) {
    constexpr int NFG = DFF / 8, NBD = NB * 15;
    const int gt = F.vcu * (NWAVES * 64) + F.tid, NT_ = F.G * NWAVES * 64;
    const float* cw = F.conv_w(); const float* cbp_ = F.conv_b(); const float* halo = (const float*)F.Win(); bf16* actp = F.ACT();
    for (int item = gt; item < NFG * NBD; item += NT_) {
        const int fg = item % NFG, bd = item / NFG, pm = (bd / 15) * 16 + (bd % 15), f0 = 8 * fg, cg = 256 * (f0 >> 7) + (f0 & 127);
        float w[3][8], bb[8], r254[8], r255[8], r0[8], r1[8], og[2][8], ov[2][8];
#pragma unroll
        for (int half = 0; half < 2; ++half) {
            const int fo = half * DFF + f0, co = cg + half * 128;
#pragma unroll
            for (int j = 0; j < 3; ++j) ld8f(cw + j * F2 + fo, w[j]);
            ld8f(cbp_ + fo, bb);
            ld8f(halo + ((size_t)pm * 4 + 2) * F2 + co, r254); ld8f(halo + ((size_t)pm * 4 + 3) * F2 + co, r255);
            ld8f(halo + ((size_t)(pm + 1) * 4 + 0) * F2 + co, r0); ld8f(halo + ((size_t)(pm + 1) * 4 + 1) * F2 + co, r1);
#pragma unroll
            for (int e = 0; e < 8; ++e) { const float a = r254[e] * w[0][e] + r255[e] * w[1][e] + r0[e] * w[2][e] + bb[e], b = r255[e] * w[0][e] + r0[e] * w[1][e] + r1[e] * w[2][e] + bb[e];
                if (half == 0) { og[0][e] = a; og[1][e] = b; } else { ov[0][e] = a; ov[1][e] = b; } }
        }
#pragma unroll
        for (int rr = 0; rr < 2; ++rr) { float o[8];
#pragma unroll
            for (int e = 0; e < 8; ++e) o[e] = og[rr][e] * sigmoid_f(og[rr][e]) * ov[rr][e];
            v4u wv; wv.x = pk2(o[0], o[1]); wv.y = pk2(o[2], o[3]); wv.z = pk2(o[4], o[5]); wv.w = pk2(o[6], o[7]);
            *(GAS v4u*)(actp + (size_t)(pm * 256 + 255 + rr) * DFF + f0) = wv; }
    }
}

namespace att {
using bf16x8 = __attribute__((ext_vector_type(8))) short;
using s16x4  = __attribute__((ext_vector_type(4))) short;
using f32x16 = __attribute__((ext_vector_type(16))) float;
using u32x4  = __attribute__((ext_vector_type(4))) unsigned;
constexpr int AD = 128, NW = 8, QBLK = 32, KVBLK = 64;
constexpr float THR = 8.f;
constexpr size_t SHM_V = KVBLK * AD * 2, SHM_K = KVBLK * AD * 2, SHM_ATTN = 2 * SHM_V + 2 * SHM_K + NW * 64 * 4;
constexpr int BIAS_OFF = (int)SHM_ATTN;
constexpr int ATT_LDS = BIAS_OFF + 2048;
#define KSWZ(row, colB) ((row) * 256 + ((colB) ^ (((row) & 7) << 4)))
#define SBAR() __builtin_amdgcn_sched_barrier(0)
__device__ __forceinline__ int crow(int r, int hi) { return (r & 3) + 8 * (r >> 2) + 4 * hi; }
__device__ __forceinline__ unsigned cvtpk(float lo, float hi) { unsigned r; asm volatile("v_cvt_pk_bf16_f32 %0, %1, %2" : "=v"(r) : "v"(lo), "v"(hi)); return r; }
template <int FIXM = 0>
__device__ __forceinline__ void partialSM(f32x16& p0, f32x16& p1, float& m_reg, float& mn, float& alpha, float m0c = 0.f) {
  constexpr float C = SCALE * 1.4426950408889634f;
  if (FIXM == 2) { alpha = 1.f; mn = 0.f;
    for (int r = 0; r < 16; ++r) p0[r] = __builtin_amdgcn_exp2f(p0[r]);
    return; }
  if (FIXM == 1) { alpha = 1.f; mn = 0.f;
    for (int r = 0; r < 16; ++r) p0[r] = fmaf(p0[r], C, -m0c); for (int r = 0; r < 16; ++r) p1[r] = fmaf(p1[r], C, -m0c);
    for (int r = 0; r < 16; ++r) p0[r] = __builtin_amdgcn_exp2f(p0[r]);
    return; }
  float pmax = p0[0]; for (int r = 1; r < 16; ++r) pmax = fmaxf(pmax, p0[r]); for (int r = 0; r < 16; ++r) pmax = fmaxf(pmax, p1[r]);
  { auto rr = __builtin_amdgcn_permlane32_swap(__float_as_uint(pmax), __float_as_uint(pmax), false, false);
    pmax = fmaxf(__uint_as_float(rr[0]), __uint_as_float(rr[1])); }
  if (__builtin_expect(__all(pmax - m_reg <= THR / SCALE), 1)) { mn = m_reg; alpha = 1.f; }
  else { mn = fmaxf(m_reg, pmax); alpha = __builtin_amdgcn_exp2f((m_reg - mn) * C); m_reg = mn; }
  float mnC = -mn * C;
  for (int r = 0; r < 16; ++r) p0[r] = fmaf(p0[r], C, mnC); for (int r = 0; r < 16; ++r) p1[r] = fmaf(p1[r], C, mnC);
  for (int r = 0; r < 16; ++r) p0[r] = __builtin_amdgcn_exp2f(p0[r]);
}
__device__ __forceinline__ void finishSM(f32x16& p0, f32x16& p1, float alpha, float& l_reg, bf16x8& pa0, bf16x8& pa1, bf16x8& pa2, bf16x8& pa3) {
  for (int r = 0; r < 16; ++r) p1[r] = __builtin_amdgcn_exp2f(p1[r]);
  float ps = 0; for (int r = 0; r < 16; ++r) ps += p0[r]; for (int r = 0; r < 16; ++r) ps += p1[r];
  { auto rr = __builtin_amdgcn_permlane32_swap(__float_as_uint(ps), __float_as_uint(ps), false, false);
    ps = __uint_as_float(rr[0]) + __uint_as_float(rr[1]); }
  l_reg = l_reg * alpha + ps;
#define PK4(P, BASE, OUT) do { unsigned a0 = cvtpk(P[BASE + 0], P[BASE + 1]), a1 = cvtpk(P[BASE + 2], P[BASE + 3]);   \
    unsigned b0 = cvtpk(P[BASE + 4], P[BASE + 5]), b1 = cvtpk(P[BASE + 6], P[BASE + 7]);                              \
    auto r0 = __builtin_amdgcn_permlane32_swap(a0, b0, false, false); auto r1 = __builtin_amdgcn_permlane32_swap(a1, b1, false, false); \
    u32x4 w = {r0[0], r1[0], r0[1], r1[1]}; OUT = *reinterpret_cast<bf16x8*>(&w); } while (0)
  PK4(p0, 0, pa0); PK4(p0, 8, pa1); PK4(p1, 0, pa2); PK4(p1, 8, pa3);
#undef PK4
}
__device__ __forceinline__ void qkt(f32x16& p0, f32x16& p1, const char* Ks, const bf16x8* qr, int r32, int hi) {
  p0 = f32x16{}; p1 = f32x16{};
  for (int d0 = 0; d0 < 8; ++d0) { int cb = (d0 * 16 + hi * 8) * 2;
    bf16x8 b0 = *reinterpret_cast<const bf16x8*>(Ks + KSWZ(r32, cb));
    bf16x8 b1 = *reinterpret_cast<const bf16x8*>(Ks + KSWZ(32 + r32, cb));
    p0 = __builtin_amdgcn_mfma_f32_32x32x16_bf16(b0, qr[d0], p0, 0, 0, 0);
    p1 = __builtin_amdgcn_mfma_f32_32x32x16_bf16(b1, qr[d0], p1, 0, 0, 0); }
}
__device__ __forceinline__ int v_st(int k, int c) { const int kk = (k & ~0xC) | ((k & 4) << 1) | ((k & 8) >> 1); return ((kk >> 3) * 4 + (c >> 5)) * 512 + ((kk & 7) * 32 + (c & 31)) * 2; }
__device__ __forceinline__ int v_rd_base(int lane) { return ((lane & 3) << 3) | (((lane >> 2) & 3) << 6) | (((lane >> 4) & 1) << 5) | (((lane >> 5) & 1) << 8); }
constexpr int v_rd_off(int d0, int ks, int half) { return d0 * 512 + ks * 4096 + half * 2048; }
template <int OFF> __device__ __forceinline__ s16x4 tr_read(int vb) {
  s16x4 r; asm volatile("ds_read_b64_tr_b16 %0, %1 offset:%2" : "=&v"(r) : "v"(vb), "i"(OFF) : "memory"); return r;
}
template <int D0> __device__ __forceinline__ void pv_one(f32x16& od, int vb, bf16x8 pa0, bf16x8 pa1, bf16x8 pa2, bf16x8 pa3) {
  const s16x4 l0 = tr_read<v_rd_off(D0, 0, 0)>(vb), h0 = tr_read<v_rd_off(D0, 0, 1)>(vb), l1 = tr_read<v_rd_off(D0, 1, 0)>(vb), h1 = tr_read<v_rd_off(D0, 1, 1)>(vb);
  const s16x4 l2 = tr_read<v_rd_off(D0, 2, 0)>(vb), h2 = tr_read<v_rd_off(D0, 2, 1)>(vb), l3 = tr_read<v_rd_off(D0, 3, 0)>(vb), h3 = tr_read<v_rd_off(D0, 3, 1)>(vb);
  asm volatile("s_waitcnt lgkmcnt(0)" ::: "memory"); SBAR();
#define PK(L, H) (bf16x8){L[0], L[1], L[2], L[3], H[0], H[1], H[2], H[3]}
  od = __builtin_amdgcn_mfma_f32_32x32x16_bf16(pa0, PK(l0, h0), od, 0, 0, 0);
  od = __builtin_amdgcn_mfma_f32_32x32x16_bf16(pa1, PK(l1, h1), od, 0, 0, 0);
  od = __builtin_amdgcn_mfma_f32_32x32x16_bf16(pa2, PK(l2, h2), od, 0, 0, 0);
  od = __builtin_amdgcn_mfma_f32_32x32x16_bf16(pa3, PK(l3, h3), od, 0, 0, 0);
#undef PK
}
__device__ __forceinline__ void pv_d0(f32x16* o, int vb, bf16x8 pa0, bf16x8 pa1, bf16x8 pa2, bf16x8 pa3) {
  pv_one<0>(o[0], vb, pa0, pa1, pa2, pa3); pv_one<1>(o[1], vb, pa0, pa1, pa2, pa3); pv_one<2>(o[2], vb, pa0, pa1, pa2, pa3); pv_one<3>(o[3], vb, pa0, pa1, pa2, pa3);
}
struct NatGeo { int R_lo, nloc, qr, rs, qc, cs; };
__device__ __forceinline__ void nat_mask(f32x16& p0, f32x16& p1, int kr, const NatGeo& g, const float* btab, int hi) {
  const float ninf = -__builtin_inff();
  const float* tb = btab + (kr - g.qr + 7) * 31 + 15 - g.qc + 4 * hi;
#pragma unroll
  for (int q = 0; q < 4; ++q) {
    float bb[8];
#pragma unroll
    for (int e = 0; e < 4; ++e) { bb[e] = tb[8 * q + e]; bb[4 + e] = tb[32 + 8 * q + e]; }
#pragma unroll
    for (int e = 0; e < 4; ++e) { const int r = 4 * q + e, k0 = 8 * q + e + 4 * hi, k1 = k0 + 32;
      p0[r] = ((unsigned)(k0 - g.cs) < 16u) ? p0[r] + bb[e] : ninf; p1[r] = ((unsigned)(k1 - g.cs) < 16u) ? p1[r] + bb[4 + e] : ninf; }
    asm volatile("" ::: "memory");
  }
}
template <int LDQ, int LDK, int LDO, int FIXM = 0, bool QFIX = false>
__device__ __forceinline__ void attn_body(const bf16* Qb, const bf16* __restrict__ Kh, const bf16* __restrict__ Vh, bf16* Ob, int NT, char* lds, unsigned char* Ob8 = nullptr, float oscale8 = 1.f, float m0c = 0.f,
                                          const float* qg = nullptr, const float2* ropet = nullptr, int t0 = 0) {
  int tid_o = threadIdx.x; asm volatile("" : "+v"(tid_o));
  const int tid = tid_o, wid = tid >> 6, lane = tid & 63, r32 = lane & 31, hi = lane >> 5;
  char* V_lds = lds; char* K_lds = lds + 2 * SHM_V;
  float* ws = (float*)(lds + 2 * SHM_V + 2 * SHM_K) + wid * 64; float* li_l = ws; float* al_l = ws + 32;
  float m_reg = -1e30f, l_reg = 0; f32x16 o[4] = {}; bf16x8 qr[8];
  const bf16* Qw = Qb + (long)(wid * QBLK + r32) * LDQ + hi * 8;
#pragma unroll
  for (int d0 = 0; d0 < 8; ++d0) qr[d0] = *reinterpret_cast<const bf16x8*>(Qw + d0 * 16);
  if (QFIX) {
    float x[8][8]; float ss = 0.f;
#pragma unroll
    for (int d0 = 0; d0 < 8; ++d0) { const u32x4 w = *reinterpret_cast<const u32x4*>(&qr[d0]);
      x[d0][0] = bf_lo(w.x); x[d0][1] = bf_hi(w.x); x[d0][2] = bf_lo(w.y); x[d0][3] = bf_hi(w.y); x[d0][4] = bf_lo(w.z); x[d0][5] = bf_hi(w.z); x[d0][6] = bf_lo(w.w); x[d0][7] = bf_hi(w.w);
#pragma unroll
      for (int e = 0; e < 8; ++e) ss += x[d0][e] * x[d0][e]; }
    { auto rr = __builtin_amdgcn_permlane32_swap(__float_as_uint(ss), __float_as_uint(ss), false, false); ss = __uint_as_float(rr[0]) + __uint_as_float(rr[1]); }
    const float rstd = (FIXM == 2 ? SCALE * 1.4426950408889634f : 1.0f) / sqrtf(ss * (1.0f / AD) + EPS);
#pragma unroll
    for (int d0 = 0; d0 < 8; ++d0) { const f32x4 g0 = *reinterpret_cast<const f32x4*>(qg + d0 * 16 + hi * 8), g1 = *reinterpret_cast<const f32x4*>(qg + d0 * 16 + hi * 8 + 4);
      x[d0][0] *= rstd * g0.x; x[d0][1] *= rstd * g0.y; x[d0][2] *= rstd * g0.z; x[d0][3] *= rstd * g0.w; x[d0][4] *= rstd * g1.x; x[d0][5] *= rstd * g1.y; x[d0][6] *= rstd * g1.z; x[d0][7] *= rstd * g1.w; }
    const int tok = t0 + wid * QBLK + r32;
#pragma unroll
    for (int half = 0; half < 2; ++half) { const float2* rp = ropet + (half == 0 ? (tok >> 6) : (tok & 63)) * 32 + hi * 8;
#pragma unroll
      for (int dd = 0; dd < 2; ++dd)
#pragma unroll
        for (int e = 0; e < 8; ++e) { const float2 cs = rp[dd * 16 + e]; const float a = x[4 * half + dd][e], b = x[4 * half + dd + 2][e];
          x[4 * half + dd][e] = a * cs.x - b * cs.y; x[4 * half + dd + 2][e] = b * cs.x + a * cs.y; } }
#pragma unroll
    for (int d0 = 0; d0 < 8; ++d0) { u32x4 w = {cvtpk(x[d0][0], x[d0][1]), cvtpk(x[d0][2], x[d0][3]), cvtpk(x[d0][4], x[d0][5]), cvtpk(x[d0][6], x[d0][7])}; qr[d0] = *reinterpret_cast<bf16x8*>(&w); }
  }
  const int sr = tid >> 4, sc = (tid & 15) * 8, vst0 = v_st(sr, sc), vst1 = v_st(32 + sr, sc);
  const int vb0 = (int)(uintptr_t)V_lds + v_rd_base(lane);
  struct { bf16x8 vs0, vs1, ks0, ks1; } sr_[2];
#define TROW(j) (64 * (j))
#define SLOAD(i, j) do { const long k0_ = TROW(j); sr_[i].vs0 = *reinterpret_cast<const bf16x8*>(&Vh[(k0_ + sr) * LDK + sc]); sr_[i].vs1 = *reinterpret_cast<const bf16x8*>(&Vh[(k0_ + 32 + sr) * LDK + sc]); \
    sr_[i].ks0 = *reinterpret_cast<const bf16x8*>(&Kh[(k0_ + sr) * LDK + sc]); sr_[i].ks1 = *reinterpret_cast<const bf16x8*>(&Kh[(k0_ + 32 + sr) * LDK + sc]); } while (0)
#define SWRITE(b, i) do { *(bf16x8*)(V_lds + (b) * SHM_V + vst0) = sr_[i].vs0;          \
    *(bf16x8*)(V_lds + (b) * SHM_V + vst1) = sr_[i].vs1; int kc = sc * 2;               \
    *(bf16x8*)(K_lds + (b) * SHM_K + KSWZ(sr, kc)) = sr_[i].ks0;                       \
    *(bf16x8*)(K_lds + (b) * SHM_K + KSWZ(32 + sr, kc)) = sr_[i].ks1; } while (0)
#define SWAIT() asm volatile("s_waitcnt vmcnt(4)" ::: "memory")
#define RESC(a) do { if (__any((a) < 1.f)) { if (hi == 0) al_l[r32] = (a); asm volatile("s_waitcnt lgkmcnt(0)" ::: "memory"); \
    for (int d = 0; d < 4; ++d) for (int r = 0; r < 16; ++r) o[d][r] *= al_l[crow(r, hi)]; } } while (0)
#define MASK(P0, P1, j) do { } while (0)
  f32x16 pA0, pA1, pB0, pB1; float mnA, mnB, alA, alB; bf16x8 pa0, pa1, pa2, pa3;
  constexpr int SE = 0, SO = 1;
  SLOAD(SE, 0); asm volatile("s_waitcnt vmcnt(0)" ::: "memory"); SWRITE(0, SE); __syncthreads();
  qkt(pA0, pA1, K_lds, qr, r32, hi); MASK(pA0, pA1, 0); partialSM<FIXM>(pA0, pA1, m_reg, mnA, alA, m0c);
  SLOAD(SO, 1); if (2 < NT) SLOAD(SE, 2);
  SWAIT(); SWRITE(1, SO); __syncthreads();
  for (int j = 1; j + 1 < NT; j += 2) {
    SBAR(); qkt(pB0, pB1, K_lds + SHM_K, qr, r32, hi);
    finishSM(pA0, pA1, alA, l_reg, pa0, pa1, pa2, pa3); SBAR();
    SLOAD(SO, j + 2); SBAR();
    pv_d0(o, vb0, pa0, pa1, pa2, pa3); MASK(pB0, pB1, j); partialSM<FIXM>(pB0, pB1, m_reg, mnB, alB, m0c);
    __syncthreads(); SWAIT(); SWRITE(0, SE);
    RESC(alB); __syncthreads();
    SBAR(); qkt(pA0, pA1, K_lds, qr, r32, hi);
    finishSM(pB0, pB1, alB, l_reg, pa0, pa1, pa2, pa3); SBAR();
    if (j + 3 < NT) SLOAD(SE, j + 3); SBAR();
    pv_d0(o, vb0 + (int)SHM_V, pa0, pa1, pa2, pa3); MASK(pA0, pA1, j + 1); partialSM<FIXM>(pA0, pA1, m_reg, mnA, alA, m0c);
    __syncthreads(); SWAIT(); SWRITE(1, SO);
    RESC(alA); __syncthreads();
  }
  SBAR(); qkt(pB0, pB1, K_lds + SHM_K, qr, r32, hi);
  finishSM(pA0, pA1, alA, l_reg, pa0, pa1, pa2, pa3); SBAR();
  pv_d0(o, vb0, pa0, pa1, pa2, pa3); MASK(pB0, pB1, NT - 1); partialSM<FIXM>(pB0, pB1, m_reg, mnB, alB, m0c);
  __syncthreads(); RESC(alB);
  finishSM(pB0, pB1, alB, l_reg, pa0, pa1, pa2, pa3); SBAR();
  pv_d0(o, vb0 + (int)SHM_V, pa0, pa1, pa2, pa3);
  if (hi == 0) li_l[r32] = l_reg; asm volatile("s_waitcnt lgkmcnt(0)" ::: "memory");
  float rli[16];
#pragma unroll
  for (int r = 0; r < 16; ++r) rli[r] = __builtin_amdgcn_rcpf(li_l[crow(r, hi)]);
  bf16* Ow = Ob + (long)(wid * QBLK) * LDO;
#pragma unroll
  for (int r = 0; r < 16; ++r) { int orow = crow(r, hi);
    if (BR_FP8) { unsigned char* Ow8 = Ob8 + (long)(wid * QBLK + orow) * LDO;
      for (int d0 = 0; d0 < 4; ++d0) Ow8[d0 * 32 + r32] = (unsigned char)(pk4_fp8(o[d0][r] * rli[r] * oscale8, 0.f, 0.f, 0.f) & 0xffu); }
    else for (int d0 = 0; d0 < 4; ++d0) Ow[(long)orow * LDO + d0 * 32 + r32] = (bf16)(cvtpk(o[d0][r] * rli[r], 0.f) & 0xffffu); }
#undef TROW
#undef SLOAD
#undef SWRITE
#undef SWAIT
#undef RESC
#undef MASK
}

template <int LDQ, int LDK, int LDO>
__device__ __forceinline__ void nat_body(const bf16* Qb, const bf16* __restrict__ Kh, const bf16* __restrict__ Vh, bf16* Ob, const NatGeo g, char* lds, unsigned char* Ob8 = nullptr, float oscale8 = 1.f) {
  int tid_o = threadIdx.x; asm volatile("" : "+v"(tid_o));
  const int tid = tid_o, wid = tid >> 6, lane = tid & 63, r32 = lane & 31, hi = lane >> 5;
  char* V_lds = lds; char* K_lds = lds + 2 * SHM_V;
  float* ws = (float*)(lds + 2 * SHM_V + 2 * SHM_K) + wid * 64; float* li_l = ws; float* al_l = ws + 32;
  const float* btab = (const float*)(lds + BIAS_OFF);
  float m_reg = -1e30f, l_reg = 0; f32x16 o[4] = {}; bf16x8 qr[8];
  const bf16* Qw = Qb + (long)(wid * QBLK + r32) * LDQ + hi * 8;
#pragma unroll
  for (int d0 = 0; d0 < 8; ++d0) qr[d0] = *reinterpret_cast<const bf16x8*>(Qw + d0 * 16);
  const int sr = tid >> 4, sc = (tid & 15) * 8, vst0 = v_st(sr, sc), vst1 = v_st(32 + sr, sc);
  const int vb0 = (int)(uintptr_t)V_lds + v_rd_base(lane);
  bf16x8 vs0, vs1, ks0, ks1;
#define TROW(j) ((j) < 4 ? 64 * (j) : L + 64 * (g.R_lo + (j) - 4))
#define SLOAD(j) do { const long k0_ = TROW(j); vs0 = *reinterpret_cast<const bf16x8*>(&Vh[(k0_ + sr) * LDK + sc]); vs1 = *reinterpret_cast<const bf16x8*>(&Vh[(k0_ + 32 + sr) * LDK + sc]); \
    ks0 = *reinterpret_cast<const bf16x8*>(&Kh[(k0_ + sr) * LDK + sc]); ks1 = *reinterpret_cast<const bf16x8*>(&Kh[(k0_ + 32 + sr) * LDK + sc]); } while (0)
#define SWRITE(b) do { *(bf16x8*)(V_lds + (b) * SHM_V + vst0) = vs0; *(bf16x8*)(V_lds + (b) * SHM_V + vst1) = vs1; int kc = sc * 2;               \
    *(bf16x8*)(K_lds + (b) * SHM_K + KSWZ(sr, kc)) = ks0; *(bf16x8*)(K_lds + (b) * SHM_K + KSWZ(32 + sr, kc)) = ks1; } while (0)
  const int NT = 4 + g.nloc;
  SLOAD(0); asm volatile("s_waitcnt vmcnt(0)" ::: "memory"); SWRITE(0); __syncthreads();
  for (int j = 0; j < NT; ++j) {
    const int b = j & 1;
    if (j + 1 < NT) SLOAD(j + 1);
    const int kr = g.R_lo + j - 4;
    const bool skip = (j >= 4) && ((unsigned)(kr - g.rs) >= 8u);
    if (!skip) {
      f32x16 p0, p1; float mn, al; bf16x8 pa0, pa1, pa2, pa3;
      qkt(p0, p1, K_lds + b * SHM_K, qr, r32, hi);
      if (j >= 4) nat_mask(p0, p1, kr, g, btab, hi);
      partialSM(p0, p1, m_reg, mn, al);
      if (__any(al < 1.f)) { if (hi == 0) al_l[r32] = al; asm volatile("s_waitcnt lgkmcnt(0)" ::: "memory");
        for (int d = 0; d < 4; ++d) for (int r = 0; r < 16; ++r) o[d][r] *= al_l[crow(r, hi)]; }
      finishSM(p0, p1, al, l_reg, pa0, pa1, pa2, pa3); SBAR();
      pv_d0(o, vb0 + b * (int)SHM_V, pa0, pa1, pa2, pa3);
    }
    if (j + 1 < NT) { asm volatile("s_waitcnt vmcnt(0)" ::: "memory"); SWRITE(b ^ 1); }
    __syncthreads();
  }
  if (hi == 0) li_l[r32] = l_reg; asm volatile("s_waitcnt lgkmcnt(0)" ::: "memory");
  float rli[16];
#pragma unroll
  for (int r = 0; r < 16; ++r) rli[r] = __builtin_amdgcn_rcpf(li_l[crow(r, hi)]);
  bf16* Ow = Ob + (long)(wid * QBLK) * LDO;
#pragma unroll
  for (int r = 0; r < 16; ++r) { int orow = crow(r, hi);
    if (BR_FP8) { unsigned char* Ow8 = Ob8 + (long)(wid * QBLK + orow) * LDO;
      for (int d0 = 0; d0 < 4; ++d0) Ow8[d0 * 32 + r32] = (unsigned char)(pk4_fp8(o[d0][r] * rli[r] * oscale8, 0.f, 0.f, 0.f) & 0xffu); }
    else for (int d0 = 0; d0 < 4; ++d0) Ow[(long)orow * LDO + d0 * 32 + r32] = (bf16)(cvtpk(o[d0][r] * rli[r], 0.f) & 0xffffu); }
#undef TROW
#undef SLOAD
#undef SWRITE
}
}

__device__ __forceinline__ void p4_attention(Frame& F) {
    char* lds = (char*)(F.lds + RING_OFF);
    bf16* QOp = F.QO(); const bf16* KAp = F.KA(); const bf16* VAp = F.VA(); const bf16* KBp = F.KB(); const bf16* VBp = F.VB(); const float* rpbp = F.rpb(); bf16* scrp = F.ACT(); unsigned char* o8p = (unsigned char*)F.ACT(); const float* qgp = F.qnorm(); const float2* ropep = F.rope();
    float m0c, m0c_raw; { const float gq = fmaxf(fabsf(F.qnorm()[F.lane]), fabsf(F.qnorm()[64 + F.lane])), gk = fmaxf(fabsf(F.knorm()[F.lane]), fabsf(F.knorm()[64 + F.lane])); float a = gq, b = gk;
#pragma unroll
      for (int o = 1; o < 64; o <<= 1) { a = fmaxf(a, __shfl_xor(a, o)); b = fmaxf(b, __shfl_xor(b, o)); }
      m0c_raw = __uint_as_float(__builtin_amdgcn_readfirstlane(__float_as_uint(128.0f * 1.01f * a * b * SCALE * 1.4426950408889634f))); m0c = fminf(m0c_raw, 60.0f); }
#ifndef ATT_NO_A
    for (int u = F.vcu; u < NB * KVA * GQ * (S / 256); u += F.G) {
        const int grp = u >> 6, j = u & 63, b = grp >> 2, kvh = grp & 3, gq = j >> 4, qblk = j & 15;
        bf16* Q = QOp + ((size_t)(b * S + qblk * 256)) * 4096 + (kvh * GQ + gq) * HD;
        const bf16* K = KAp + (size_t)b * KT * 512 + kvh * HD; const bf16* V = VAp + (size_t)b * KT * 512 + kvh * HD;
        __syncthreads();
#if defined(ATT_PROBE) && (ATT_PROBE & 1)
        att::attn_body<4096, 512, 4096>(Q, K, V, scrp + (Q - QOp), KT / 64, lds); __syncthreads();
#endif
        if (QFIX_ATT && m0c_raw <= 40.0f) att::attn_body<4096, 512, 4096, 2, QFIX_ATT>(Q, K, V, Q, KT / 64, lds, o8p + (Q - QOp), SC_OA, 0.f, qgp, ropep, qblk * 256);
        else att::attn_body<4096, 512, 4096, 1, QFIX_ATT>(Q, K, V, Q, KT / 64, lds, o8p + (Q - QOp), SC_OA, m0c, qgp, ropep, qblk * 256);
    }
#endif
#ifndef ATT_NO_B
    for (int u = F.vcu; u < NB * HB * (S / 256); u += F.G) {
        const int pair = u >> 4, rblk = u & 15, b = pair >> 4, h = pair & 15, r0 = 4 * rblk;
        bf16* Q = QOp + ((size_t)(b * S + r0 * GW)) * 4096 + 2048 + h * HD;
        const bf16* K = KBp + (size_t)b * KT * 2048 + h * HD; const bf16* V = VBp + (size_t)b * KT * 2048 + h * HD;
        int R_lo = r0 - 4; R_lo = R_lo < 0 ? 0 : (R_lo > GW - 8 ? GW - 8 : R_lo);
        int R_hi = r0 + 3 - 4; R_hi = (R_hi < 0 ? 0 : (R_hi > GW - 8 ? GW - 8 : R_hi)) + 7;
        att::NatGeo g; g.R_lo = R_lo; g.nloc = R_hi - R_lo + 1; g.qr = r0 + (F.wave >> 1); g.qc = 32 * (F.wave & 1) + (F.lane & 31);
        g.rs = g.qr - 4; g.rs = g.rs < 0 ? 0 : (g.rs > GW - 8 ? GW - 8 : g.rs); g.cs = g.qc - 8; g.cs = g.cs < 0 ? 0 : (g.cs > GW - 16 ? GW - 16 : g.cs);
        __syncthreads();
        if (F.tid < 15 * 31) ((LAS float*)(F.lds + RING_OFF + att::BIAS_OFF))[F.tid] = rpbp[h * (15 * 31) + F.tid] * (1.0f / SCALE);
        __syncthreads();
#if defined(ATT_PROBE) && (ATT_PROBE & 2)
        att::nat_body<4096, 2048, 4096>(Q, K, V, scrp + (Q - QOp), g, lds); __syncthreads();
#endif
        att::nat_body<4096, 2048, 4096>(Q, K, V, Q, g, lds, o8p + (Q - QOp), SC_OB);
    }
#endif
    __syncthreads();
}

typedef const f32x4 (&AccRef)[2][2][4][2];
__device__ __forceinline__ v4u pack8(const f32x4 v0, const f32x4 v1) { v4u w; w.x = pk2(v0[0], v0[1]); w.y = pk2(v0[2], v0[3]); w.z = pk2(v1[0], v1[1]); w.w = pk2(v1[2], v1[3]); return w; }
template <bool FP8C> struct EpiInProj {
    static constexpr bool PERM = true, AFTER_DRAIN = false, MIDK = false;
    bf16 *QO, *KA, *VA, *KB, *VB, *GA, *GB; const float* rsh; float wscale;
    __device__ __forceinline__ void operator()(AccRef acc, const pg8::Unit& u, int wr, int wc, int fr, int fq) const {
        constexpr bool I8 = FP8C && INPROJ_MODE == 2;
        const int pm = u.pm, pn = inproj_global_tile(FP8C, u.pn); const bool ctx = pm >= 64; const float osc = FP8C ? 1.0f / SC_WIN : 1.0f; const int b = ctx ? pm - 64 : pm >> 4; const size_t krow0 = (size_t)b * KT + (ctx ? 0 : L + (pm & 15) * 256);
        bf16* tile; int ldc; bool sig = false;
        if (pn < 8) { tile = QO + (size_t)pm * 256 * 4096 + pn * 256; ldc = 4096; }
        else if (pn < 10) { tile = KA + krow0 * 512 + (pn - 8) * 256; ldc = 512; }
        else if (pn < 12) { tile = VA + krow0 * 512 + (pn - 10) * 256; ldc = 512; }
        else if (pn < 20) { tile = QO + (size_t)pm * 256 * 4096 + 2048 + (pn - 12) * 256; ldc = 4096; }
        else if (pn < 28) { tile = KB + krow0 * 2048 + (pn - 20) * 256; ldc = 2048; }
        else if (pn < 36) { tile = VB + krow0 * 2048 + (pn - 28) * 256; ldc = 2048; }
        else if (pn < 52) { tile = GA + (size_t)pm * 256 * 4096 + (pn - 36) * 256; ldc = 4096; sig = true; }
        else { tile = GB + (size_t)pm * 256 * 4096 + (pn - 52) * 256; ldc = 4096; sig = true; }
#pragma unroll
        for (int ai = 0; ai < 2; ++ai)
#pragma unroll
            for (int m = 0; m < 4; ++m) { bf16* rowp = tile + (size_t)(ai * 128 + wr * 64 + m * 16 + fr) * ldc + wc * 32 + 8 * fq;
                const float rsc = I8 ? rsh[pm * 256 + ai * 128 + wr * 64 + m * 16 + fr] * wscale : osc;
#pragma unroll
                for (int bj = 0; bj < 2; ++bj) { f32x4 v0, v1;
                    if (I8) { typedef int i32x4_ __attribute__((ext_vector_type(4)));
                        const f32x4 a0 = acc[ai][bj][m][0], a1 = acc[ai][bj][m][1];
                        v0 = __builtin_convertvector(__builtin_bit_cast(i32x4_, a0), f32x4) * rsc; v1 = __builtin_convertvector(__builtin_bit_cast(i32x4_, a1), f32x4) * rsc; }
                    else { v0 = acc[ai][bj][m][0] * rsc; v1 = acc[ai][bj][m][1] * rsc; }
                    if (sig) {
#pragma unroll
                        for (int e = 0; e < 4; ++e) { v0[e] = sigmoid_f(v0[e]); v1[e] = sigmoid_f(v1[e]); } }
                    *(GAS v4u*)(rowp + bj * 128) = pack8(v0, v1); } }
    }
};
struct EpiPlain {
    static constexpr bool PERM = true, AFTER_DRAIN = false, MIDK = false;
    bf16* O; int ldc; int pad;
    __device__ __forceinline__ void operator()(AccRef acc, const pg8::Unit& u, int wr, int wc, int fr, int fq) const {
        bf16* tile = O + (size_t)u.pm * 256 * ldc + u.pn * 256;
#pragma unroll
        for (int ai = 0; ai < 2; ++ai)
#pragma unroll
            for (int m = 0; m < 4; ++m) { bf16* rowp = tile + (size_t)(ai * 128 + wr * 64 + m * 16 + fr) * ldc + wc * 32 + 8 * fq;
#pragma unroll
                for (int bj = 0; bj < 2; ++bj) *(GAS v4u*)(rowp + bj * 128) = pack8(acc[ai][bj][m][0], acc[ai][bj][m][1]); }
    }
};
template <bool ACCUM> struct EpiGate {
    static constexpr bool PERM = true, AFTER_DRAIN = false, MIDK = false;
    bf16* Y; const bf16* G; unsigned char* Y8;
    __device__ __forceinline__ void operator()(AccRef acc, const pg8::Unit& u, int wr, int wc, int fr, int fq) const {
        const size_t t0 = (size_t)u.pm * 256 * 4096 + u.pn * 256;
#pragma unroll
        for (int ai = 0; ai < 2; ++ai)
#pragma unroll
            for (int m = 0; m < 4; ++m) { const size_t ro = t0 + (size_t)(ai * 128 + wr * 64 + m * 16 + fr) * 4096 + wc * 32 + 8 * fq;
#pragma unroll
                for (int bj = 0; bj < 2; ++bj) { const v4u g = *(const GAS v4u*)(G + ro + bj * 128); f32x4 v0 = acc[ai][bj][m][0], v1 = acc[ai][bj][m][1];
                    v0[0] *= bf_lo(g.x); v0[1] *= bf_hi(g.x); v0[2] *= bf_lo(g.y); v0[3] *= bf_hi(g.y); v1[0] *= bf_lo(g.z); v1[1] *= bf_hi(g.z); v1[2] *= bf_lo(g.w); v1[3] *= bf_hi(g.w);
                    if (ACCUM) { const v4u y = *(const GAS v4u*)(Y + ro + bj * 128);
                        v0[0] += bf_lo(y.x); v0[1] += bf_hi(y.x); v0[2] += bf_lo(y.y); v0[3] += bf_hi(y.y); v1[0] += bf_lo(y.z); v1[1] += bf_hi(y.z); v1[2] += bf_lo(y.w); v1[3] += bf_hi(y.w); }
                    if (ACCUM && WOUT_FP8) { v0 = v0 * SC_Y; v1 = v1 * SC_Y; v2u w; w.x = pk4_fp8(v0[0], v0[1], v0[2], v0[3]); w.y = pk4_fp8(v1[0], v1[1], v1[2], v1[3]); *(GAS v2u*)(Y8 + ro + bj * 128) = w; }
                    else *(GAS v4u*)(Y + ro + bj * 128) = pack8(v0, v1); } }
    }
};
struct EpiGateMerged {
    static constexpr bool PERM = true, AFTER_DRAIN = false, MIDK = true;
    static constexpr float MIDS = BR_FP8 ? SC_OB / SC_OA : 1.0f, ENDS = BR_FP8 ? 1.0f / (SC_OB * SC_WBR) : 1.0f;
    bf16* Y; const bf16* GA; const bf16* GB; unsigned char* Y8;
    __device__ __forceinline__ void mid(f32x4 (&acc)[2][2][4][2], const pg8::Unit& u, int wr, int wc, int fr, int fq) const {
        size_t rb = (size_t)u.pm * 256 * 4096 + u.pn * 256 + (size_t)(wr * 64 + fr) * 4096 + wc * 32 + 8 * fq;
        asm volatile("" : "+v"(rb));
#pragma unroll
        for (int ai = 0; ai < 2; ++ai)
#pragma unroll
            for (int m = 0; m < 4; ++m) { const size_t ro = rb + (size_t)(ai * 128 + m * 16) * 4096;
#pragma unroll
                for (int bj = 0; bj < 2; ++bj) { const v4u a = *(const GAS v4u*)(GA + ro + bj * 128), b = *(const GAS v4u*)(GB + ro + bj * 128);
                    const unsigned aw[4] = {a.x, a.y, a.z, a.w}, bw[4] = {b.x, b.y, b.z, b.w};
#pragma unroll
                    for (int q = 0; q < 4; ++q) { const float r0 = bf_lo(aw[q]) * MIDS * __builtin_amdgcn_rcpf(fmaxf(bf_lo(bw[q]), 1e-20f)), r1 = bf_hi(aw[q]) * MIDS * __builtin_amdgcn_rcpf(fmaxf(bf_hi(bw[q]), 1e-20f));
                        acc[ai][bj][m][q >> 1][(q & 1) * 2] *= r0; acc[ai][bj][m][q >> 1][(q & 1) * 2 + 1] *= r1; }
                    asm volatile("" : "+v"(acc[ai][bj][m][0]), "+v"(acc[ai][bj][m][1])); }
                __builtin_amdgcn_sched_barrier(0); }
    }
    __device__ __forceinline__ void operator()(AccRef acc, const pg8::Unit& u, int wr, int wc, int fr, int fq) const {
        size_t rb = (size_t)u.pm * 256 * 4096 + u.pn * 256 + (size_t)(wr * 64 + fr) * 4096 + wc * 32 + 8 * fq;
        asm volatile("" : "+v"(rb));
#pragma unroll
        for (int ai = 0; ai < 2; ++ai)
#pragma unroll
            for (int m = 0; m < 4; ++m) { const size_t ro = rb + (size_t)(ai * 128 + m * 16) * 4096;
#pragma unroll
                for (int bj = 0; bj < 2; ++bj) { const v4u g = *(const GAS v4u*)(GB + ro + bj * 128); f32x4 v0 = acc[ai][bj][m][0], v1 = acc[ai][bj][m][1];
                    v0[0] *= ENDS * fmaxf(bf_lo(g.x), 1e-20f); v0[1] *= ENDS * fmaxf(bf_hi(g.x), 1e-20f); v0[2] *= ENDS * fmaxf(bf_lo(g.y), 1e-20f); v0[3] *= ENDS * fmaxf(bf_hi(g.y), 1e-20f);
                    v1[0] *= ENDS * fmaxf(bf_lo(g.z), 1e-20f); v1[1] *= ENDS * fmaxf(bf_hi(g.z), 1e-20f); v1[2] *= ENDS * fmaxf(bf_lo(g.w), 1e-20f); v1[3] *= ENDS * fmaxf(bf_hi(g.w), 1e-20f);
                    if (WOUT_FP8) { v0 = v0 * SC_Y; v1 = v1 * SC_Y; v2u w; w.x = pk4_fp8(v0[0], v0[1], v0[2], v0[3]); w.y = pk4_fp8(v1[0], v1[1], v1[2], v1[3]); *(GAS v2u*)(Y8 + ro + bj * 128) = w; }
                    else *(GAS v4u*)(Y + ro + bj * 128) = pack8(v0, v1); } }
    }
};
struct EpiResid {
    static constexpr bool PERM = true, AFTER_DRAIN = false, MIDK = false;
    float* out; const float* base; const float* gate; float oscale; int pad;
    __device__ __forceinline__ void operator()(AccRef acc, const pg8::Unit& u, int wr, int wc, int fr, int fq) const {
        const float* gb = gate + (size_t)(u.pm >> 4) * MODN + u.pn * 256 + wc * 32 + 8 * fq;
        f32x4 gv[2][2];
#pragma unroll
        for (int bj = 0; bj < 2; ++bj)
#pragma unroll
            for (int n = 0; n < 2; ++n) gv[bj][n] = *(const GAS f32x4*)(gb + bj * 128 + n * 4) * oscale;
#pragma unroll
        for (int ai = 0; ai < 2; ++ai)
#pragma unroll
            for (int m = 0; m < 4; ++m) { const size_t ro = (size_t)(u.pm * 256 + ai * 128 + wr * 64 + m * 16 + fr) * D + u.pn * 256 + wc * 32 + 8 * fq;
#pragma unroll
                for (int bj = 0; bj < 2; ++bj)
#pragma unroll
                    for (int n = 0; n < 2; ++n) { const f32x4 bs = *(const GAS f32x4*)(base + ro + bj * 128 + n * 4); *(GAS f32x4*)(out + ro + bj * 128 + n * 4) = bs + gv[bj][n] * acc[ai][bj][m][n]; } }
    }
};
__device__ __forceinline__ float dpp_f(float old, float src, const int ctrl_sel) {
    const int o = __builtin_bit_cast(int, old), x = __builtin_bit_cast(int, src); int r;
    if (ctrl_sel == 0) r = __builtin_amdgcn_update_dpp(o, x, 0x111, 0xf, 0xf, false);
    else if (ctrl_sel == 1) r = __builtin_amdgcn_update_dpp(o, x, 0x101, 0xf, 0xf, false);
    else if (ctrl_sel == 2) r = __builtin_amdgcn_update_dpp(o, x, 0x121, 0xf, 0xf, false);
    else r = __builtin_amdgcn_update_dpp(o, x, 0x12F, 0xf, 0xf, false);
    return __builtin_bit_cast(float, r);
}
template <int SEL> __device__ __forceinline__ f32x4 dpp4(const f32x4 old, const f32x4 src) { f32x4 r; r.x = dpp_f(old.x, src.x, SEL); r.y = dpp_f(old.y, src.y, SEL); r.z = dpp_f(old.z, src.z, SEL); r.w = dpp_f(old.w, src.w, SEL); return r; }
constexpr int XCH_OFF = LDSCTL_OFF + 1024;
static_assert(XCH_OFF + 8192 <= LDS_BYTES, "LDS map");
struct EpiConvAct {
    static constexpr bool PERM = true, AFTER_DRAIN = false, MIDK = false;
    bf16* ACT; float* HALO; const float* cw; const float* cb; LAS f32x4* xch;
    __device__ __forceinline__ void operator()(f32x4 (&acc)[2][2][4][2], const pg8::Unit& u, int wr, int wc, int fr, int fq) const {
        const int wid = wr * 4 + wc, fbase = 128 * u.pn + 32 * wc + 8 * fq;
        const f32x4 zero4 = {0.f, 0.f, 0.f, 0.f};
        f32x4 W0[2][2], W1[2][2], W2[2][2], Bb[2][2];
#pragma unroll
        for (int bj = 0; bj < 2; ++bj)
#pragma unroll
            for (int n = 0; n < 2; ++n) { const int fo = bj * DFF + fbase + 4 * n; W0[bj][n] = *(const GAS f32x4*)(cw + fo); W1[bj][n] = *(const GAS f32x4*)(cw + F2 + fo); W2[bj][n] = *(const GAS f32x4*)(cw + 2 * F2 + fo); Bb[bj][n] = *(const GAS f32x4*)(cb + fo); }
        LAS f32x4* mine = xch + wid * 64;
        if (fr == 0) {
#pragma unroll
            for (int ai = 0; ai < 2; ++ai)
#pragma unroll
                for (int bj = 0; bj < 2; ++bj)
#pragma unroll
                    for (int n = 0; n < 2; ++n) mine[((ai * 2 + 0) * 4 + fq) * 4 + bj * 2 + n] = acc[ai][bj][0][n]; }
        if (fr == 15) {
#pragma unroll
            for (int ai = 0; ai < 2; ++ai)
#pragma unroll
                for (int bj = 0; bj < 2; ++bj)
#pragma unroll
                    for (int n = 0; n < 2; ++n) mine[((ai * 2 + 1) * 4 + fq) * 4 + bj * 2 + n] = acc[ai][bj][3][n]; }
        { const int slot = wr == 0 ? fr : fr - 12;
          if ((wr == 0 && fr < 2) || (wr == 1 && fr >= 14)) { float* hp = HALO + ((size_t)u.pm * 4 + slot) * F2 + 256 * u.pn + 32 * wc + 8 * fq;
#pragma unroll
              for (int bj = 0; bj < 2; ++bj)
#pragma unroll
                  for (int n = 0; n < 2; ++n) *(GAS f32x4*)(hp + bj * 128 + 4 * n) = wr == 0 ? acc[0][bj][0][n] : acc[1][bj][3][n]; } }
        asm volatile("s_waitcnt vmcnt(0) lgkmcnt(0)" ::: "memory"); __builtin_amdgcn_s_barrier(); asm volatile("" ::: "memory");
#pragma unroll
        for (int bj = 0; bj < 2; ++bj)
#pragma unroll
            for (int n = 0; n < 2; ++n) asm volatile("" : "+v"(W0[bj][n]), "+v"(W1[bj][n]), "+v"(W2[bj][n]), "+v"(Bb[bj][n]));
        __builtin_amdgcn_sched_barrier(0);
#pragma unroll
        for (int bj = 0; bj < 2; ++bj) {
#pragma unroll
            for (int ai = 0; ai < 2; ++ai) {
                const int rho = 2 * ai + wr;
                f32x4 carry[2], eN[2];
#pragma unroll
                for (int n = 0; n < 2; ++n) {
                    carry[n] = rho > 0 ? xch[(((rho - 1) & 1) * 4 + wc) * 64 + ((((rho - 1) >> 1) * 2 + 1) * 4 + fq) * 4 + bj * 2 + n] : zero4;
                    eN[n] = rho < 3 ? xch[(((rho + 1) & 1) * 4 + wc) * 64 + ((((rho + 1) >> 1) * 2 + 0) * 4 + fq) * 4 + bj * 2 + n] : zero4; }
#pragma unroll
                for (int m = 0; m < 4; ++m)
#pragma unroll
                    for (int n = 0; n < 2; ++n) {
                        const f32x4 cur = acc[ai][bj][m][n];
                        const f32x4 prv = dpp4<0>(carry[n], cur);
                        const f32x4 tn = m < 3 ? dpp4<3>(zero4, acc[ai][bj][m < 3 ? m + 1 : 3][n]) : eN[n];
                        const f32x4 nxt = dpp4<1>(tn, cur);
                        carry[n] = dpp4<2>(zero4, cur);
                        acc[ai][bj][m][n] = W0[bj][n] * prv + W1[bj][n] * cur + W2[bj][n] * nxt + Bb[bj][n];
                        asm volatile("" : "+v"(acc[ai][bj][m][n]));
                        __builtin_amdgcn_sched_barrier(0);
                    }
            }
        }
#pragma unroll
        for (int ai = 0; ai < 2; ++ai)
#pragma unroll
            for (int m = 0; m < 4; ++m) { bf16* rowp = ACT + (size_t)(u.pm * 256 + ai * 128 + wr * 64 + m * 16 + fr) * DFF + fbase;
                f32x4 o[2];
#pragma unroll
                for (int n = 0; n < 2; ++n) { const f32x4 g = acc[ai][0][m][n], v = acc[ai][1][m][n];
#pragma unroll
                    for (int e = 0; e < 4; ++e) o[n][e] = g[e] * sigmoid_f(g[e]) * v[e]; }
                *(GAS v4u*)rowp = pack8(o[0], o[1]); __builtin_amdgcn_sched_barrier(0); }
    }
};
struct EpiResidI8 {
    static constexpr bool PERM = true, AFTER_DRAIN = false, MIDK = false;
    float* out; const float* base; const float* gate; const float* rs; float wscale; int pad;
    __device__ __forceinline__ void operator()(AccRef acc, const pg8::Unit& u, int wr, int wc, int fr, int fq) const {
        typedef int i32x4_ __attribute__((ext_vector_type(4)));
        const float* gb = gate + (size_t)(u.pm >> 4) * MODN + u.pn * 256 + wc * 32 + 8 * fq;
        f32x4 gv[2][2];
#pragma unroll
        for (int bj = 0; bj < 2; ++bj)
#pragma unroll
            for (int n = 0; n < 2; ++n) gv[bj][n] = *(const GAS f32x4*)(gb + bj * 128 + n * 4) * wscale;
#pragma unroll
        for (int ai = 0; ai < 2; ++ai)
#pragma unroll
            for (int m = 0; m < 4; ++m) { const int grow = u.pm * 256 + ai * 128 + wr * 64 + m * 16 + fr; const float rsc = rs[grow]; const size_t ro = (size_t)grow * D + u.pn * 256 + wc * 32 + 8 * fq;
#pragma unroll
                for (int bj = 0; bj < 2; ++bj)
#pragma unroll
                    for (int n = 0; n < 2; ++n) { const f32x4 bs = *(const GAS f32x4*)(base + ro + bj * 128 + n * 4); const f32x4 a = acc[ai][bj][m][n];
                        *(GAS f32x4*)(out + ro + bj * 128 + n * 4) = bs + gv[bj][n] * (__builtin_convertvector(__builtin_bit_cast(i32x4_, a), f32x4) * rsc); } }
    }
};
template <bool FP8C> struct InProjOrder {
    static constexpr int NT = FP8C ? NT_IN8 : NT_IN16;
    pg8::StaticOrder base; int G, c;
    __device__ __forceinline__ void init(int G_, int c_) { base.init(M, NT * 256, G_, c_); G = G_; c = c_; }
    __device__ __forceinline__ bool next(int i, pg8::Unit& u) const {
        if (base.next(i, u)) return true;
        constexpr int NCT = V_FP8 ? (FP8C ? 20 : 0) : 10;
        const long e = (long)i * G + c - (long)(M / 256) * NT; if (e < 0 || e >= 4 * NCT) return false;
        u.pm = 64 + (int)(e & 3); const int j = (int)(e >> 2); u.pn = V_FP8 ? (j < 4 ? 8 + j : 16 + j) : (FP8C ? (j < 2 ? 8 + j : 16 + j) : j); return true;
    }
    __device__ __forceinline__ void a_ready(const pg8::Unit&) const {}
    __device__ __forceinline__ void done(const pg8::Unit&) const {}
};

struct EpiNullProbe {
    static constexpr bool PERM = true, AFTER_DRAIN = false, MIDK = false;
    float* O; int flag; int pad;
    __device__ __forceinline__ void operator()(AccRef acc, const pg8::Unit& u, int wr, int wc, int fr, int fq) const {
        f32x4 t = {0.f, 0.f, 0.f, 0.f};
#pragma unroll
        for (int ai = 0; ai < 2; ++ai)
#pragma unroll
            for (int bj = 0; bj < 2; ++bj)
#pragma unroll
                for (int m = 0; m < 4; ++m) t += acc[ai][bj][m][0] + acc[ai][bj][m][1];
        if (flag) O[threadIdx.x] = (t[0] + t[1]) + (t[2] + t[3]);
    }
};
template <int SAME> struct ProbeOrder { pg8::StaticOrder base;
    __device__ __forceinline__ bool next(int i, pg8::Unit& u) const { const bool ok = base.next(i, u); if (SAME & 1) u.pm = 0; if (SAME & 2) u.pn = 0; return ok; }
    __device__ __forceinline__ void a_ready(const pg8::Unit&) const {}
    __device__ __forceinline__ void done(const pg8::Unit&) const {} };
#ifndef P11_WGM
#define P11_WGM 8
#endif
#ifndef TUNE_ALIGN
#define TUNE_ALIGN true
#endif
#ifndef TUNE_SP2
#define TUNE_SP2 true
#endif
static_assert(sizeof(Args) == 22 * 8 + 16, "kernarg layout");
__global__ void __launch_bounds__(NWAVES * 64, 2) fwd(Args args) {
    extern __shared__ __attribute__((aligned(16))) unsigned char lds[];
    Frame F;
    F.lds = (LAS unsigned char*)lds;
    F.MISC = (volatile LAS unsigned*)(F.lds + MISC_OFF);
    F.tid = threadIdx.x; F.lane = F.tid & 63; F.wave = __builtin_amdgcn_readfirstlane(F.tid >> 6);
    F.G = gridDim.x; { const int bx = blockIdx.x; F.vcu = (F.G % 8 == 0) ? (bx % 8) * (F.G / 8) + bx / 8 : bx; }
    F.ctl = (gu32*)(args.ws + WS_CTL);
    for (int u = F.tid; u < (LDS_BYTES - LDSCTL_OFF) / 4; u += NWAVES * 64) ((LAS unsigned*)(F.lds + LDSCTL_OFF))[u] = 0u;
    __syncthreads();
    XcdBarrier bar; bar.bar = (unsigned*)(F.ctl + CW_BAR); bar.x = 0; bar.st = nullptr;
    if (N_LAUNCHES == 1) bar = xcd_barrier_post((unsigned*)(F.ctl + CW_BAR), F.MISC + 8);
#define GRID_BAR() do { if (N_LAUNCHES == 1) xcd_barrier(bar); } while (0)
    const int lo = args.ph_lo, hi = args.ph_hi;
#ifndef PH_MASK
#define PH_MASK 0x1fff
#endif
#define IN(k) (((PH_MASK >> (k)) & 1) && lo <= (k) && (k) < hi)
#define BOTH(k) (IN(k) && IN((k) + 1))
#ifndef REP2
#define REP2 0
#endif
#define NREP(k) (((REP2 >> (k)) & 1) ? 2 : 1)
    LAS unsigned char* ring = F.lds + RING_OFF;
    typedef const pg8::bf16_t* cbp;

    if (IN(0)) { p0a_prologue(F); GRID_BAR();
                 p1_norm1(F); __syncthreads(); p0_transpose_runs(F, CW_QUEUE, 0, P0_RUN_SPLIT);
                 if (BOTH(0)) GRID_BAR(); }
    if (IN(2)) { for (int rep = 0; rep < NREP(2); ++rep) {
        { pg8::Gemm g = pg8::gemm_rowmajor((cbp)F.H(), (cbp)F.Win(), M + MC, NT_IN16 * 256, D, D, D); InProjOrder<false> Sd; Sd.init(F.G, (int)blockIdx.x);
          EpiInProj<false> E{F.QO(), F.KA(), F.VA(), F.KB(), F.VB(), F.GA(), F.GB(), nullptr, 1.0f};
          pg8::gemm_phase<EpiInProj<false>, InProjOrder<false>, true, true, 0>(ring, g, Sd, E); }
        { pg8::Gemm g = pg8::gemm_rowmajor((cbp)F.ACT(), (cbp)((unsigned char*)F.Win() + WIN8_OFF), M + MC, NT_IN8 * 256, D / 2, D / 2, D / 2); InProjOrder<true> Sd; Sd.init(F.G, F.G - 1 - (int)blockIdx.x);
          EpiInProj<true> E{F.QO(), F.KA(), F.VA(), F.KB(), F.VB(), F.GA(), F.GB(), F.rsh(), __uint_as_float(__hip_atomic_load((unsigned*)(F.ctl + CW_WMAX), RLX_AGENT)) * (1.0f / 127.0f)};
          pg8::gemm_phase<EpiInProj<true>, InProjOrder<true>, true, true, INPROJ_MODE>(ring, g, Sd, E); }
        if (DEFER_UP_RUNS > 0) { __syncthreads(); p0_transpose_runs(F, CW_QUEUE3, P0_RUN_SPLIT, P0_RUN_DN0); }
        if (BOTH(2)) GRID_BAR();
    } }
    if (IN(3)) { p3_qkfix(F); if (BOTH(3)) GRID_BAR(); }
    if (IN(4)) { p4_attention(F); if (BOTH(4)) GRID_BAR(); }
    if (IN(5)) { for (int rep = 0; rep < NREP(5); ++rep) {
        pg8::Gemm g = BR_FP8 ? pg8::gemm_rowmajor((cbp)F.ACT(), (cbp)F.Wbr(), M, D, 2048, 2048, 2048) : pg8::gemm_rowmajor((cbp)F.QO(), (cbp)F.Wbr(), M, D, 4096, 4096, 4096);
        pg8::StaticOrder Sd; Sd.init(M, D, F.G, (int)blockIdx.x);
        EpiGateMerged E{F.H(), F.GA(), F.GB(), (unsigned char*)F.KB()};
        pg8::gemm_phase<EpiGateMerged, pg8::StaticOrder, true, true, BR_FP8 ? 1 : 0>(ring, g, Sd, E);
        if (BOTH(5)) GRID_BAR();
    } }
    if (IN(6) && WOUT_MODE == 2) { p6_quant_y(F); if (BOTH(6)) GRID_BAR(); }
    if (IN(7)) { for (int rep = 0; rep < NREP(7); ++rep) {
        pg8::StaticOrder Sd; Sd.init(M, D, F.G, (int)blockIdx.x);
        if constexpr (WOUT_MODE == 2) { pg8::Gemm g = pg8::gemm_rowmajor((cbp)F.KB(), (cbp)F.Wout(), M, D, D / 2, D / 2, D / 2);
            EpiResidI8 E{F.out(), F.x(), F.modf() + 2 * D, F.rsy(), __uint_as_float(__hip_atomic_load((unsigned*)(F.ctl + CW_WMAX2), RLX_AGENT)) * (1.0f / 127.0f), 0};
            pg8::gemm_phase<EpiResidI8, pg8::StaticOrder, true, true, 2>(ring, g, Sd, E); }
        else if constexpr (WOUT_FP8) { pg8::Gemm g = pg8::gemm_rowmajor((cbp)F.KB(), (cbp)F.Wout(), M, D, D / 2, D / 2, D / 2);
            EpiResid E{F.out(), F.x(), F.modf() + 2 * D, 1.0f / (SC_WOUT * SC_Y), 0};
            pg8::gemm_phase<EpiResid, pg8::StaticOrder, true, true, 1>(ring, g, Sd, E); }
        else { pg8::Gemm g = pg8::gemm_rowmajor((cbp)F.H(), (cbp)F.Wout(), M, D, D, D, D);
            EpiResid E{F.out(), F.x(), F.modf() + 2 * D, 1.0f, 0};
            pg8::gemm_phase<EpiResid, pg8::StaticOrder, true, true, 0>(ring, g, Sd, E); }
        if (BOTH(7)) GRID_BAR();
    } }
    if (IN(8)) { for (int rep = 0; rep < NREP(8); ++rep) { p7_norm2(F); if (BOTH(8)) GRID_BAR(); } }
#ifdef GEMM_PROBE
    if (IN(9)) { pg8::Gemm g = pg8::gemm_rowmajor((cbp)F.QO(), (cbp)F.Wup(), M, F2, D, D, D); ProbeOrder<GEMM_PROBE & 3> Sd; Sd.base.init(M, F2, F.G, (int)blockIdx.x);
        EpiNullProbe E{(float*)F.ACT(), args.pad, 0};
        pg8::gemm_phase<EpiNullProbe, ProbeOrder<GEMM_PROBE & 3>, true, true>(ring, g, Sd, E); GRID_BAR(); }
#endif
    if (IN(9)) { for (int rep = 0; rep < NREP(9); ++rep) {
        pg8::Gemm g = pg8::gemm_rowmajor((cbp)F.QO(), (cbp)F.Wup(), M, F2, D, D, D);
        pg8::StaticOrder Sd; Sd.init(M, F2, F.G, (int)blockIdx.x);
        EpiConvAct E{F.ACT(), (float*)F.Win(), F.conv_w(), F.conv_b(), (LAS f32x4*)(F.lds + XCH_OFF)};
        pg8::gemm_phase<EpiConvAct, pg8::StaticOrder, true, TUNE_SP2>(ring, g, Sd, E);
        __syncthreads(); p0_transpose_runs(F, CW_QUEUE4, P0_RUN_DN0, P0_RUN_END);
        if (BOTH(9)) GRID_BAR();
    } }
    if (IN(10)) { for (int rep = 0; rep < NREP(10); ++rep) { p10_convfix(F); if (BOTH(10)) GRID_BAR(); } }
    if (IN(11)) {
        pg8::Gemm g = pg8::gemm_rowmajor((cbp)F.ACT(), (cbp)F.Wdn(), M, D, DFF, DFF, DFF); pg8::StaticOrder Sd; Sd.init(M, D, F.G, (int)blockIdx.x, P11_WGM);
        EpiResid E{F.out(), F.out(), F.modf() + 5 * D, 1.0f, 0};
        pg8::gemm_phase<EpiResid, pg8::StaticOrder, TUNE_ALIGN, TUNE_SP2>(ring, g, Sd, E);
        if (BOTH(11)) GRID_BAR();
    }
    if (IN(12)) { p11_final(F); }
#undef IN
#undef BOTH
#undef GRID_BAR
}

extern "C" void kernel_launch(void* const* d_in, const int* in_sizes, int n_in, void* d_out, int out_size, void* d_ws, size_t ws_size, hipStream_t stream) {
    static int grid = 0;
    if (grid == 0) {
        if (n_in != 20 || in_sizes[0] != M * D || out_size != M * D || ws_size < WS_END) { fprintf(stderr, "kernel_launch: unexpected shapes (n_in %d, in0 %d, out %d, ws %zu < %zu?)\n", n_in, n_in > 0 ? in_sizes[0] : -1, out_size, ws_size, (size_t)WS_END); grid = -1; return; }
        int dev = 0, cus = 0, per_cu = 0;
        if (hipGetDevice(&dev) != hipSuccess || hipDeviceGetAttribute(&cus, hipDeviceAttributeMultiprocessorCount, dev) != hipSuccess) { grid = -1; return; }
        if (hipFuncSetAttribute((const void*)fwd, hipFuncAttributeMaxDynamicSharedMemorySize, LDS_BYTES) != hipSuccess) { fprintf(stderr, "kernel_launch: hipFuncSetAttribute failed\n"); grid = -1; return; }
        if (hipOccupancyMaxActiveBlocksPerMultiprocessor(&per_cu, (const void*)fwd, NWAVES * 64, LDS_BYTES) != hipSuccess || per_cu < 1) fprintf(stderr, "kernel_launch: occupancy query reports %d\n", per_cu);
        (void)hipGetLastError();
        grid = cus < 256 ? cus : 256;
    }
    if (grid < 0) return;
    if (hipMemsetAsync((char*)d_ws + WS_CTL, 0, CTL_ZERO_BYTES, stream) != hipSuccess) return;
    Args a{};
    for (int i = 0; i < 20; ++i) a.in[i] = (const float*)d_in[i];
    a.out = (float*)d_out; a.ws = (unsigned char*)d_ws;
    for (int li = 0; li < N_LAUNCHES; ++li) {
        if (N_LAUNCHES == 1) { a.ph_lo = 0; a.ph_hi = N_PHASES; } else { a.ph_lo = li; a.ph_hi = li + 1; }
        a.li = li;
        hipLaunchKernelGGL(fwd, dim3(grid), dim3(NWAVES * 64), LDS_BYTES, stream, a);
        const hipError_t le = hipPeekAtLastError();
        if (le != hipSuccess) { fprintf(stderr, "kernel_launch: launch %d failed: %s\n", li, hipGetErrorName(le)); break; }
    }
}
```

```cpp
#include <hip/hip_runtime.h>
#include <cstdio>
#include <cstdint>
namespace pg8 {
#define PG8_LAS __attribute__((address_space(3)))
typedef unsigned short bf16_t;
typedef short bf16x8 __attribute__((ext_vector_type(8)));
typedef float f32x4 __attribute__((ext_vector_type(4)));
typedef unsigned u32x4 __attribute__((ext_vector_type(4)));
typedef int i32x8 __attribute__((ext_vector_type(8)));
typedef short s16x16 __attribute__((ext_vector_type(16)));
template <bool FP8> struct Frag { bf16x8 h[2]; };
template <> struct Frag<true> { s16x16 v; };
__device__ __forceinline__ void fset(Frag<false>& f, int k, bf16x8 x) { f.h[k] = x; }
__device__ __forceinline__ void fset(Frag<true>& f, int k, bf16x8 x) { if (k == 0) f.v.lo = x; else f.v.hi = x; }
__device__ __forceinline__ f32x4 fmma(const Frag<false>& b, const Frag<false>& a, f32x4 c) { c = __builtin_amdgcn_mfma_f32_16x16x32_bf16(b.h[0], a.h[0], c, 0, 0, 0); return __builtin_amdgcn_mfma_f32_16x16x32_bf16(b.h[1], a.h[1], c, 0, 0, 0); }
typedef int i32x4 __attribute__((ext_vector_type(4)));
__device__ __forceinline__ f32x4 fmma_i8(const Frag<false>& b, const Frag<false>& a, f32x4 c) {
    i32x4 ci = __builtin_bit_cast(i32x4, c);
    ci = __builtin_amdgcn_mfma_i32_16x16x64_i8(__builtin_bit_cast(i32x4, b.h[0]), __builtin_bit_cast(i32x4, a.h[0]), ci, 0, 0, 0);
    ci = __builtin_amdgcn_mfma_i32_16x16x64_i8(__builtin_bit_cast(i32x4, b.h[1]), __builtin_bit_cast(i32x4, a.h[1]), ci, 0, 0, 0);
    return __builtin_bit_cast(f32x4, ci); }
__device__ __forceinline__ f32x4 fmma(const Frag<true>& b, const Frag<true>& a, f32x4 c) { const int one = 0x7F7F7F7F;
    asm volatile("v_mfma_scale_f32_16x16x128_f8f6f4 %0, %1, %2, %0, %3, %3 op_sel_hi:[0,0,0]" : "+v"(c) : "v"(__builtin_bit_cast(i32x8, b.v)), "v"(__builtin_bit_cast(i32x8, a.v)), "v"(one)); return c; }
constexpr int BM = 256, BK = 64, HALF = 128, HTB = HALF * BK * 2  , STAGE_BYTES = 8 * HTB, NXCD = 8, WGM = 8;

__host__ __device__ __forceinline__ int lds_byte(int r, int c) { const int st = (r >> 4) * 2 + (c >> 5), rr = r & 15, cc = c & 31, ob = rr * 64 + cc * 2; return st * 1024 + (ob ^ (((ob >> 9) & 1) << 5)); }
__host__ __device__ __forceinline__ void stage_rc(int b, int& R, int& C) { const int st = b / 1024, sb = b % 1024, swz = sb ^ (((sb >> 9) & 1) << 5); R = (st >> 1) * 16 + swz / 64; C = (st & 1) * 32 + (swz % 64) / 2; }
__host__ __device__ __forceinline__ int perm32(int rho) { const int n = rho >> 4, i = rho & 15; return 8 * (i >> 2) + 4 * n + (i & 3); }

struct Unit { int pm, pn; };
struct Gemm { const bf16_t* A; const bf16_t* Bt; int M, N, K, lda, ldb; unsigned ksA, ksB; size_t tsA, tsB; };
__host__ __device__ __forceinline__ Gemm gemm_rowmajor(const bf16_t* A, const bf16_t* Bt, int M, int N, int K, int lda, int ldb) { return Gemm{A, Bt, M, N, K, lda, ldb, 128u, 128u, (size_t)512 * lda, (size_t)512 * ldb}; }

struct StaticOrder {
    int nM, nN, nwg, G, c, wgm;
    __host__ __device__ void init(int M, int N, int G_, int c_, int wgm_ = WGM) { nM = M / BM; nN = N / BM; nwg = nM * nN; G = G_; c = c_; wgm = wgm_; }
    __host__ __device__ bool next(int i, Unit& u) const {
        const long L = (long)i * G + c; if (L >= nwg) return false;
        int wgid = (int)L; { const int q = nwg / NXCD, r = nwg % NXCD, xcd = wgid % NXCD, off = wgid / NXCD; wgid = (xcd < r ? xcd * (q + 1) : r * (q + 1) + (xcd - r) * q) + off; }
        const int nig = wgm * nN, gid = wgid / nig, fm = gid * wgm, gsz = (nM - fm) < wgm ? (nM - fm) : wgm;
        u.pm = fm + ((wgid % nig) % gsz); u.pn = (wgid % nig) / gsz; return true;
    }
    __device__ __forceinline__ void a_ready(const Unit&) const {}
    __device__ __forceinline__ void done(const Unit&) const {}
};

template <class Epi, class Sched, bool ALIGN_EPI = false, bool SP2 = false, int MODE = 0  >
__device__ __forceinline__ void gemm_phase(PG8_LAS unsigned char* lds, const Gemm g, const Sched& S, const Epi& E) {
    int tid_o = threadIdx.x; asm volatile("" : "+v"(tid_o));
    const int tid = tid_o, wid = __builtin_amdgcn_readfirstlane(tid >> 6), lane = tid & 63, wr = wid >> 2, wc = wid & 3, fr = lane & 15, fq = lane >> 4;
    const int K = g.K, nt = K / BK;
    unsigned voffA[2], voffB[2];
#pragma unroll
    for (int i = 0; i < 2; ++i) { int R, C; stage_rc(tid * 16 + i * 8192, R, C); const int Rb = Epi::PERM ? ((R & ~31) + perm32(R & 31)) : R;
        voffA[i] = (unsigned)(R * g.lda + C) * 2u; voffB[i] = (unsigned)(Rb * g.ldb + C) * 2u; }
    const size_t kstepA = g.ksA, kstepB = g.ksB;
    const size_t hstepA = (size_t)HALF * g.lda * 2, hstepB = (size_t)HALF * g.ldb * 2;
    const size_t tstepA = g.tsA, tstepB = g.tsB;
    const unsigned ldsw = (unsigned)wid * 1024u;
    const int aoff = lds_byte(wr * 64 + fr, fq * 8), boff = lds_byte(wc * 32 + fr, fq * 8);
#define PG8_SA(b, h) (((b) * 2 + (h)) * HTB)
#define PG8_SB(b, h) ((4 + (b) * 2 + (h)) * HTB)
#define PG8_STAGE(bufoff, gbase, voff) do { _Pragma("unroll") for (int _i = 0; _i < 2; ++_i) \
        __builtin_amdgcn_global_load_lds((const unsigned*)((const char*)(gbase) + (voff)[_i]), (PG8_LAS unsigned*)(lds + (bufoff) + ldsw + _i * 8192), 16, 0, 0); } while (0)
#define PG8_LDA(dst, b, h) do { _Pragma("unroll") for (int m = 0; m < 4; ++m) _Pragma("unroll") for (int k = 0; k < 2; ++k) fset(dst[m], k, *(const PG8_LAS bf16x8*)(lds + PG8_SA(b, h) + aoff + m * 2048 + k * 1024)); } while (0)
#define PG8_LDB(dst, b, h) do { _Pragma("unroll") for (int n = 0; n < 2; ++n) _Pragma("unroll") for (int k = 0; k < 2; ++k) fset(dst[n], k, *(const PG8_LAS bf16x8*)(lds + PG8_SB(b, h) + boff + n * 2048 + k * 1024)); } while (0)
#define PG8_MMA(ai, bj, At, Bt) do { __builtin_amdgcn_s_setprio(1); _Pragma("unroll") for (int m = 0; m < 4; ++m) _Pragma("unroll") for (int n = 0; n < 2; ++n) { if constexpr (MODE == 2) acc[ai][bj][m][n] = fmma_i8(Bt[n], At[m], acc[ai][bj][m][n]); else acc[ai][bj][m][n] = fmma(Bt[n], At[m], acc[ai][bj][m][n]); } __builtin_amdgcn_s_setprio(0); } while (0)
#define PG8_WAIT_V(n) asm volatile("s_waitcnt vmcnt(" #n ")" ::: "memory")
#define PG8_WAIT_L(n) asm volatile("s_waitcnt lgkmcnt(" #n ")" ::: "memory")
#define PG8_BAR __builtin_amdgcn_s_barrier()
#define PG8_SCHED __builtin_amdgcn_sched_barrier(0)
    Unit cur, nxt; int ui = 0;
    if (!S.next(0, cur)) return;
    f32x4 acc[2][2][4][2];
#pragma unroll
    for (int a = 0; a < 2; ++a)
#pragma unroll
        for (int b = 0; b < 2; ++b)
#pragma unroll
            for (int m = 0; m < 4; ++m)
#pragma unroll
                for (int n = 0; n < 2; ++n) acc[a][b][m][n] = (f32x4){0.f, 0.f, 0.f, 0.f};
    constexpr bool FP8 = (MODE == 1);
    Frag<FP8> At[4], B0[2], B1[2];
    const char* cA = (const char*)g.A + (size_t)cur.pm * tstepA; const char* cB = (const char*)g.Bt + (size_t)cur.pn * tstepB;
    S.a_ready(cur);
    if constexpr (SP2) {
        PG8_STAGE(PG8_SB(0, 0), cB, voffB); PG8_STAGE(PG8_SB(0, 1), cB + hstepB, voffB); PG8_STAGE(PG8_SA(0, 0), cA, voffA); PG8_STAGE(PG8_SA(0, 1), cA + hstepA, voffA);
        if (wr == 1) PG8_BAR;
        PG8_WAIT_V(2); PG8_BAR;
        PG8_STAGE(PG8_SB(1, 0), cB + kstepB, voffB); PG8_STAGE(PG8_SA(1, 0), cA + kstepA, voffA); PG8_STAGE(PG8_SB(1, 1), cB + hstepB + kstepB, voffB);
        PG8_WAIT_V(6); PG8_BAR;
    } else {
        PG8_STAGE(PG8_SB(0, 0), cB, voffB); PG8_STAGE(PG8_SA(0, 0), cA, voffA); PG8_STAGE(PG8_SB(0, 1), cB + hstepB, voffB); PG8_STAGE(PG8_SA(0, 1), cA + hstepA, voffA);
        if (wr == 1) PG8_BAR;
        PG8_WAIT_V(4); PG8_BAR;
        PG8_STAGE(PG8_SB(1, 0), cB + kstepB, voffB); PG8_STAGE(PG8_SA(1, 0), cA + kstepA, voffA); PG8_STAGE(PG8_SB(1, 1), cB + hstepB + kstepB, voffB);
        PG8_WAIT_V(6); PG8_BAR;
    }
    for (;;) {
        const bool has_next = S.next(ui + 1, nxt);
        const char* nA = has_next ? (const char*)g.A + (size_t)nxt.pm * tstepA : cA; const char* nB = has_next ? (const char*)g.Bt + (size_t)nxt.pn * tstepB : cB;
        constexpr int NPASS = Epi::MIDK ? 2 : 1;
#pragma unroll
        for (int hp = 0; hp < NPASS; ++hp) {
        const int t_lo = hp == 0 ? 0 : (nt >> 1), t_hi = (NPASS == 2 && hp == 0) ? (nt >> 1) : nt;
        if constexpr (Epi::MIDK) { if (hp == 1) { if constexpr (FP8) asm volatile("s_nop 15\n\ts_nop 15" ::: "memory"); E.mid(acc, cur, wr, wc, fr, fq); } }
        for (int t = t_lo; t < t_hi; t += 2) {
            const bool last = (t == nt - 2);
            const char* a1 = cA + (size_t)(t + 1) * kstepA;
            const char* a2 = last ? nA : cA + (size_t)(t + 2) * kstepA; const char* b2 = last ? nB : cB + (size_t)(t + 2) * kstepB;
            const char* a3 = a2 + kstepA; const char* b3 = b2 + kstepB;
            if (last && has_next) S.a_ready(nxt);
            if constexpr (SP2) {
            PG8_LDB(B0, 0, 0); PG8_LDB(B1, 0, 1); PG8_SCHED; PG8_LDA(At, 0, 0); PG8_STAGE(PG8_SA(1, 1), a1 + hstepA, voffA);
            PG8_WAIT_V(8); PG8_WAIT_L(0); PG8_BAR; PG8_MMA(0, 0, At, B0); PG8_MMA(0, 1, At, B1); PG8_BAR; PG8_SCHED;
            PG8_LDA(At, 0, 1); PG8_STAGE(PG8_SB(0, 0), b2, voffB); PG8_STAGE(PG8_SB(0, 1), b2 + hstepB, voffB); PG8_STAGE(PG8_SA(0, 0), a2, voffA);
            PG8_WAIT_V(8); PG8_WAIT_L(0); PG8_BAR; PG8_MMA(1, 0, At, B0); PG8_MMA(1, 1, At, B1); PG8_BAR; PG8_SCHED;
            PG8_LDB(B0, 1, 0); PG8_LDB(B1, 1, 1); PG8_SCHED; PG8_LDA(At, 1, 0); PG8_STAGE(PG8_SA(0, 1), a2 + hstepA, voffA);
            PG8_WAIT_V(8); PG8_WAIT_L(0); PG8_BAR; PG8_MMA(0, 0, At, B0); PG8_MMA(0, 1, At, B1); PG8_BAR; PG8_SCHED;
            PG8_LDA(At, 1, 1); PG8_STAGE(PG8_SB(1, 0), b3, voffB); PG8_STAGE(PG8_SB(1, 1), b3 + hstepB, voffB); PG8_STAGE(PG8_SA(1, 0), a3, voffA);
            PG8_WAIT_V(8); PG8_WAIT_L(0); PG8_BAR; PG8_MMA(1, 0, At, B0); PG8_MMA(1, 1, At, B1); PG8_BAR; PG8_SCHED;
            } else {
            PG8_LDB(B0, 0, 0); PG8_SCHED; PG8_LDA(At, 0, 0); PG8_STAGE(PG8_SA(1, 1), a1 + hstepA, voffA);
            PG8_WAIT_L(8); PG8_BAR; PG8_WAIT_L(0); PG8_MMA(0, 0, At, B0); PG8_BAR; PG8_SCHED;
            PG8_LDB(B1, 0, 1); PG8_STAGE(PG8_SB(0, 0), b2, voffB);
            PG8_BAR; PG8_WAIT_L(0); PG8_MMA(0, 1, At, B1); PG8_BAR;
            PG8_LDA(At, 0, 1); PG8_STAGE(PG8_SA(0, 0), a2, voffA);
            PG8_BAR; PG8_WAIT_L(0); PG8_MMA(1, 0, At, B0); PG8_BAR; PG8_SCHED;
            PG8_STAGE(PG8_SB(0, 1), b2 + hstepB, voffB);
            PG8_WAIT_V(6); PG8_BAR; PG8_MMA(1, 1, At, B1); PG8_BAR;
            PG8_LDB(B0, 1, 0); PG8_SCHED; PG8_LDA(At, 1, 0); PG8_STAGE(PG8_SA(0, 1), a2 + hstepA, voffA);
            PG8_WAIT_L(8); PG8_BAR; PG8_WAIT_L(0); PG8_MMA(0, 0, At, B0); PG8_BAR; PG8_SCHED;
            PG8_LDB(B1, 1, 1); PG8_STAGE(PG8_SB(1, 0), b3, voffB);
            PG8_BAR; PG8_WAIT_L(0); PG8_MMA(0, 1, At, B1); PG8_BAR;
            PG8_LDA(At, 1, 1); PG8_STAGE(PG8_SA(1, 0), a3, voffA);
            PG8_BAR; PG8_WAIT_L(0); PG8_MMA(1, 0, At, B0); PG8_BAR; PG8_SCHED;
            PG8_STAGE(PG8_SB(1, 1), b3 + hstepB, voffB);
            PG8_WAIT_V(6); PG8_BAR; PG8_MMA(1, 1, At, B1); PG8_BAR;
            }
        }
        }
        if constexpr (ALIGN_EPI) { if (wr == 0) PG8_BAR; }
        if constexpr (FP8) asm volatile("s_nop 15\n\ts_nop 15" ::: "memory");
        if constexpr (!Epi::AFTER_DRAIN) { E(acc, cur, wr, wc, fr, fq); S.done(cur); }
        if (!has_next) break;
#pragma unroll
        for (int a = 0; a < 2; ++a)
#pragma unroll
            for (int b = 0; b < 2; ++b)
#pragma unroll
                for (int m = 0; m < 4; ++m)
#pragma unroll
                    for (int n = 0; n < 2; ++n) acc[a][b][m][n] = (f32x4){0.f, 0.f, 0.f, 0.f};
        cur = nxt; cA = nA; cB = nB; ++ui;
        if constexpr (ALIGN_EPI) { if (wr == 1) PG8_BAR; }
    }
    PG8_WAIT_V(0);
    if constexpr (!ALIGN_EPI) { if (wr == 0) PG8_BAR; }
    PG8_BAR;
    if constexpr (Epi::AFTER_DRAIN) { E.fused(acc, cur, wr, wc, fr, fq, lds, wid, lane); S.done(cur); }
#undef PG8_SA
#undef PG8_SB
#undef PG8_STAGE
#undef PG8_LDA
#undef PG8_LDB
#undef PG8_MMA
#undef PG8_WAIT_V
#undef PG8_WAIT_L
#undef PG8_BAR
#undef PG8_SCHED
}
}

constexpr int D = 4096, NB = 4, S = 4096, L = 256, HD = 128, HA = 16, KVA = 4, HB = 16, GQ = HA / KVA;
constexpr int NIN = 17408, DFF = 11008, F2 = 2 * DFF, GW = 64, KT = L + S;
constexpr int M = NB * S, MC = NB * L;
constexpr int MODN = 6 * D, MOD_SPLIT = 8, MOD_KC = D / MOD_SPLIT, MOD_WAVES = 3;
constexpr float EPS = 1e-6f;
constexpr float SCALE = 0.088388347648318440f;
constexpr int NT_IN = NIN / 256;
constexpr float SC_WIN = 64.f, SC_WOUT = 64.f, SC_Y = 16.f;
#ifndef INPROJ_MODE_DEF
#define INPROJ_MODE_DEF 2
#endif
constexpr int INPROJ_MODE = INPROJ_MODE_DEF;
#ifndef TILED_B
#define TILED_B 1
#endif
#ifndef QFIX_ATT_DEF
#define QFIX_ATT_DEF 1
#endif
constexpr bool QFIX_ATT = QFIX_ATT_DEF;
#ifndef BR_FP8_DEF
#define BR_FP8_DEF 1
#endif
constexpr bool BR_FP8 = BR_FP8_DEF;
constexpr float SC_OA = 32.f, SC_OB = 16.f, SC_WBR = 32.f;
#ifndef WOUT_MODE_DEF
#define WOUT_MODE_DEF 2
#endif
constexpr int WOUT_MODE = WOUT_MODE_DEF;
constexpr bool WOUT_FP8 = (WOUT_MODE == 1);
constexpr bool V_FP8 = true;
constexpr int NT_IN16 = V_FP8 ? 0 : 10, NT_IN8 = V_FP8 ? 68 : 58;
__host__ __device__ constexpr bool inproj_is_fp8(int pn) { return V_FP8 || !(pn == 10 || pn == 11 || (pn >= 28 && pn < 36)); }
__host__ __device__ constexpr int inproj_local_tile(int pn) { return V_FP8 ? pn : (inproj_is_fp8(pn) ? (pn < 10 ? pn : (pn < 28 ? pn - 2 : pn - 10)) : (pn < 12 ? pn - 10 : pn - 26)); }
__host__ __device__ constexpr int inproj_global_tile(bool fp8, int t) { return V_FP8 ? t : (fp8 ? (t < 10 ? t : (t < 26 ? t + 2 : t + 10)) : (t < 2 ? 10 + t : 26 + t)); }
constexpr size_t WIN8_OFF = (size_t)NT_IN16 * 256 * D * 2;

constexpr size_t MiB = 1u << 20;
constexpr size_t WS_CTL = 0, CTL_ZERO_BYTES = 1 * MiB;
constexpr size_t WS_MODP = 266 * MiB;
constexpr size_t WS_MODF = 5 * MiB;
constexpr size_t WS_ROPE = 6 * MiB;
constexpr size_t WS_RSH = 7 * MiB;
constexpr size_t WS_RSY = 7 * MiB + 256 * 1024;
constexpr size_t WS_WUP = 8 * MiB;
constexpr size_t WS_WDN = 180 * MiB;
constexpr size_t WS_QO = 266 * MiB;
constexpr size_t WS_WIN = 394 * MiB;
constexpr size_t WS_WBR = 530 * MiB;
constexpr size_t WS_WOUT = 562 * MiB;
constexpr size_t WS_H = 594 * MiB;
constexpr size_t WS_KA = 730 * MiB;
constexpr size_t WS_VA = 747 * MiB;
constexpr size_t WS_KB = 764 * MiB;
constexpr size_t WS_VB = 832 * MiB;
constexpr size_t WS_GA = 900 * MiB;
constexpr size_t WS_GB = 1028 * MiB;
constexpr size_t WS_U = 394 * MiB;
constexpr size_t WS_ACT = 1156 * MiB;
constexpr size_t WS_END = 1500 * MiB;
static_assert(WS_U + (size_t)M * F2 * 2 <= WS_ACT && WS_GB + (size_t)M * D * 2 <= WS_ACT && WS_ACT + (size_t)M * DFF * 2 <= WS_END, "d_ws map");
static_assert(WS_WUP + (size_t)F2 * D * 2 <= WS_WDN && WS_WDN + (size_t)D * DFF * 2 <= WS_QO && WS_QO + (size_t)M * 4096 * 2 <= WS_WIN && WS_WIN + (size_t)NIN * D * 2 <= WS_WBR, "d_ws map 2");
static_assert(WS_H + (size_t)(M + MC) * D * 2 <= WS_KA && WS_KA + (size_t)NB * KT * 512 * 2 <= WS_VA && WS_VA + (size_t)NB * KT * 512 * 2 <= WS_KB && WS_KB + (size_t)NB * KT * 2048 * 2 <= WS_VB && WS_VB + (size_t)NB * KT * 2048 * 2 <= WS_GA, "d_ws map 3");
constexpr int CW_BAR = 4096;
constexpr int CW_QUEUE = 8192;
constexpr int CW_QUEUE3 = 8448, CW_QUEUE4 = 8512;
constexpr int CW_TMAX = 8576, CW_TMAX2 = 8640, CW_QUEUE5 = 8704;
constexpr int CW_QUEUE2 = 8256, CW_WMAX = 8320, CW_WMAX2 = 8384;

constexpr int RING_OFF = 0, RING_BYTES = 131072;
constexpr int LDSCTL_OFF = RING_BYTES, MISC_OFF = LDSCTL_OFF + 320;
constexpr int LDS_BYTES = 147456;
constexpr int NWAVES = 8;

#ifndef MK_N_LAUNCHES
#define MK_N_LAUNCHES 1
#endif
constexpr int N_PHASES = 13;
constexpr int N_LAUNCHES = MK_N_LAUNCHES;

#define GAS __attribute__((address_space(1)))
#define LAS __attribute__((address_space(3)))
typedef unsigned short bf16;
typedef unsigned v4u __attribute__((ext_vector_type(4)));
typedef unsigned v2u __attribute__((ext_vector_type(2)));
typedef float f32x4 __attribute__((ext_vector_type(4)));
typedef float f32x2 __attribute__((ext_vector_type(2)));
typedef GAS unsigned gu32;
#define RLX_AGENT __ATOMIC_RELAXED, __HIP_MEMORY_SCOPE_AGENT
#define LDS_WAIT() asm volatile("s_waitcnt lgkmcnt(0)" ::: "memory")
#define VM_WAIT() asm volatile("s_waitcnt vmcnt(0)" ::: "memory")
__device__ __forceinline__ unsigned pk2(float lo, float hi) { unsigned r; asm volatile("v_cvt_pk_bf16_f32 %0, %1, %2" : "=v"(r) : "v"(lo), "v"(hi)); return r; }
__device__ __forceinline__ unsigned pk4_fp8(float a, float b, float c, float d) { int w = 0; w = __builtin_amdgcn_cvt_pk_fp8_f32(a, b, w, false); w = __builtin_amdgcn_cvt_pk_fp8_f32(c, d, w, true); return (unsigned)w; }
__device__ __forceinline__ unsigned pk4_i8(float a, float b, float c, float d) {
    const int q0 = __float2int_rn(a), q1 = __float2int_rn(b), q2 = __float2int_rn(c), q3 = __float2int_rn(d);
    return (unsigned)(q0 & 255) | ((unsigned)(q1 & 255) << 8) | ((unsigned)(q2 & 255) << 16) | ((unsigned)q3 << 24); }
__device__ __forceinline__ unsigned pk4_u8(float a, float b, float c, float d) {
    const int q0 = __float2int_rn(a), q1 = __float2int_rn(b), q2 = __float2int_rn(c), q3 = __float2int_rn(d);
    return (unsigned)q0 | ((unsigned)q1 << 8) | ((unsigned)q2 << 16) | ((unsigned)q3 << 24); }
__device__ __forceinline__ float ub(unsigned w, int e) { return (float)((w >> (8 * e)) & 255u); }
__device__ __forceinline__ float bf_lo(unsigned w) { return __uint_as_float(w << 16); }
__device__ __forceinline__ float bf_hi(unsigned w) { return __uint_as_float(w & 0xffff0000u); }
__device__ __forceinline__ float sigmoid_f(float x) { return __builtin_amdgcn_rcpf(1.0f + __expf(-x)); }
__device__ __forceinline__ float wave_sum(float v) {
#pragma unroll
    for (int o = 1; o < 64; o <<= 1) v += __shfl_xor(v, o);
    return v;
}

#define XB_TMO      128
#define XB_XCNT(j)  (256  + 64 * (j))
#define XB_XSUB(j)  (1280 + 64 * (j))
#define XB_XGEN(j)  (2304 + 64 * (j))
#define XB_TOP      3328
#define XB_TOPGEN   3392
#define XCD_BAR_WORDS 3456
#define XB_SPIN_CAP (1u << 18)
__device__ __forceinline__ unsigned xb_ld(unsigned* p)              { return __hip_atomic_load(p, __ATOMIC_RELAXED, __HIP_MEMORY_SCOPE_AGENT); }
__device__ __forceinline__ unsigned xb_add(unsigned* p, unsigned v) { return __hip_atomic_fetch_add(p, v, __ATOMIC_RELAXED, __HIP_MEMORY_SCOPE_AGENT); }
__device__ __forceinline__ unsigned xb_xcc_id() { return (unsigned)__builtin_amdgcn_s_getreg((3 << 11) | 20) & 0xFu; }
#define XB_SPIN(cond, bar) do { unsigned _sp = 0; while (cond) { __builtin_amdgcn_s_sleep(1); \
    if ((++_sp & 255u) == 0u) { if (xb_ld(&(bar)[XB_TMO])) break; if (_sp > XB_SPIN_CAP) { atomicAdd(&(bar)[XB_TMO], 1u); break; } } } } while (0)
struct XcdBarrier { unsigned* bar; unsigned x; volatile LAS unsigned* st; };
__device__ __forceinline__ XcdBarrier xcd_barrier_post(unsigned* bar, volatile LAS unsigned* st) {
    XcdBarrier b; b.bar = bar; b.x = xb_xcc_id(); b.st = st;
    if (threadIdx.x == 0) (void)xb_add(&bar[XB_XCNT(b.x)], 1u);
    return b;
}
__device__ __forceinline__ void xcd_barrier_complete(unsigned* bar, unsigned x, unsigned& nloc, unsigned& nx) {
    const unsigned G = gridDim.x * gridDim.y * gridDim.z;
    unsigned sum, cnt, mine, sp = 0u;
    for (;;) {
        sum = 0u; cnt = 0u; mine = 0u;
#pragma unroll
        for (unsigned j = 0; j < 16; ++j) { const unsigned c = xb_ld(&bar[XB_XCNT(j)]); sum += c; cnt += (c > 0u) ? 1u : 0u; mine = (j == x) ? c : mine; }
        if (sum == G) break;
        __builtin_amdgcn_s_sleep(1);
        if ((++sp & 255u) == 0u) { if (xb_ld(&bar[XB_TMO])) break; if (sp > XB_SPIN_CAP) { atomicAdd(&bar[XB_TMO], 1u); break; } }
    }
    nloc = mine > 0u ? mine : 1u; nx = cnt > 0u ? cnt : 1u;
}
__device__ __forceinline__ void xcd_barrier(const XcdBarrier& b) {
    asm volatile("s_waitcnt vmcnt(0)" ::: "memory");
    __syncthreads();
    if (threadIdx.x == 0) {
        unsigned* bar = b.bar;
        __builtin_amdgcn_s_waitcnt(0);
        unsigned nloc = b.st[0], nx = b.st[1];
        if (nloc == 0u) { xcd_barrier_complete(bar, b.x, nloc, nx); b.st[0] = nloc; b.st[1] = nx; }
        const unsigned old = xb_add(&bar[XB_XSUB(b.x)], 1u);
        const unsigned gen = old / nloc;
        if (old + 1u == (gen + 1u) * nloc) {
            __builtin_amdgcn_fence(__ATOMIC_RELEASE, "agent");
            asm volatile("s_waitcnt vmcnt(0)" ::: "memory");
            const unsigned og = xb_add(&bar[XB_TOP], 1u);
            const unsigned tg = og / nx;
            if (og + 1u == (tg + 1u) * nx) xb_add(&bar[XB_TOPGEN], 1u);
            else XB_SPIN(xb_ld(&bar[XB_TOPGEN]) == tg, bar);
            __builtin_amdgcn_fence(__ATOMIC_ACQUIRE, "agent");
            xb_add(&bar[XB_XGEN(b.x)], 1u);
            asm volatile("s_waitcnt vmcnt(0)" ::: "memory");
        } else {
            XB_SPIN(xb_ld(&bar[XB_XGEN(b.x)]) == gen, bar);
            __builtin_amdgcn_fence(__ATOMIC_ACQUIRE, "agent");
            asm volatile("s_waitcnt vmcnt(0)" ::: "memory");
        }
    }
    __syncthreads();
}

struct Args { const float* in[20]; float* out; unsigned char* ws; int ph_lo, ph_hi, li, pad; };
__device__ __forceinline__ const float* karg_in(int i) { return *(const float* const volatile __attribute__((address_space(4)))*)((const __attribute__((address_space(4))) char*)__builtin_amdgcn_kernarg_segment_ptr() + 8 * i); }
__device__ __forceinline__ unsigned char* karg_ws() { return (unsigned char*)karg_in(21); }
struct Frame {
    LAS unsigned char* lds;
    volatile LAS unsigned* MISC;
    gu32* ctl;
    int tid, lane, wave;
    int vcu, G;
#define KIN(name, i) __device__ __forceinline__ const float* name() const { return karg_in(i); }
    KIN(x, 0) KIN(c, 1) KIN(ctx, 2) KIN(cctx, 3) KIN(ada_w, 4) KIN(ada_b, 5) KIN(norm1_g, 6) KIN(w_in, 7) KIN(qnorm, 8) KIN(knorm, 9) KIN(rpb, 10) KIN(w_br_a, 11) KIN(w_br_b, 12) KIN(w_out, 13)
    KIN(norm2_g, 14) KIN(w_up, 15) KIN(conv_w, 16) KIN(conv_b, 17) KIN(w_down, 18) KIN(final_g, 19)
#undef KIN
    __device__ __forceinline__ float* out() const { return (float*)karg_in(20); }
#define KWS(T, name, off) __device__ __forceinline__ T* name() const { return (T*)(karg_ws() + (off)); }
    KWS(float, modp, WS_MODP) KWS(float, modf, WS_MODF) KWS(float2, rope, WS_ROPE) KWS(float, rsh, WS_RSH) KWS(float, rsy, WS_RSY)
    KWS(bf16, Wup, WS_WUP) KWS(bf16, Wdn, WS_WDN) KWS(bf16, QO, WS_QO) KWS(bf16, Win, WS_WIN) KWS(bf16, Wbr, WS_WBR) KWS(bf16, Wout, WS_WOUT) KWS(bf16, H, WS_H)
    KWS(bf16, KA, WS_KA) KWS(bf16, VA, WS_VA) KWS(bf16, KB, WS_KB) KWS(bf16, VB, WS_VB) KWS(bf16, GA, WS_GA) KWS(bf16, GB, WS_GB) KWS(bf16, U, WS_U) KWS(bf16, ACT, WS_ACT)
#undef KWS
};

__device__ __forceinline__ void p0_mod_item(Frame& F, LAS float* sv, int item) {
    const int kc = item / (MODN / 256), nb = item % (MODN / 256), k0 = kc * MOD_KC;
    const float* cc = F.c(); const float* cx = F.cctx();
    for (int i = F.lane; i < 5 * MOD_KC; i += 64) { const int r = i / MOD_KC, k = i % MOD_KC; const float v = (r < 4) ? cc[r * D + k0 + k] : cx[k0 + k]; sv[i] = v * sigmoid_f(v); }
    LDS_WAIT(); asm volatile("" ::: "memory");
    f32x4 a0 = {0.f, 0.f, 0.f, 0.f}, a1 = a0, a2 = a0, a3 = a0, a4 = a0;
    const GAS f32x4* wp = (const GAS f32x4*)(F.ada_w() + (size_t)k0 * MODN + 256 * nb) + F.lane;
#pragma unroll 16
    for (int k = 0; k < MOD_KC; ++k) { const f32x4 w = wp[(size_t)k * (MODN / 4)];
        a0 += sv[k] * w; a1 += sv[MOD_KC + k] * w; a2 += sv[2 * MOD_KC + k] * w; a3 += sv[3 * MOD_KC + k] * w; a4 += sv[4 * MOD_KC + k] * w; }
    GAS f32x4* o = (GAS f32x4*)(F.modp() + (size_t)kc * 5 * MODN + 256 * nb) + F.lane;
    o[0] = a0; o[MODN / 4] = a1; o[2 * (MODN / 4)] = a2; o[3 * (MODN / 4)] = a3; o[4 * (MODN / 4)] = a4;
    LDS_WAIT(); asm volatile("" ::: "memory");
}
struct TItem { const float* src; unsigned char* dst; int N, ldT, fp8; float scale; };
constexpr int P0_NBW = 8, P0_KBL = 16;
constexpr int P0_BLK_IN = (D / 64 / P0_KBL) * (NIN / 32 / P0_NBW), P0_BLK_BR = (2048 / 64 / P0_KBL) * (D / 32 / P0_NBW), P0_BLK_OUT = (D / 64 / P0_KBL) * (D / 32 / P0_NBW), P0_BLK_UP = (D / 64 / P0_KBL) * (F2 / 32 / P0_NBW), P0_BLK_DN = ((DFF / 64 + P0_KBL - 1) / P0_KBL) * (D / 32 / P0_NBW);
static_assert((NIN / 32) % P0_NBW == 0 && (F2 / 32) % P0_NBW == 0 && (D / 32) % P0_NBW == 0 && (2048 / 64) % P0_KBL == 0, "P0 block shape");
constexpr int P0_NBLK = P0_BLK_IN + 2 * P0_BLK_BR + P0_BLK_OUT + P0_BLK_UP + P0_BLK_DN;
struct TRun { int mat, kb0, nb; };
__device__ __forceinline__ void p0_run_of(int blk, int slot, TRun& r) {
    int nbg_per;
    if (blk < P0_BLK_IN) { r.mat = 0; nbg_per = NIN / 32 / P0_NBW; }
    else if ((blk -= P0_BLK_IN) < P0_BLK_BR) { r.mat = 1; nbg_per = D / 32 / P0_NBW; }
    else if ((blk -= P0_BLK_BR) < P0_BLK_BR) { r.mat = 2; nbg_per = D / 32 / P0_NBW; }
    else if ((blk -= P0_BLK_BR) < P0_BLK_OUT) { r.mat = 3; nbg_per = D / 32 / P0_NBW; }
    else if ((blk -= P0_BLK_OUT) < P0_BLK_UP) { r.mat = 4; nbg_per = F2 / 32 / P0_NBW; }
    else { blk -= P0_BLK_UP; r.mat = 5; nbg_per = D / 32 / P0_NBW; }
    r.kb0 = (blk / nbg_per) * P0_KBL; r.nb = (blk % nbg_per) * P0_NBW + slot;
}
__device__ __forceinline__ bool p0_decode(Frame& F, int mat, int kb, int nb, TItem& t, float win_qscale, float wout_qscale) {
    t.fp8 = 0; t.scale = 1.0f;
    if (mat == 0) { const int pn = nb >> 3, nbd = inproj_local_tile(pn) * 8 + (nb & 7);
        t.src = F.w_in() + (size_t)(64 * kb) * NIN + 32 * nb; t.N = NIN;
        if (inproj_is_fp8(pn)) { t.dst = (unsigned char*)F.Win() + WIN8_OFF + (size_t)(32 * nbd) * D + 64 * kb; t.ldT = D; t.fp8 = INPROJ_MODE; t.scale = INPROJ_MODE == 2 ? win_qscale : SC_WIN; }
        else { t.dst = (unsigned char*)F.Win() + ((size_t)(32 * nbd) * D + 64 * kb) * 2; t.ldT = 2 * D; }
        return true; }
    if (mat == 1 || mat == 2) { const int second = mat - 1;
        t.src = (second ? F.w_br_b() : F.w_br_a()) + (size_t)(64 * kb) * D + 32 * nb; t.N = D;
        if (BR_FP8) { t.dst = (unsigned char*)F.Wbr() + (size_t)(32 * nb) * 4096 + second * 2048 + 64 * kb; t.ldT = 4096; t.fp8 = 1; t.scale = SC_WBR; }
        else { t.dst = (unsigned char*)F.Wbr() + ((size_t)(32 * nb) * 4096 + second * 2048 + 64 * kb) * 2; t.ldT = 2 * 4096; }
        return true; }
    if (mat == 3) { t.src = F.w_out() + (size_t)(64 * kb) * D + 32 * nb; t.N = D;
        if (WOUT_MODE) { t.dst = (unsigned char*)F.Wout() + (size_t)(32 * nb) * D + 64 * kb; t.ldT = D; t.fp8 = WOUT_MODE; t.scale = WOUT_MODE == 2 ? wout_qscale : SC_WOUT; }
        else { t.dst = (unsigned char*)F.Wout() + ((size_t)(32 * nb) * D + 64 * kb) * 2; t.ldT = 2 * D; }
        return true; }
    if (mat == 4) { const int fb = nb < DFF / 32 ? nb : nb - DFF / 32, nbd = (fb >> 2) * 8 + (nb < DFF / 32 ? 0 : 4) + (fb & 3);
        t.src = F.w_up() + (size_t)(64 * kb) * F2 + 32 * nb; t.N = F2; t.dst = (unsigned char*)F.Wup() + ((size_t)(32 * nbd) * D + 64 * kb) * 2; t.ldT = 2 * D; return true; }
    if (kb >= DFF / 64) return false;
    t.src = F.w_down() + (size_t)(64 * kb) * D + 32 * nb; t.N = D; t.dst = (unsigned char*)F.Wdn() + ((size_t)(32 * nb) * DFF + 64 * kb) * 2; t.ldT = 2 * DFF; return true;
}
__device__ __forceinline__ void p0_load(const TItem& t, float (&v)[32], int lane) {
    const float* p = t.src + (size_t)(lane >> 5) * t.N + (lane & 31);
#pragma unroll
    for (int i = 0; i < 32; ++i) v[i] = p[(size_t)(2 * i) * t.N];
}
#ifndef WQ_MARGIN
#define WQ_MARGIN 1.3f
#endif
constexpr int WQ_SAMPLE = 8;
__device__ __forceinline__ float wq_clip(Frame& F, int k) { return WQ_MARGIN * __uint_as_float(__hip_atomic_load((unsigned*)(F.ctl + (k ? CW_WMAX2 : CW_WMAX)), RLX_AGENT)); }
__device__ __forceinline__ float wq_true(Frame& F, int k) { return __uint_as_float(__hip_atomic_load((unsigned*)(F.ctl + (k ? CW_TMAX2 : CW_TMAX)), RLX_AGENT)); }
__device__ __forceinline__ float wq_range(Frame& F, int k) { const float c = wq_clip(F, k), t = wq_true(F, k); return t > c ? t : c; }
__device__ __forceinline__ void p0a_prologue(Frame& F) {
    LAS float* scr = (LAS float*)(F.lds + RING_OFF + F.wave * 16384);
    { const int gt = F.vcu * (NWAVES * 64) + F.tid; if (gt < 64 * 32) { const int pos = gt >> 5, i = gt & 31; const float fr = powf(10000.0f, -(float)i / 32.0f), a = (float)pos * fr; F.rope()[gt] = make_float2(cosf(a), sinf(a)); } }
    if (F.wave < MOD_WAVES) { for (int item = F.vcu * MOD_WAVES + F.wave; item < MOD_SPLIT * (MODN / 256); item += MOD_WAVES * F.G) p0_mod_item(F, scr, item); }
    if (INPROJ_MODE == 2 || WOUT_MODE == 2) {
        constexpr int NCH1 = INPROJ_MODE == 2 ? (int)((size_t)D * NIN / 16384 / WQ_SAMPLE) : 0, NCH2 = WOUT_MODE == 2 ? (int)((size_t)D * D / 16384 / WQ_SAMPLE) : 0;
        const GAS f32x4* w1 = (const GAS f32x4*)F.w_in(); const GAS f32x4* w2 = (const GAS f32x4*)F.w_out(); float m1 = 0.f, m2 = 0.f;
        for (;;) {
            int ch = 0; if (F.lane == 0) ch = (int)__hip_atomic_fetch_add((unsigned*)(F.ctl + CW_QUEUE2), 1u, RLX_AGENT);
            ch = __builtin_amdgcn_readfirstlane(ch);
            if (ch >= NCH1 + NCH2) break;
            const bool second = ch >= NCH1; const GAS f32x4* p = (second ? w2 + (size_t)(ch - NCH1) * (4096 * WQ_SAMPLE) : w1 + (size_t)ch * (4096 * WQ_SAMPLE)) + F.lane; f32x4 v[8]; float m = 0.f;
#pragma unroll
            for (int h = 0; h < 8; ++h) {
#pragma unroll
                for (int i = 0; i < 8; ++i) v[i] = p[(h * 8 + i) * 64];
#pragma unroll
                for (int i = 0; i < 8; ++i) m = fmaxf(m, fmaxf(fmaxf(fabsf(v[i].x), fabsf(v[i].y)), fmaxf(fabsf(v[i].z), fabsf(v[i].w)))); }
            if (second) m2 = fmaxf(m2, m); else m1 = fmaxf(m1, m);
        }
#pragma unroll
        for (int o = 1; o < 64; o <<= 1) { m1 = fmaxf(m1, __shfl_xor(m1, o)); m2 = fmaxf(m2, __shfl_xor(m2, o)); }
        if (F.lane == 0) { if (NCH1) __hip_atomic_fetch_max((unsigned*)(F.ctl + CW_WMAX), __float_as_uint(m1), RLX_AGENT);
                           if (NCH2) __hip_atomic_fetch_max((unsigned*)(F.ctl + CW_WMAX2), __float_as_uint(m2), RLX_AGENT); }
    }
}
#ifndef DEFER_UP_RUNS
#define DEFER_UP_RUNS 1024
#endif
constexpr int P0_RUN_UP0 = (P0_BLK_IN + 2 * P0_BLK_BR + P0_BLK_OUT) * P0_NBW, P0_RUN_DN0 = P0_RUN_UP0 + P0_BLK_UP * P0_NBW, P0_RUN_END = P0_NBLK * P0_NBW, P0_RUN_SPLIT = P0_RUN_DN0 - DEFER_UP_RUNS;
static_assert(DEFER_UP_RUNS >= 0 && DEFER_UP_RUNS <= P0_BLK_UP * P0_NBW, "deferred w_up runs");
constexpr int P0_RUN_IN1 = P0_BLK_IN * P0_NBW, P0_RUN_OUT0 = (P0_BLK_IN + 2 * P0_BLK_BR) * P0_NBW;
__device__ __forceinline__ void p0_transpose_runs(Frame& F, int qw, int run_lo, int run_hi, bool exact = false, int skip_lo = 0, int skip_hi = 0) {
    LAS float* scr = (LAS float*)(F.lds + RING_OFF + F.wave * 16384);
    const float win_qscale = INPROJ_MODE == 2 ? 127.0f / fmaxf(exact ? wq_range(F, 0) : wq_clip(F, 0), 1e-30f) : 1.0f;
    const float wout_qscale = WOUT_MODE == 2 ? 127.0f / fmaxf(exact ? wq_range(F, 1) : wq_clip(F, 1), 1e-30f) : 1.0f;
    float tm1 = 0.f, tm2 = 0.f;
    int lane = F.lane; asm volatile("" : "+v"(lane));
    const int c = lane & 7;
    for (;;) {
        int run = 0; if (lane == 0) run = (int)__hip_atomic_fetch_add((unsigned*)(F.ctl + qw), 1u, RLX_AGENT);
        run = run_lo + __builtin_amdgcn_readfirstlane(run);
        if (run >= run_hi) break;
        if (run >= skip_lo && run < skip_hi) continue;
        TRun R; p0_run_of(run / P0_NBW, run % P0_NBW, R);
        TItem cur, nxt; float v[32]; float tm = 0.f;
        bool have = p0_decode(F, R.mat, R.kb0, R.nb, cur, win_qscale, wout_qscale); if (have) p0_load(cur, v, lane);
        for (int j = 0; j < P0_KBL; ++j) {
            if (have) {
#pragma unroll
                for (int i = 0; i < 32; ++i) { scr[(2 * i + (lane >> 5)) * 33 + (lane & 31)] = v[i] * cur.scale; tm = fmaxf(tm, fabsf(v[i])); }
                LDS_WAIT(); asm volatile("" ::: "memory"); }
            nxt = cur; const bool more = (j + 1 < P0_KBL) && p0_decode(F, R.mat, R.kb0 + j + 1, R.nb, nxt, win_qscale, wout_qscale);
            if (more) p0_load(nxt, v, lane);
            if (have) {
#pragma unroll
                for (int q = 0; q < 4; ++q) { const int n = (lane >> 3) + 8 * q; const LAS float* sp = scr + (8 * c) * 33 + n;
                    if (cur.fp8 == 2) { v2u o; o.x = pk4_i8(sp[0 * 33], sp[1 * 33], sp[2 * 33], sp[3 * 33]); o.y = pk4_i8(sp[4 * 33], sp[5 * 33], sp[6 * 33], sp[7 * 33]); *(GAS v2u*)(cur.dst + (size_t)n * cur.ldT + 8 * c) = o; }
                    else if (cur.fp8) { v2u o; o.x = pk4_fp8(sp[0 * 33], sp[1 * 33], sp[2 * 33], sp[3 * 33]); o.y = pk4_fp8(sp[4 * 33], sp[5 * 33], sp[6 * 33], sp[7 * 33]); *(GAS v2u*)(cur.dst + (size_t)n * cur.ldT + 8 * c) = o; }
                    else { v4u o; o.x = pk2(sp[0 * 33], sp[1 * 33]); o.y = pk2(sp[2 * 33], sp[3 * 33]); o.z = pk2(sp[4 * 33], sp[5 * 33]); o.w = pk2(sp[6 * 33], sp[7 * 33]); *(GAS v4u*)(cur.dst + (size_t)n * cur.ldT + 16 * c) = o; } }
                LDS_WAIT(); asm volatile("" ::: "memory"); }
            cur = nxt; have = more;
        }
        if (R.mat == 0) tm1 = fmaxf(tm1, tm); else if (R.mat == 3) tm2 = fmaxf(tm2, tm);
    }
    if ((INPROJ_MODE == 2 || WOUT_MODE == 2) && run_lo < P0_RUN_UP0) {
#pragma unroll
        for (int o = 1; o < 64; o <<= 1) { tm1 = fmaxf(tm1, __shfl_xor(tm1, o)); tm2 = fmaxf(tm2, __shfl_xor(tm2, o)); }
        if (lane == 0) { if (INPROJ_MODE == 2 && tm1 > 0.f) __hip_atomic_fetch_max((unsigned*)(F.ctl + CW_TMAX), __float_as_uint(tm1), RLX_AGENT);
                         if (WOUT_MODE == 2 && tm2 > 0.f) __hip_atomic_fetch_max((unsigned*)(F.ctl + CW_TMAX2), __float_as_uint(tm2), RLX_AGENT); }
    }
}

template <int OUT_MODE  , bool HAS_B>
__device__ __forceinline__ void norm_row(const float* xrow, void* orow, const LAS float* A, const LAS float* B, int lane, void* orow8 = nullptr, float* rs = nullptr) {
    const GAS f32x4* xr = (const GAS f32x4*)xrow + lane;
    f32x4 v[16]; float s = 0.f;
#pragma unroll
    for (int j = 0; j < 16; ++j) { v[j] = xr[64 * j]; s += (v[j].x * v[j].x + v[j].y * v[j].y) + (v[j].z * v[j].z + v[j].w * v[j].w); }
    const float rstd = 1.0f / sqrtf(wave_sum(s) * (1.0f / D) + EPS);
#pragma unroll
    for (int j = 0; j < 16; ++j) {
        const f32x4 a = ((const LAS f32x4*)A)[lane + 64 * j]; f32x4 o = v[j] * rstd * a;
        if (HAS_B) o += ((const LAS f32x4*)B)[lane + 64 * j];
        if (OUT_MODE == 4) { v[j] = o; continue; }
        if (OUT_MODE == 1 || OUT_MODE == 3) { v2u w; w.x = pk2(o.x, o.y); w.y = pk2(o.z, o.w); ((GAS v2u*)orow)[lane + 64 * j] = w; if (OUT_MODE == 3) ((GAS unsigned*)orow8)[lane + 64 * j] = pk4_fp8(o.x, o.y, o.z, o.w); }
        else if (OUT_MODE == 2) ((GAS unsigned*)orow)[lane + 64 * j] = pk4_fp8(o.x, o.y, o.z, o.w);
        else ((GAS f32x4*)orow)[lane + 64 * j] = o;
    }
    if (OUT_MODE == 4) {
        float m = 0.f;
#pragma unroll
        for (int j = 0; j < 16; ++j) m = fmaxf(m, fmaxf(fmaxf(fabsf(v[j].x), fabsf(v[j].y)), fmaxf(fabsf(v[j].z), fabsf(v[j].w))));
#pragma unroll
        for (int o = 1; o < 64; o <<= 1) m = fmaxf(m, __shfl_xor(m, o));
        const float inv = m > 0.f ? 127.0f / m : 0.f;
#pragma unroll
        for (int j = 0; j < 16; ++j) ((GAS unsigned*)orow)[lane + 64 * j] = pk4_i8(v[j].x * inv, v[j].y * inv, v[j].z * inv, v[j].w * inv);
        if (lane == 0) *rs = m * (1.0f / 127.0f);
    }
}
__device__ __forceinline__ float mod_sum(const float* ada_b, const float* modp, int r, int n) {
    float s = ada_b[n];
#pragma unroll
    for (int kc = 0; kc < MOD_SPLIT; ++kc) s += modp[(size_t)(kc * 5 + r) * MODN + n];
    return s;
}
__device__ __forceinline__ void p1_norm1(Frame& F) {
    LAS float* Al = (LAS float*)(F.lds + RING_OFF); LAS float* Bl = Al + D; LAS float* Ac = Bl + D; LAS float* Bc = Ac + D;
    const int c = blockIdx.x, b = c / 64;
    const float* ada_b = F.ada_b(); const float* modp = F.modp(); const float* n1g = F.norm1_g();
    for (int k = F.tid; k < D; k += NWAVES * 64) { const float g = n1g[k];
        Al[k] = g * (1.0f + mod_sum(ada_b, modp, b, D + k)); Bl[k] = mod_sum(ada_b, modp, b, k); Ac[k] = g * (1.0f + mod_sum(ada_b, modp, 4, D + k)); Bc[k] = mod_sum(ada_b, modp, 4, k); }
    { const int per = (5 * MODN) / 256; if (F.tid < per) { const int i = c * per + F.tid; F.modf()[i] = mod_sum(ada_b, modp, i / MODN, i % MODN); } }
    __syncthreads();
    const float* xp = F.x(); const float* cxp = F.ctx(); unsigned char* h8 = (unsigned char*)F.ACT(); bf16* h16 = F.H(); float* rsh = F.rsh();
    for (int j = F.wave; j < 68; j += NWAVES) {
        if (j < 64) { const size_t row = (size_t)c * 64 + j; if (V_FP8 && INPROJ_MODE == 2) norm_row<4, true>(xp + row * D, h8 + row * D, Al, Bl, F.lane, nullptr, rsh + row); else if (V_FP8) norm_row<2, true>(xp + row * D, h8 + row * D, Al, Bl, F.lane); else norm_row<3, true>(xp + row * D, h16 + row * D, Al, Bl, F.lane, h8 + row * D); }
        else { const size_t row = (size_t)c * 4 + (j - 64); if (V_FP8 && INPROJ_MODE == 2) norm_row<4, true>(cxp + row * D, h8 + ((size_t)M + row) * D, Ac, Bc, F.lane, nullptr, rsh + M + row); else if (V_FP8) norm_row<2, true>(cxp + row * D, h8 + ((size_t)M + row) * D, Ac, Bc, F.lane); else norm_row<3, true>(cxp + row * D, h16 + ((size_t)M + row) * D, Ac, Bc, F.lane, h8 + ((size_t)M + row) * D); }
    }
}
__device__ __forceinline__ void p7_norm2(Frame& F) {
    LAS float* Al = (LAS float*)(F.lds + RING_OFF); LAS float* Bl = Al + D;
    const int c = blockIdx.x, b = c / 64; const float* mb = F.modf() + (size_t)b * MODN;
    const float* n2g = F.norm2_g();
    for (int k = F.tid; k < D; k += NWAVES * 64) { Al[k] = n2g[k] * (1.0f + mb[4 * D + k]); Bl[k] = mb[3 * D + k]; }
    __syncthreads();
    const float* x1 = F.out(); bf16* h2 = F.QO();
    for (int j = F.wave; j < 64; j += NWAVES) { const size_t row = (size_t)c * 64 + j; norm_row<1, true>(x1 + row * D, h2 + row * D, Al, Bl, F.lane); }
}
__device__ __forceinline__ void p11_final(Frame& F, float osc = 1.0f) {
    LAS float* Al = (LAS float*)(F.lds + RING_OFF);
    const int c = blockIdx.x;
    const float* fg = F.final_g(); float* outp = F.out();
    for (int k = F.tid; k < D; k += NWAVES * 64) Al[k] = fg[k] * osc;
    __syncthreads();
    for (int j = F.wave; j < 64; j += NWAVES) { const size_t row = (size_t)c * 64 + j; norm_row<0, false>(outp + row * D, outp + row * D, Al, Al, F.lane); }
}

__device__ __forceinline__ void p6_quant_y(Frame& F) {
    const bf16* Y = F.H(); unsigned char* Y8 = (unsigned char*)F.KB(); float* rsy = F.rsy();
    for (int j = F.wave; j < 64; j += NWAVES) { const size_t row = (size_t)blockIdx.x * 64 + j;
        const GAS v4u* yr = (const GAS v4u*)(Y + row * D) + F.lane; v4u r[8]; float m = 0.f;
#pragma unroll
        for (int q = 0; q < 8; ++q) { r[q] = yr[64 * q]; const unsigned w[4] = {r[q].x, r[q].y, r[q].z, r[q].w};
#pragma unroll
            for (int e = 0; e < 4; ++e) m = fmaxf(m, fmaxf(fabsf(bf_lo(w[e])), fabsf(bf_hi(w[e])))); }
#pragma unroll
        for (int o = 1; o < 64; o <<= 1) m = fmaxf(m, __shfl_xor(m, o));
        const float inv = m > 0.f ? 127.0f / m : 0.f;
#pragma unroll
        for (int q = 0; q < 8; ++q) { v2u o; o.x = pk4_i8(bf_lo(r[q].x) * inv, bf_hi(r[q].x) * inv, bf_lo(r[q].y) * inv, bf_hi(r[q].y) * inv); o.y = pk4_i8(bf_lo(r[q].z) * inv, bf_hi(r[q].z) * inv, bf_lo(r[q].w) * inv, bf_hi(r[q].w) * inv);
            ((GAS v2u*)(Y8 + row * D))[F.lane + 64 * q] = o; }
        if (F.lane == 0) rsy[row] = m * (1.0f / 127.0f);
    }
}

__device__ __forceinline__ void p3_qkfix(Frame& F) {
    constexpr int NPQ = QFIX_ATT ? 0 : M * HA, NPK = M * KVA, NPC = MC * KVA, NP = NPQ + NPK + NPC;
    const int gw = F.vcu * NWAVES + F.wave, NGW = F.G * NWAVES, sub = F.lane & 15;
    bf16* QOp = F.QO(); bf16* KAp = F.KA(); const float* qn = F.qnorm(); const float* kn = F.knorm(); const float2* ropep = F.rope();
    for (int wi = gw; wi < NP / 4; wi += NGW) {
        int p = 4 * wi + (F.lane >> 4); bf16* ptr; const float* gain; int t; bool rope = true;
        if (p < NPQ) { const int row = p >> 4, h = p & 15; ptr = QOp + (size_t)row * 4096 + h * HD; gain = qn; t = row & (S - 1); }
        else if (p < NPQ + NPK) { p -= NPQ; const int row = p >> 2, h = p & 3, b = row >> 12; t = row & (S - 1); ptr = KAp + ((size_t)b * KT + L + t) * 512 + h * HD; gain = kn; }
        else { p -= NPQ + NPK; const int row = p >> 2, h = p & 3, b = row >> 8, j = row & (L - 1); ptr = KAp + ((size_t)b * KT + j) * 512 + h * HD; gain = kn; t = 0; rope = false; }
        const v4u raw = *(const GAS v4u*)(ptr + 8 * sub);
        float v[8] = {bf_lo(raw.x), bf_hi(raw.x), bf_lo(raw.y), bf_hi(raw.y), bf_lo(raw.z), bf_hi(raw.z), bf_lo(raw.w), bf_hi(raw.w)};
        float ss = 0.f;
#pragma unroll
        for (int e = 0; e < 8; ++e) ss += v[e] * v[e];
        ss += __shfl_xor(ss, 1); ss += __shfl_xor(ss, 2); ss += __shfl_xor(ss, 4); ss += __shfl_xor(ss, 8);
        const float rstd = 1.0f / sqrtf(ss * (1.0f / HD) + EPS);
        const f32x4 g0 = *(const GAS f32x4*)(gain + 8 * sub), g1 = *(const GAS f32x4*)(gain + 8 * sub + 4);
        v[0] *= rstd * g0.x; v[1] *= rstd * g0.y; v[2] *= rstd * g0.z; v[3] *= rstd * g0.w; v[4] *= rstd * g1.x; v[5] *= rstd * g1.y; v[6] *= rstd * g1.z; v[7] *= rstd * g1.w;
        const int pos = (sub < 8) ? (t >> 6) : (t & 63); const float2* rp = ropep + pos * 32 + 8 * (sub & 3);
        float o[8];
#pragma unroll
        for (int e = 0; e < 8; ++e) { const float q = __shfl_xor(v[e], 4); const float2 cs = rp[e]; o[e] = rope ? ((sub & 4) ? (v[e] * cs.x + q * cs.y) : (v[e] * cs.x - q * cs.y)) : v[e]; }
        v4u w; w.x = pk2(o[0], o[1]); w.y = pk2(o[2], o[3]); w.z = pk2(o[4], o[5]); w.w = pk2(o[6], o[7]);
        *(GAS v4u*)(ptr + 8 * sub) = w;
    }
}

__device__ __forceinline__ void ld8f(const float* p, float (&v)[8]) { const f32x4 a = *(const GAS f32x4*)p, b = *(const GAS f32x4*)(p + 4); v[0] = a.x; v[1] = a.y; v[2] = a.z; v[3] = a.w; v[4] = b.x; v[5] = b.y; v[6] = b.z; v[7] = b.w; }
__device__ __forceinline__ void p10_convfix(Frame& F) {
    constexpr int NFG = DFF / 8, NBD = NB * 15;
    const int gt = F.vcu * (NWAVES * 64) + F.tid, NT_ = F.G * NWAVES * 64;
    const float* cw = F.conv_w(); const float* cbp_ = F.conv_b(); const float* halo = (const float*)F.Win(); bf16* actp = F.ACT();
    for (int item = gt; item < NFG * NBD; item += NT_) {
        const int fg = item % NFG, bd = item / NFG, pm = (bd / 15) * 16 + (bd % 15), f0 = 8 * fg, cg = 256 * (f0 >> 7) + (f0 & 127);
        float w[3][8], bb[8], r254[8], r255[8], r0[8], r1[8], og[2][8], ov[2][8];
#pragma unroll
        for (int half = 0; half < 2; ++half) {
            const int fo = half * DFF + f0, co = cg + half * 128;
#pragma unroll
            for (int j = 0; j < 3; ++j) ld8f(cw + j * F2 + fo, w[j]);
            ld8f(cbp_ + fo, bb);
            ld8f(halo + ((size_t)pm * 4 + 2) * F2 + co, r254); ld8f(halo + ((size_t)pm * 4 + 3) * F2 + co, r255);
            ld8f(halo + ((size_t)(pm + 1) * 4 + 0) * F2 + co, r0); ld8f(halo + ((size_t)(pm + 1) * 4 + 1) * F2 + co, r1);
#pragma unroll
            for (int e = 0; e < 8; ++e) { const float a = r254[e] * w[0][e] + r255[e] * w[1][e] + r0[e] * w[2][e] + bb[e], b = r255[e] * w[0][e] + r0[e] * w[1][e] + r1[e] * w[2][e] + bb[e];
                if (half == 0) { og[0][e] = a; og[1][e] = b; } else { ov[0][e] = a; ov[1][e] = b; } }
        }
#pragma unroll
        for (int rr = 0; rr < 2; ++rr) { float o[8];
#pragma unroll
            for (int e = 0; e < 8; ++e) o[e] = og[rr][e] * sigmoid_f(og[rr][e]) * ov[rr][e];
            v4u wv; wv.x = pk2(o[0], o[1]); wv.y = pk2(o[2], o[3]); wv.z = pk2(o[4], o[5]); wv.w = pk2(o[6], o[7]);
            *(GAS v4u*)(actp + (size_t)(pm * 256 + 255 + rr) * DFF + f0) = wv; }
    }
}

namespace att {
using bf16x8 = __attribute__((ext_vector_type(8))) short;
using s16x4  = __attribute__((ext_vector_type(4))) short;
using f32x16 = __attribute__((ext_vector_type(16))) float;
using u32x4  = __attribute__((ext_vector_type(4))) unsigned;
constexpr int AD = 128, NW = 8, QBLK = 32, KVBLK = 64;
constexpr float THR = 8.f;
constexpr size_t SHM_V = KVBLK * AD * 2, SHM_K = KVBLK * AD * 2, SHM_ATTN = 2 * SHM_V + 2 * SHM_K + NW * 64 * 4;
constexpr int BIAS_OFF = (int)SHM_ATTN;
constexpr int ATT_LDS = BIAS_OFF + 2048;
#define KSWZ(row, colB) ((row) * 256 + ((colB) ^ (((row) & 7) << 4)))
#define SBAR() __builtin_amdgcn_sched_barrier(0)
__device__ __forceinline__ int crow(int r, int hi) { return (r & 3) + 8 * (r >> 2) + 4 * hi; }
__device__ __forceinline__ unsigned cvtpk(float lo, float hi) { unsigned r; asm volatile("v_cvt_pk_bf16_f32 %0, %1, %2" : "=v"(r) : "v"(lo), "v"(hi)); return r; }
template <int FIXM = 0>
__device__ __forceinline__ void partialSM(f32x16& p0, f32x16& p1, float& m_reg, float& mn, float& alpha, float m0c = 0.f) {
  constexpr float C = SCALE * 1.4426950408889634f;
  if (FIXM == 2) { alpha = 1.f; mn = 0.f;
    for (int r = 0; r < 16; ++r) p0[r] = __builtin_amdgcn_exp2f(p0[r]);
    return; }
  if (FIXM == 1) { alpha = 1.f; mn = 0.f;
    for (int r = 0; r < 16; ++r) p0[r] = fmaf(p0[r], C, -m0c); for (int r = 0; r < 16; ++r) p1[r] = fmaf(p1[r], C, -m0c);
    for (int r = 0; r < 16; ++r) p0[r] = __builtin_amdgcn_exp2f(p0[r]);
    return; }
  float pmax = p0[0]; for (int r = 1; r < 16; ++r) pmax = fmaxf(pmax, p0[r]); for (int r = 0; r < 16; ++r) pmax = fmaxf(pmax, p1[r]);
  { auto rr = __builtin_amdgcn_permlane32_swap(__float_as_uint(pmax), __float_as_uint(pmax), false, false);
    pmax = fmaxf(__uint_as_float(rr[0]), __uint_as_float(rr[1])); }
  if (__builtin_expect(__all(pmax - m_reg <= THR / SCALE), 1)) { mn = m_reg; alpha = 1.f; }
  else { mn = fmaxf(m_reg, pmax); alpha = __builtin_amdgcn_exp2f((m_reg - mn) * C); m_reg = mn; }
  float mnC = -mn * C;
  for (int r = 0; r < 16; ++r) p0[r] = fmaf(p0[r], C, mnC); for (int r = 0; r < 16; ++r) p1[r] = fmaf(p1[r], C, mnC);
  for (int r = 0; r < 16; ++r) p0[r] = __builtin_amdgcn_exp2f(p0[r]);
}
__device__ __forceinline__ void finishSM(f32x16& p0, f32x16& p1, float alpha, float& l_reg, bf16x8& pa0, bf16x8& pa1, bf16x8& pa2, bf16x8& pa3) {
  for (int r = 0; r < 16; ++r) p1[r] = __builtin_amdgcn_exp2f(p1[r]);
  float ps = 0; for (int r = 0; r < 16; ++r) ps += p0[r]; for (int r = 0; r < 16; ++r) ps += p1[r];
  { auto rr = __builtin_amdgcn_permlane32_swap(__float_as_uint(ps), __float_as_uint(ps), false, false);
    ps = __uint_as_float(rr[0]) + __uint_as_float(rr[1]); }
  l_reg = l_reg * alpha + ps;
#define PK4(P, BASE, OUT) do { unsigned a0 = cvtpk(P[BASE + 0], P[BASE + 1]), a1 = cvtpk(P[BASE + 2], P[BASE + 3]);   \
    unsigned b0 = cvtpk(P[BASE + 4], P[BASE + 5]), b1 = cvtpk(P[BASE + 6], P[BASE + 7]);                              \
    auto r0 = __builtin_amdgcn_permlane32_swap(a0, b0, false, false); auto r1 = __builtin_amdgcn_permlane32_swap(a1, b1, false, false); \
    u32x4 w = {r0[0], r1[0], r0[1], r1[1]}; OUT = *reinterpret_cast<bf16x8*>(&w); } while (0)
  PK4(p0, 0, pa0); PK4(p0, 8, pa1); PK4(p1, 0, pa2); PK4(p1, 8, pa3);
#undef PK4
}
__device__ __forceinline__ void qkt(f32x16& p0, f32x16& p1, const char* Ks, const bf16x8* qr, int r32, int hi) {
  p0 = f32x16{}; p1 = f32x16{};
  for (int d0 = 0; d0 < 8; ++d0) { int cb = (d0 * 16 + hi * 8) * 2;
    bf16x8 b0 = *reinterpret_cast<const bf16x8*>(Ks + KSWZ(r32, cb));
    bf16x8 b1 = *reinterpret_cast<const bf16x8*>(Ks + KSWZ(32 + r32, cb));
    p0 = __builtin_amdgcn_mfma_f32_32x32x16_bf16(b0, qr[d0], p0, 0, 0, 0);
    p1 = __builtin_amdgcn_mfma_f32_32x32x16_bf16(b1, qr[d0], p1, 0, 0, 0); }
}
__device__ __forceinline__ int v_st(int k, int c) { const int kk = (k & ~0xC) | ((k & 4) << 1) | ((k & 8) >> 1); return ((kk >> 3) * 4 + (c >> 5)) * 512 + ((kk & 7) * 32 + (c & 31)) * 2; }
__device__ __forceinline__ int v_rd_base(int lane) { return ((lane & 3) << 3) | (((lane >> 2) & 3) << 6) | (((lane >> 4) & 1) << 5) | (((lane >> 5) & 1) << 8); }
constexpr int v_rd_off(int d0, int ks, int half) { return d0 * 512 + ks * 4096 + half * 2048; }
template <int OFF> __device__ __forceinline__ s16x4 tr_read(int vb) {
  s16x4 r; asm volatile("ds_read_b64_tr_b16 %0, %1 offset:%2" : "=&v"(r) : "v"(vb), "i"(OFF) : "memory"); return r;
}
template <int D0> __device__ __forceinline__ void pv_one(f32x16& od, int vb, bf16x8 pa0, bf16x8 pa1, bf16x8 pa2, bf16x8 pa3) {
  const s16x4 l0 = tr_read<v_rd_off(D0, 0, 0)>(vb), h0 = tr_read<v_rd_off(D0, 0, 1)>(vb), l1 = tr_read<v_rd_off(D0, 1, 0)>(vb), h1 = tr_read<v_rd_off(D0, 1, 1)>(vb);
  const s16x4 l2 = tr_read<v_rd_off(D0, 2, 0)>(vb), h2 = tr_read<v_rd_off(D0, 2, 1)>(vb), l3 = tr_read<v_rd_off(D0, 3, 0)>(vb), h3 = tr_read<v_rd_off(D0, 3, 1)>(vb);
  asm volatile("s_waitcnt lgkmcnt(0)" ::: "memory"); SBAR();
#define PK(L, H) (bf16x8){L[0], L[1], L[2], L[3], H[0], H[1], H[2], H[3]}
  od = __builtin_amdgcn_mfma_f32_32x32x16_bf16(pa0, PK(l0, h0), od, 0, 0, 0);
  od = __builtin_amdgcn_mfma_f32_32x32x16_bf16(pa1, PK(l1, h1), od, 0, 0, 0);
  od = __builtin_amdgcn_mfma_f32_32x32x16_bf16(pa2, PK(l2, h2), od, 0, 0, 0);
  od = __builtin_amdgcn_mfma_f32_32x32x16_bf16(pa3, PK(l3, h3), od, 0, 0, 0);
#undef PK
}
__device__ __forceinline__ void pv_d0(f32x16* o, int vb, bf16x8 pa0, bf16x8 pa1, bf16x8 pa2, bf16x8 pa3) {
  pv_one<0>(o[0], vb, pa0, pa1, pa2, pa3); pv_one<1>(o[1], vb, pa0, pa1, pa2, pa3); pv_one<2>(o[2], vb, pa0, pa1, pa2, pa3); pv_one<3>(o[3], vb, pa0, pa1, pa2, pa3);
}
struct NatGeo { int R_lo, nloc, qr, rs, qc, cs; };
__device__ __forceinline__ void nat_mask(f32x16& p0, f32x16& p1, int kr, const NatGeo& g, const float* btab, int hi) {
  const float ninf = -__builtin_inff();
  const float* tb = btab + (kr - g.qr + 7) * 31 + 15 - g.qc + 4 * hi;
#pragma unroll
  for (int q = 0; q < 4; ++q) {
    float bb[8];
#pragma unroll
    for (int e = 0; e < 4; ++e) { bb[e] = tb[8 * q + e]; bb[4 + e] = tb[32 + 8 * q + e]; }
#pragma unroll
    for (int e = 0; e < 4; ++e) { const int r = 4 * q + e, k0 = 8 * q + e + 4 * hi, k1 = k0 + 32;
      p0[r] = ((unsigned)(k0 - g.cs) < 16u) ? p0[r] + bb[e] : ninf; p1[r] = ((unsigned)(k1 - g.cs) < 16u) ? p1[r] + bb[4 + e] : ninf; }
    asm volatile("" ::: "memory");
  }
}
template <int LDQ, int LDK, int LDO, int FIXM = 0, bool QFIX = false>
__device__ __forceinline__ void attn_body(const bf16* Qb, const bf16* __restrict__ Kh, const bf16* __restrict__ Vh, bf16* Ob, int NT, char* lds, unsigned char* Ob8 = nullptr, float oscale8 = 1.f, float m0c = 0.f,
                                          const float* qg = nullptr, const float2* ropet = nullptr, int t0 = 0) {
  int tid_o = threadIdx.x; asm volatile("" : "+v"(tid_o));
  const int tid = tid_o, wid = tid >> 6, lane = tid & 63, r32 = lane & 31, hi = lane >> 5;
  char* V_lds = lds; char* K_lds = lds + 2 * SHM_V;
  float* ws = (float*)(lds + 2 * SHM_V + 2 * SHM_K) + wid * 64; float* li_l = ws; float* al_l = ws + 32;
  float m_reg = -1e30f, l_reg = 0; f32x16 o[4] = {}; bf16x8 qr[8];
  const bf16* Qw = Qb + (long)(wid * QBLK + r32) * LDQ + hi * 8;
#pragma unroll
  for (int d0 = 0; d0 < 8; ++d0) qr[d0] = *reinterpret_cast<const bf16x8*>(Qw + d0 * 16);
  if (QFIX) {
    float x[8][8]; float ss = 0.f;
#pragma unroll
    for (int d0 = 0; d0 < 8; ++d0) { const u32x4 w = *reinterpret_cast<const u32x4*>(&qr[d0]);
      x[d0][0] = bf_lo(w.x); x[d0][1] = bf_hi(w.x); x[d0][2] = bf_lo(w.y); x[d0][3] = bf_hi(w.y); x[d0][4] = bf_lo(w.z); x[d0][5] = bf_hi(w.z); x[d0][6] = bf_lo(w.w); x[d0][7] = bf_hi(w.w);
#pragma unroll
      for (int e = 0; e < 8; ++e) ss += x[d0][e] * x[d0][e]; }
    { auto rr = __builtin_amdgcn_permlane32_swap(__float_as_uint(ss), __float_as_uint(ss), false, false); ss = __uint_as_float(rr[0]) + __uint_as_float(rr[1]); }
    const float rstd = (FIXM == 2 ? SCALE * 1.4426950408889634f : 1.0f) / sqrtf(ss * (1.0f / AD) + EPS);
#pragma unroll
    for (int d0 = 0; d0 < 8; ++d0) { const f32x4 g0 = *reinterpret_cast<const f32x4*>(qg + d0 * 16 + hi * 8), g1 = *reinterpret_cast<const f32x4*>(qg + d0 * 16 + hi * 8 + 4);
      x[d0][0] *= rstd * g0.x; x[d0][1] *= rstd * g0.y; x[d0][2] *= rstd * g0.z; x[d0][3] *= rstd * g0.w; x[d0][4] *= rstd * g1.x; x[d0][5] *= rstd * g1.y; x[d0][6] *= rstd * g1.z; x[d0][7] *= rstd * g1.w; }
    const int tok = t0 + wid * QBLK + r32;
#pragma unroll
    for (int half = 0; half < 2; ++half) { const float2* rp = ropet + (half == 0 ? (tok >> 6) : (tok & 63)) * 32 + hi * 8;
#pragma unroll
      for (int dd = 0; dd < 2; ++dd)
#pragma unroll
        for (int e = 0; e < 8; ++e) { const float2 cs = rp[dd * 16 + e]; const float a = x[4 * half + dd][e], b = x[4 * half + dd + 2][e];
          x[4 * half + dd][e] = a * cs.x - b * cs.y; x[4 * half + dd + 2][e] = b * cs.x + a * cs.y; } }
#pragma unroll
    for (int d0 = 0; d0 < 8; ++d0) { u32x4 w = {cvtpk(x[d0][0], x[d0][1]), cvtpk(x[d0][2], x[d0][3]), cvtpk(x[d0][4], x[d0][5]), cvtpk(x[d0][6], x[d0][7])}; qr[d0] = *reinterpret_cast<bf16x8*>(&w); }
  }
  const int sr = tid >> 4, sc = (tid & 15) * 8, vst0 = v_st(sr, sc), vst1 = v_st(32 + sr, sc);
  const int vb0 = (int)(uintptr_t)V_lds + v_rd_base(lane);
  struct { bf16x8 vs0, vs1, ks0, ks1; } sr_[2];
#define TROW(j) (64 * (j))
#define SLOAD(i, j) do { const long k0_ = TROW(j); sr_[i].vs0 = *reinterpret_cast<const bf16x8*>(&Vh[(k0_ + sr) * LDK + sc]); sr_[i].vs1 = *reinterpret_cast<const bf16x8*>(&Vh[(k0_ + 32 + sr) * LDK + sc]); \
    sr_[i].ks0 = *reinterpret_cast<const bf16x8*>(&Kh[(k0_ + sr) * LDK + sc]); sr_[i].ks1 = *reinterpret_cast<const bf16x8*>(&Kh[(k0_ + 32 + sr) * LDK + sc]); } while (0)
#define SWRITE(b, i) do { *(bf16x8*)(V_lds + (b) * SHM_V + vst0) = sr_[i].vs0;          \
    *(bf16x8*)(V_lds + (b) * SHM_V + vst1) = sr_[i].vs1; int kc = sc * 2;               \
    *(bf16x8*)(K_lds + (b) * SHM_K + KSWZ(sr, kc)) = sr_[i].ks0;                       \
    *(bf16x8*)(K_lds + (b) * SHM_K + KSWZ(32 + sr, kc)) = sr_[i].ks1; } while (0)
#define SWAIT() asm volatile("s_waitcnt vmcnt(4)" ::: "memory")
#define RESC(a) do { if (__any((a) < 1.f)) { if (hi == 0) al_l[r32] = (a); asm volatile("s_waitcnt lgkmcnt(0)" ::: "memory"); \
    for (int d = 0; d < 4; ++d) for (int r = 0; r < 16; ++r) o[d][r] *= al_l[crow(r, hi)]; } } while (0)
#define MASK(P0, P1, j) do { } while (0)
  f32x16 pA0, pA1, pB0, pB1; float mnA, mnB, alA, alB; bf16x8 pa0, pa1, pa2, pa3;
  constexpr int SE = 0, SO = 1;
  SLOAD(SE, 0); asm volatile("s_waitcnt vmcnt(0)" ::: "memory"); SWRITE(0, SE); __syncthreads();
  qkt(pA0, pA1, K_lds, qr, r32, hi); MASK(pA0, pA1, 0); partialSM<FIXM>(pA0, pA1, m_reg, mnA, alA, m0c);
  SLOAD(SO, 1); if (2 < NT) SLOAD(SE, 2);
  SWAIT(); SWRITE(1, SO); __syncthreads();
  for (int j = 1; j + 1 < NT; j += 2) {
    SBAR(); qkt(pB0, pB1, K_lds + SHM_K, qr, r32, hi);
    finishSM(pA0, pA1, alA, l_reg, pa0, pa1, pa2, pa3); SBAR();
    SLOAD(SO, j + 2); SBAR();
    pv_d0(o, vb0, pa0, pa1, pa2, pa3); MASK(pB0, pB1, j); partialSM<FIXM>(pB0, pB1, m_reg, mnB, alB, m0c);
    __syncthreads(); SWAIT(); SWRITE(0, SE);
    RESC(alB); __syncthreads();
    SBAR(); qkt(pA0, pA1, K_lds, qr, r32, hi);
    finishSM(pB0, pB1, alB, l_reg, pa0, pa1, pa2, pa3); SBAR();
    if (j + 3 < NT) SLOAD(SE, j + 3); SBAR();
    pv_d0(o, vb0 + (int)SHM_V, pa0, pa1, pa2, pa3); MASK(pA0, pA1, j + 1); partialSM<FIXM>(pA0, pA1, m_reg, mnA, alA, m0c);
    __syncthreads(); SWAIT(); SWRITE(1, SO);
    RESC(alA); __syncthreads();
  }
  SBAR(); qkt(pB0, pB1, K_lds + SHM_K, qr, r32, hi);
  finishSM(pA0, pA1, alA, l_reg, pa0, pa1, pa2, pa3); SBAR();
  pv_d0(o, vb0, pa0, pa1, pa2, pa3); MASK(pB0, pB1, NT - 1); partialSM<FIXM>(pB0, pB1, m_reg, mnB, alB, m0c);
  __syncthreads(); RESC(alB);
  finishSM(pB0, pB1, alB, l_reg, pa0, pa1, pa2, pa3); SBAR();
  pv_d0(o, vb0 + (int)SHM_V, pa0, pa1, pa2, pa3);
  if (hi == 0) li_l[r32] = l_reg; asm volatile("s_waitcnt lgkmcnt(0)" ::: "memory");
  float rli[16];
#pragma unroll
  for (int r = 0; r < 16; ++r) rli[r] = __builtin_amdgcn_rcpf(li_l[crow(r, hi)]);
  bf16* Ow = Ob + (long)(wid * QBLK) * LDO;
#pragma unroll
  for (int r = 0; r < 16; ++r) { int orow = crow(r, hi);
    if (BR_FP8) { unsigned char* Ow8 = Ob8 + (long)(wid * QBLK + orow) * LDO;
      for (int d0 = 0; d0 < 4; ++d0) Ow8[d0 * 32 + r32] = (unsigned char)(pk4_fp8(o[d0][r] * rli[r] * oscale8, 0.f, 0.f, 0.f) & 0xffu); }
    else for (int d0 = 0; d0 < 4; ++d0) Ow[(long)orow * LDO + d0 * 32 + r32] = (bf16)(cvtpk(o[d0][r] * rli[r], 0.f) & 0xffffu); }
#undef TROW
#undef SLOAD
#undef SWRITE
#undef SWAIT
#undef RESC
#undef MASK
}

template <int LDQ, int LDK, int LDO>
__device__ __forceinline__ void nat_body(const bf16* Qb, const bf16* __restrict__ Kh, const bf16* __restrict__ Vh, bf16* Ob, const NatGeo g, char* lds, unsigned char* Ob8 = nullptr, float oscale8 = 1.f) {
  int tid_o = threadIdx.x; asm volatile("" : "+v"(tid_o));
  const int tid = tid_o, wid = tid >> 6, lane = tid & 63, r32 = lane & 31, hi = lane >> 5;
  char* V_lds = lds; char* K_lds = lds + 2 * SHM_V;
  float* ws = (float*)(lds + 2 * SHM_V + 2 * SHM_K) + wid * 64; float* li_l = ws; float* al_l = ws + 32;
  const float* btab = (const float*)(lds + BIAS_OFF);
  float m_reg = -1e30f, l_reg = 0; f32x16 o[4] = {}; bf16x8 qr[8];
  const bf16* Qw = Qb + (long)(wid * QBLK + r32) * LDQ + hi * 8;
#pragma unroll
  for (int d0 = 0; d0 < 8; ++d0) qr[d0] = *reinterpret_cast<const bf16x8*>(Qw + d0 * 16);
  const int sr = tid >> 4, sc = (tid & 15) * 8, vst0 = v_st(sr, sc), vst1 = v_st(32 + sr, sc);
  const int vb0 = (int)(uintptr_t)V_lds + v_rd_base(lane);
  bf16x8 vs0, vs1, ks0, ks1;
#define TROW(j) ((j) < 4 ? 64 * (j) : L + 64 * (g.R_lo + (j) - 4))
#define SLOAD(j) do { const long k0_ = TROW(j); vs0 = *reinterpret_cast<const bf16x8*>(&Vh[(k0_ + sr) * LDK + sc]); vs1 = *reinterpret_cast<const bf16x8*>(&Vh[(k0_ + 32 + sr) * LDK + sc]); \
    ks0 = *reinterpret_cast<const bf16x8*>(&Kh[(k0_ + sr) * LDK + sc]); ks1 = *reinterpret_cast<const bf16x8*>(&Kh[(k0_ + 32 + sr) * LDK + sc]); } while (0)
#define SWRITE(b) do { *(bf16x8*)(V_lds + (b) * SHM_V + vst0) = vs0; *(bf16x8*)(V_lds + (b) * SHM_V + vst1) = vs1; int kc = sc * 2;               \
    *(bf16x8*)(K_lds + (b) * SHM_K + KSWZ(sr, kc)) = ks0; *(bf16x8*)(K_lds + (b) * SHM_K + KSWZ(32 + sr, kc)) = ks1; } while (0)
  const int NT = 4 + g.nloc;
  SLOAD(0); asm volatile("s_waitcnt vmcnt(0)" ::: "memory"); SWRITE(0); __syncthreads();
  for (int j = 0; j < NT; ++j) {
    const int b = j & 1;
    if (j + 1 < NT) SLOAD(j + 1);
    const int kr = g.R_lo + j - 4;
    const bool skip = (j >= 4) && ((unsigned)(kr - g.rs) >= 8u);
    if (!skip) {
      f32x16 p0, p1; float mn, al; bf16x8 pa0, pa1, pa2, pa3;
      qkt(p0, p1, K_lds + b * SHM_K, qr, r32, hi);
      if (j >= 4) nat_mask(p0, p1, kr, g, btab, hi);
      partialSM(p0, p1, m_reg, mn, al);
      if (__any(al < 1.f)) { if (hi == 0) al_l[r32] = al; asm volatile("s_waitcnt lgkmcnt(0)" ::: "memory");
        for (int d = 0; d < 4; ++d) for (int r = 0; r < 16; ++r) o[d][r] *= al_l[crow(r, hi)]; }
      finishSM(p0, p1, al, l_reg, pa0, pa1, pa2, pa3); SBAR();
      pv_d0(o, vb0 + b * (int)SHM_V, pa0, pa1, pa2, pa3);
    }
    if (j + 1 < NT) { asm volatile("s_waitcnt vmcnt(0)" ::: "memory"); SWRITE(b ^ 1); }
    __syncthreads();
  }
  if (hi == 0) li_l[r32] = l_reg; asm volatile("s_waitcnt lgkmcnt(0)" ::: "memory");
  float rli[16];
#pragma unroll
  for (int r = 0; r < 16; ++r) rli[r] = __builtin_amdgcn_rcpf(li_l[crow(r, hi)]);
  bf16* Ow = Ob + (long)(wid * QBLK) * LDO;
#pragma unroll
  for (int r = 0; r < 16; ++r) { int orow = crow(r, hi);
    if (BR_FP8) { unsigned char* Ow8 = Ob8 + (long)(wid * QBLK + orow) * LDO;
      for (int d0 = 0; d0 < 4; ++d0) Ow8[d0 * 32 + r32] = (unsigned char)(pk4_fp8(o[d0][r] * rli[r] * oscale8, 0.f, 0.f, 0.f) & 0xffu); }
    else for (int d0 = 0; d0 < 4; ++d0) Ow[(long)orow * LDO + d0 * 32 + r32] = (bf16)(cvtpk(o[d0][r] * rli[r], 0.f) & 0xffffu); }
#undef TROW
#undef SLOAD
#undef SWRITE
}
}

__device__ __forceinline__ void p4_attention(Frame& F) {
    char* lds = (char*)(F.lds + RING_OFF);
    bf16* QOp = F.QO(); const bf16* KAp = F.KA(); const bf16* VAp = F.VA(); const bf16* KBp = F.KB(); const bf16* VBp = F.VB(); const float* rpbp = F.rpb(); bf16* scrp = F.ACT(); unsigned char* o8p = (unsigned char*)F.ACT(); const float* qgp = F.qnorm(); const float2* ropep = F.rope();
    float m0c, m0c_raw; { const float gq = fmaxf(fabsf(F.qnorm()[F.lane]), fabsf(F.qnorm()[64 + F.lane])), gk = fmaxf(fabsf(F.knorm()[F.lane]), fabsf(F.knorm()[64 + F.lane])); float a = gq, b = gk;
#pragma unroll
      for (int o = 1; o < 64; o <<= 1) { a = fmaxf(a, __shfl_xor(a, o)); b = fmaxf(b, __shfl_xor(b, o)); }
      m0c_raw = __uint_as_float(__builtin_amdgcn_readfirstlane(__float_as_uint(128.0f * 1.01f * a * b * SCALE * 1.4426950408889634f))); m0c = fminf(m0c_raw, 60.0f); }
#ifndef ATT_NO_A
    for (int u = F.vcu; u < NB * KVA * GQ * (S / 256); u += F.G) {
        const int grp = u >> 6, j = u & 63, b = grp >> 2, kvh = grp & 3, gq = j >> 4, qblk = j & 15;
        bf16* Q = QOp + ((size_t)(b * S + qblk * 256)) * 4096 + (kvh * GQ + gq) * HD;
        const bf16* K = KAp + (size_t)b * KT * 512 + kvh * HD; const bf16* V = VAp + (size_t)b * KT * 512 + kvh * HD;
        __syncthreads();
#if defined(ATT_PROBE) && (ATT_PROBE & 1)
        att::attn_body<4096, 512, 4096>(Q, K, V, scrp + (Q - QOp), KT / 64, lds); __syncthreads();
#endif
        if (QFIX_ATT && m0c_raw <= 40.0f) att::attn_body<4096, 512, 4096, 2, QFIX_ATT>(Q, K, V, Q, KT / 64, lds, o8p + (Q - QOp), SC_OA, 0.f, qgp, ropep, qblk * 256);
        else att::attn_body<4096, 512, 4096, 1, QFIX_ATT>(Q, K, V, Q, KT / 64, lds, o8p + (Q - QOp), SC_OA, m0c, qgp, ropep, qblk * 256);
    }
#endif
#ifndef ATT_NO_B
    for (int u = F.vcu; u < NB * HB * (S / 256); u += F.G) {
        const int pair = u >> 4, rblk = u & 15, b = pair >> 4, h = pair & 15, r0 = 4 * rblk;
        bf16* Q = QOp + ((size_t)(b * S + r0 * GW)) * 4096 + 2048 + h * HD;
        const bf16* K = KBp + (size_t)b * KT * 2048 + h * HD; const bf16* V = VBp + (size_t)b * KT * 2048 + h * HD;
        int R_lo = r0 - 4; R_lo = R_lo < 0 ? 0 : (R_lo > GW - 8 ? GW - 8 : R_lo);
        int R_hi = r0 + 3 - 4; R_hi = (R_hi < 0 ? 0 : (R_hi > GW - 8 ? GW - 8 : R_hi)) + 7;
        att::NatGeo g; g.R_lo = R_lo; g.nloc = R_hi - R_lo + 1; g.qr = r0 + (F.wave >> 1); g.qc = 32 * (F.wave & 1) + (F.lane & 31);
        g.rs = g.qr - 4; g.rs = g.rs < 0 ? 0 : (g.rs > GW - 8 ? GW - 8 : g.rs); g.cs = g.qc - 8; g.cs = g.cs < 0 ? 0 : (g.cs > GW - 16 ? GW - 16 : g.cs);
        __syncthreads();
        if (F.tid < 15 * 31) ((LAS float*)(F.lds + RING_OFF + att::BIAS_OFF))[F.tid] = rpbp[h * (15 * 31) + F.tid] * (1.0f / SCALE);
        __syncthreads();
#if defined(ATT_PROBE) && (ATT_PROBE & 2)
        att::nat_body<4096, 2048, 4096>(Q, K, V, scrp + (Q - QOp), g, lds); __syncthreads();
#endif
        att::nat_body<4096, 2048, 4096>(Q, K, V, Q, g, lds, o8p + (Q - QOp), SC_OB);
    }
#endif
    __syncthreads();
}

typedef const f32x4 (&AccRef)[2][2][4][2];
__device__ __forceinline__ v4u pack8(const f32x4 v0, const f32x4 v1) { v4u w; w.x = pk2(v0[0], v0[1]); w.y = pk2(v0[2], v0[3]); w.z = pk2(v1[0], v1[1]); w.w = pk2(v1[2], v1[3]); return w; }
template <bool FP8C> struct EpiInProj {
    static constexpr bool PERM = true, AFTER_DRAIN = false, MIDK = false;
    bf16 *QO, *KA, *VA, *KB, *VB, *GA, *GB; const float* rsh; float wscale;
    __device__ __forceinline__ void operator()(AccRef acc, const pg8::Unit& u, int wr, int wc, int fr, int fq) const {
        constexpr bool I8 = FP8C && INPROJ_MODE == 2;
        const int pm = u.pm, pn = inproj_global_tile(FP8C, u.pn); const bool ctx = pm >= 64; const float osc = FP8C ? 1.0f / SC_WIN : 1.0f; const int b = ctx ? pm - 64 : pm >> 4; const size_t krow0 = (size_t)b * KT + (ctx ? 0 : L + (pm & 15) * 256);
        bf16* tile; int ldc; bool sig = false;
        if (pn < 8) { tile = QO + (size_t)pm * 256 * 4096 + pn * 256; ldc = 4096; }
        else if (pn < 10) { tile = KA + krow0 * 512 + (pn - 8) * 256; ldc = 512; }
        else if (pn < 12) { tile = VA + krow0 * 512 + (pn - 10) * 256; ldc = 512; }
        else if (pn < 20) { tile = QO + (size_t)pm * 256 * 4096 + 2048 + (pn - 12) * 256; ldc = 4096; }
        else if (pn < 28) { tile = KB + krow0 * 2048 + (pn - 20) * 256; ldc = 2048; }
        else if (pn < 36) { tile = VB + krow0 * 2048 + (pn - 28) * 256; ldc = 2048; }
        else { tile = QO; ldc = 4096; sig = true; }
        unsigned char* gt = (unsigned char*)(pn < 52 ? GA : GB) + (size_t)pm * 256 * 4096 + (pn - (pn < 52 ? 36 : 52)) * 256;
#pragma unroll
        for (int ai = 0; ai < 2; ++ai)
#pragma unroll
            for (int m = 0; m < 4; ++m) { bf16* rowp = tile + (size_t)(ai * 128 + wr * 64 + m * 16 + fr) * ldc + wc * 32 + 8 * fq;
                const float rsc = I8 ? rsh[pm * 256 + ai * 128 + wr * 64 + m * 16 + fr] * wscale : osc;
#pragma unroll
                for (int bj = 0; bj < 2; ++bj) { f32x4 v0, v1;
                    if (I8) { typedef int i32x4_ __attribute__((ext_vector_type(4)));
                        const f32x4 a0 = acc[ai][bj][m][0], a1 = acc[ai][bj][m][1];
                        v0 = __builtin_convertvector(__builtin_bit_cast(i32x4_, a0), f32x4) * rsc; v1 = __builtin_convertvector(__builtin_bit_cast(i32x4_, a1), f32x4) * rsc; }
                    else { v0 = acc[ai][bj][m][0] * rsc; v1 = acc[ai][bj][m][1] * rsc; }
                    if (sig) {
#pragma unroll
                        for (int e = 0; e < 4; ++e) { v0[e] = 255.0f * sigmoid_f(v0[e]); v1[e] = 255.0f * sigmoid_f(v1[e]); }
                        v2u w; w.x = pk4_u8(v0[0], v0[1], v0[2], v0[3]); w.y = pk4_u8(v1[0], v1[1], v1[2], v1[3]);
                        *(GAS v2u*)(gt + (size_t)(ai * 128 + wr * 64 + m * 16 + fr) * 4096 + wc * 32 + 8 * fq + bj * 128) = w; }
                    else *(GAS v4u*)(rowp + bj * 128) = pack8(v0, v1); } }
    }
};
struct EpiPlain {
    static constexpr bool PERM = true, AFTER_DRAIN = false, MIDK = false;
    bf16* O; int ldc; int pad;
    __device__ __forceinline__ void operator()(AccRef acc, const pg8::Unit& u, int wr, int wc, int fr, int fq) const {
        bf16* tile = O + (size_t)u.pm * 256 * ldc + u.pn * 256;
#pragma unroll
        for (int ai = 0; ai < 2; ++ai)
#pragma unroll
            for (int m = 0; m < 4; ++m) { bf16* rowp = tile + (size_t)(ai * 128 + wr * 64 + m * 16 + fr) * ldc + wc * 32 + 8 * fq;
#pragma unroll
                for (int bj = 0; bj < 2; ++bj) *(GAS v4u*)(rowp + bj * 128) = pack8(acc[ai][bj][m][0], acc[ai][bj][m][1]); }
    }
};
template <bool ACCUM> struct EpiGate {
    static constexpr bool PERM = true, AFTER_DRAIN = false, MIDK = false;
    bf16* Y; const bf16* G; unsigned char* Y8;
    __device__ __forceinline__ void operator()(AccRef acc, const pg8::Unit& u, int wr, int wc, int fr, int fq) const {
        const size_t t0 = (size_t)u.pm * 256 * 4096 + u.pn * 256;
#pragma unroll
        for (int ai = 0; ai < 2; ++ai)
#pragma unroll
            for (int m = 0; m < 4; ++m) { const size_t ro = t0 + (size_t)(ai * 128 + wr * 64 + m * 16 + fr) * 4096 + wc * 32 + 8 * fq;
#pragma unroll
                for (int bj = 0; bj < 2; ++bj) { const v4u g = *(const GAS v4u*)(G + ro + bj * 128); f32x4 v0 = acc[ai][bj][m][0], v1 = acc[ai][bj][m][1];
                    v0[0] *= bf_lo(g.x); v0[1] *= bf_hi(g.x); v0[2] *= bf_lo(g.y); v0[3] *= bf_hi(g.y); v1[0] *= bf_lo(g.z); v1[1] *= bf_hi(g.z); v1[2] *= bf_lo(g.w); v1[3] *= bf_hi(g.w);
                    if (ACCUM) { const v4u y = *(const GAS v4u*)(Y + ro + bj * 128);
                        v0[0] += bf_lo(y.x); v0[1] += bf_hi(y.x); v0[2] += bf_lo(y.y); v0[3] += bf_hi(y.y); v1[0] += bf_lo(y.z); v1[1] += bf_hi(y.z); v1[2] += bf_lo(y.w); v1[3] += bf_hi(y.w); }
                    if (ACCUM && WOUT_FP8) { v0 = v0 * SC_Y; v1 = v1 * SC_Y; v2u w; w.x = pk4_fp8(v0[0], v0[1], v0[2], v0[3]); w.y = pk4_fp8(v1[0], v1[1], v1[2], v1[3]); *(GAS v2u*)(Y8 + ro + bj * 128) = w; }
                    else *(GAS v4u*)(Y + ro + bj * 128) = pack8(v0, v1); } }
    }
};
struct EpiGateMerged {
    static constexpr bool PERM = true, AFTER_DRAIN = false, MIDK = true;
    static constexpr float MIDS = BR_FP8 ? SC_OB / SC_OA : 1.0f, ENDS = BR_FP8 ? 1.0f / (SC_OB * SC_WBR) : 1.0f;
    bf16* Y; const unsigned char* GA; const unsigned char* GB; unsigned char* Y8;
    __device__ __forceinline__ void mid(f32x4 (&acc)[2][2][4][2], const pg8::Unit& u, int wr, int wc, int fr, int fq) const {
        size_t rb = (size_t)u.pm * 256 * 4096 + u.pn * 256 + (size_t)(wr * 64 + fr) * 4096 + wc * 32 + 8 * fq;
        asm volatile("" : "+v"(rb));
#pragma unroll
        for (int ai = 0; ai < 2; ++ai)
#pragma unroll
            for (int m = 0; m < 4; ++m) { const size_t ro = rb + (size_t)(ai * 128 + m * 16) * 4096;
#pragma unroll
                for (int bj = 0; bj < 2; ++bj) { const v2u a = *(const GAS v2u*)(GA + ro + bj * 128), b = *(const GAS v2u*)(GB + ro + bj * 128);
                    const unsigned aw[2] = {a.x, a.y}, bw[2] = {b.x, b.y};
#pragma unroll
                    for (int n = 0; n < 2; ++n)
#pragma unroll
                        for (int e = 0; e < 4; ++e) acc[ai][bj][m][n][e] *= ub(aw[n], e) * MIDS * __builtin_amdgcn_rcpf(fmaxf(ub(bw[n], e), 1e-20f));
                    asm volatile("" : "+v"(acc[ai][bj][m][0]), "+v"(acc[ai][bj][m][1])); }
                __builtin_amdgcn_sched_barrier(0); }
    }
    __device__ __forceinline__ void operator()(AccRef acc, const pg8::Unit& u, int wr, int wc, int fr, int fq) const {
        size_t rb = (size_t)u.pm * 256 * 4096 + u.pn * 256 + (size_t)(wr * 64 + fr) * 4096 + wc * 32 + 8 * fq;
        asm volatile("" : "+v"(rb));
#pragma unroll
        for (int ai = 0; ai < 2; ++ai)
#pragma unroll
            for (int m = 0; m < 4; ++m) { const size_t ro = rb + (size_t)(ai * 128 + m * 16) * 4096;
#pragma unroll
                for (int bj = 0; bj < 2; ++bj) { const v2u g = *(const GAS v2u*)(GB + ro + bj * 128); f32x4 v0 = acc[ai][bj][m][0], v1 = acc[ai][bj][m][1];
#pragma unroll
                    for (int e = 0; e < 4; ++e) { v0[e] *= (ENDS / 255.0f) * fmaxf(ub(g.x, e), 1e-20f); v1[e] *= (ENDS / 255.0f) * fmaxf(ub(g.y, e), 1e-20f); }
                    if (WOUT_FP8) { v0 = v0 * SC_Y; v1 = v1 * SC_Y; v2u w; w.x = pk4_fp8(v0[0], v0[1], v0[2], v0[3]); w.y = pk4_fp8(v1[0], v1[1], v1[2], v1[3]); *(GAS v2u*)(Y8 + ro + bj * 128) = w; }
                    else *(GAS v4u*)(Y + ro + bj * 128) = pack8(v0, v1); } }
    }
};
#ifndef RESID_BATCH
#define RESID_BATCH 2
#endif
#ifndef RESID_NT
#define RESID_NT 0
#endif
#if RESID_NT
#define NT_LOAD(p) __builtin_nontemporal_load(p)
#define NT_STORE(v, p) __builtin_nontemporal_store(v, p)
#else
#define NT_LOAD(p) (*(p))
#define NT_STORE(v, p) (*(p) = (v))
#endif
struct EpiResid {
    static constexpr bool PERM = true, AFTER_DRAIN = false, MIDK = false;
    float* out; const float* base; const float* gate; float oscale; int pad;
    __device__ __forceinline__ void operator()(AccRef acc, const pg8::Unit& u, int wr, int wc, int fr, int fq) const {
        const float* gb = gate + (size_t)(u.pm >> 4) * MODN + u.pn * 256 + wc * 32 + 8 * fq;
        f32x4 gv[2][2];
#pragma unroll
        for (int bj = 0; bj < 2; ++bj)
#pragma unroll
            for (int n = 0; n < 2; ++n) gv[bj][n] = *(const GAS f32x4*)(gb + bj * 128 + n * 4) * oscale;
#pragma unroll
        for (int q = 0; q < 2 * (4 / RESID_BATCH); ++q) { const int ai = q / (4 / RESID_BATCH), m0 = (q % (4 / RESID_BATCH)) * RESID_BATCH;
            const size_t r0 = (size_t)(u.pm * 256 + ai * 128 + wr * 64 + m0 * 16 + fr) * D + u.pn * 256 + wc * 32 + 8 * fq; f32x4 bs[RESID_BATCH][2][2];
#pragma unroll
            for (int m = 0; m < RESID_BATCH; ++m)
#pragma unroll
                for (int bj = 0; bj < 2; ++bj)
#pragma unroll
                    for (int n = 0; n < 2; ++n) bs[m][bj][n] = NT_LOAD((const GAS f32x4*)(base + r0 + (size_t)(m * 16) * D + bj * 128 + n * 4));
#pragma unroll
            for (int m = 0; m < RESID_BATCH; ++m)
#pragma unroll
                for (int bj = 0; bj < 2; ++bj)
#pragma unroll
                    for (int n = 0; n < 2; ++n) NT_STORE(bs[m][bj][n] + gv[bj][n] * acc[ai][bj][m0 + m][n], (GAS f32x4*)(out + r0 + (size_t)(m * 16) * D + bj * 128 + n * 4)); }
    }
};
__device__ __forceinline__ float dpp_f(float old, float src, const int ctrl_sel) {
    const int o = __builtin_bit_cast(int, old), x = __builtin_bit_cast(int, src); int r;
    if (ctrl_sel == 0) r = __builtin_amdgcn_update_dpp(o, x, 0x111, 0xf, 0xf, false);
    else if (ctrl_sel == 1) r = __builtin_amdgcn_update_dpp(o, x, 0x101, 0xf, 0xf, false);
    else if (ctrl_sel == 2) r = __builtin_amdgcn_update_dpp(o, x, 0x121, 0xf, 0xf, false);
    else r = __builtin_amdgcn_update_dpp(o, x, 0x12F, 0xf, 0xf, false);
    return __builtin_bit_cast(float, r);
}
template <int SEL> __device__ __forceinline__ f32x4 dpp4(const f32x4 old, const f32x4 src) { f32x4 r; r.x = dpp_f(old.x, src.x, SEL); r.y = dpp_f(old.y, src.y, SEL); r.z = dpp_f(old.z, src.z, SEL); r.w = dpp_f(old.w, src.w, SEL); return r; }
constexpr int XCH_OFF = LDSCTL_OFF + 1024;
static_assert(XCH_OFF + 8192 <= LDS_BYTES, "LDS map");
struct EpiConvAct {
    static constexpr bool PERM = true, AFTER_DRAIN = false, MIDK = false;
    bf16* ACT; float* HALO; const float* cw; const float* cb; LAS f32x4* xch;
    __device__ __forceinline__ void operator()(f32x4 (&acc)[2][2][4][2], const pg8::Unit& u, int wr, int wc, int fr, int fq) const {
        const int wid = wr * 4 + wc, fbase = 128 * u.pn + 32 * wc + 8 * fq;
        const f32x4 zero4 = {0.f, 0.f, 0.f, 0.f};
        f32x4 W0[2][2], W1[2][2], W2[2][2], Bb[2][2];
#pragma unroll
        for (int bj = 0; bj < 2; ++bj)
#pragma unroll
            for (int n = 0; n < 2; ++n) { const int fo = bj * DFF + fbase + 4 * n; W0[bj][n] = *(const GAS f32x4*)(cw + fo); W1[bj][n] = *(const GAS f32x4*)(cw + F2 + fo); W2[bj][n] = *(const GAS f32x4*)(cw + 2 * F2 + fo); Bb[bj][n] = *(const GAS f32x4*)(cb + fo); }
        LAS f32x4* mine = xch + wid * 64;
        if (fr == 0) {
#pragma unroll
            for (int ai = 0; ai < 2; ++ai)
#pragma unroll
                for (int bj = 0; bj < 2; ++bj)
#pragma unroll
                    for (int n = 0; n < 2; ++n) mine[((ai * 2 + 0) * 4 + fq) * 4 + bj * 2 + n] = acc[ai][bj][0][n]; }
        if (fr == 15) {
#pragma unroll
            for (int ai = 0; ai < 2; ++ai)
#pragma unroll
                for (int bj = 0; bj < 2; ++bj)
#pragma unroll
                    for (int n = 0; n < 2; ++n) mine[((ai * 2 + 1) * 4 + fq) * 4 + bj * 2 + n] = acc[ai][bj][3][n]; }
        { const int slot = wr == 0 ? fr : fr - 12;
          if ((wr == 0 && fr < 2) || (wr == 1 && fr >= 14)) { float* hp = HALO + ((size_t)u.pm * 4 + slot) * F2 + 256 * u.pn + 32 * wc + 8 * fq;
#pragma unroll
              for (int bj = 0; bj < 2; ++bj)
#pragma unroll
                  for (int n = 0; n < 2; ++n) *(GAS f32x4*)(hp + bj * 128 + 4 * n) = wr == 0 ? acc[0][bj][0][n] : acc[1][bj][3][n]; } }
        asm volatile("s_waitcnt vmcnt(0) lgkmcnt(0)" ::: "memory"); __builtin_amdgcn_s_barrier(); asm volatile("" ::: "memory");
#pragma unroll
        for (int bj = 0; bj < 2; ++bj)
#pragma unroll
            for (int n = 0; n < 2; ++n) asm volatile("" : "+v"(W0[bj][n]), "+v"(W1[bj][n]), "+v"(W2[bj][n]), "+v"(Bb[bj][n]));
        __builtin_amdgcn_sched_barrier(0);
#pragma unroll
        for (int bj = 0; bj < 2; ++bj) {
#pragma unroll
            for (int ai = 0; ai < 2; ++ai) {
                const int rho = 2 * ai + wr;
                f32x4 carry[2], eN[2];
#pragma unroll
                for (int n = 0; n < 2; ++n) {
                    carry[n] = rho > 0 ? xch[(((rho - 1) & 1) * 4 + wc) * 64 + ((((rho - 1) >> 1) * 2 + 1) * 4 + fq) * 4 + bj * 2 + n] : zero4;
                    eN[n] = rho < 3 ? xch[(((rho + 1) & 1) * 4 + wc) * 64 + ((((rho + 1) >> 1) * 2 + 0) * 4 + fq) * 4 + bj * 2 + n] : zero4; }
#pragma unroll
                for (int m = 0; m < 4; ++m)
#pragma unroll
                    for (int n = 0; n < 2; ++n) {
                        const f32x4 cur = acc[ai][bj][m][n];
                        const f32x4 prv = dpp4<0>(carry[n], cur);
                        const f32x4 tn = m < 3 ? dpp4<3>(zero4, acc[ai][bj][m < 3 ? m + 1 : 3][n]) : eN[n];
                        const f32x4 nxt = dpp4<1>(tn, cur);
                        carry[n] = dpp4<2>(zero4, cur);
                        acc[ai][bj][m][n] = W0[bj][n] * prv + W1[bj][n] * cur + W2[bj][n] * nxt + Bb[bj][n];
                        asm volatile("" : "+v"(acc[ai][bj][m][n]));
                        __builtin_amdgcn_sched_barrier(0);
                    }
            }
        }
#pragma unroll
        for (int ai = 0; ai < 2; ++ai)
#pragma unroll
            for (int m = 0; m < 4; ++m) { bf16* rowp = ACT + (size_t)(u.pm * 256 + ai * 128 + wr * 64 + m * 16 + fr) * DFF + fbase;
                f32x4 o[2];
#pragma unroll
                for (int n = 0; n < 2; ++n) { const f32x4 g = acc[ai][0][m][n], v = acc[ai][1][m][n];
#pragma unroll
                    for (int e = 0; e < 4; ++e) o[n][e] = g[e] * sigmoid_f(g[e]) * v[e]; }
                *(GAS v4u*)rowp = pack8(o[0], o[1]); __builtin_amdgcn_sched_barrier(0); }
    }
};
struct EpiResidI8 {
    static constexpr bool PERM = true, AFTER_DRAIN = false, MIDK = false;
    float* out; const float* base; const float* gate; const float* rs; float wscale; int pad;
    __device__ __forceinline__ void operator()(AccRef acc, const pg8::Unit& u, int wr, int wc, int fr, int fq) const {
        typedef int i32x4_ __attribute__((ext_vector_type(4)));
        const float* gb = gate + (size_t)(u.pm >> 4) * MODN + u.pn * 256 + wc * 32 + 8 * fq;
        f32x4 gv[2][2];
#pragma unroll
        for (int bj = 0; bj < 2; ++bj)
#pragma unroll
            for (int n = 0; n < 2; ++n) gv[bj][n] = *(const GAS f32x4*)(gb + bj * 128 + n * 4) * wscale;
#pragma unroll
        for (int q = 0; q < 2 * (4 / RESID_BATCH); ++q) { const int ai = q / (4 / RESID_BATCH), m0 = (q % (4 / RESID_BATCH)) * RESID_BATCH;
            const int g0 = u.pm * 256 + ai * 128 + wr * 64 + m0 * 16 + fr; const size_t r0 = (size_t)g0 * D + u.pn * 256 + wc * 32 + 8 * fq; f32x4 bs[RESID_BATCH][2][2]; float rsc[RESID_BATCH];
#pragma unroll
            for (int m = 0; m < RESID_BATCH; ++m) { rsc[m] = rs[g0 + m * 16];
#pragma unroll
                for (int bj = 0; bj < 2; ++bj)
#pragma unroll
                    for (int n = 0; n < 2; ++n) bs[m][bj][n] = NT_LOAD((const GAS f32x4*)(base + r0 + (size_t)(m * 16) * D + bj * 128 + n * 4)); }
#pragma unroll
            for (int m = 0; m < RESID_BATCH; ++m)
#pragma unroll
                for (int bj = 0; bj < 2; ++bj)
#pragma unroll
                    for (int n = 0; n < 2; ++n) { const f32x4 a = acc[ai][bj][m0 + m][n];
                        NT_STORE(bs[m][bj][n] + gv[bj][n] * (__builtin_convertvector(__builtin_bit_cast(i32x4_, a), f32x4) * rsc[m]), (GAS f32x4*)(out + r0 + (size_t)(m * 16) * D + bj * 128 + n * 4)); } }
    }
};
template <bool FP8C> struct InProjOrder {
    static constexpr int NT = FP8C ? NT_IN8 : NT_IN16;
    pg8::StaticOrder base; int G, c;
    __device__ __forceinline__ void init(int G_, int c_) { base.init(M, NT * 256, G_, c_); G = G_; c = c_; }
    __device__ __forceinline__ bool next(int i, pg8::Unit& u) const {
        if (base.next(i, u)) return true;
        constexpr int NCT = V_FP8 ? (FP8C ? 20 : 0) : 10;
        const long e = (long)i * G + c - (long)(M / 256) * NT; if (e < 0 || e >= 4 * NCT) return false;
        u.pm = 64 + (int)(e & 3); const int j = (int)(e >> 2); u.pn = V_FP8 ? (j < 4 ? 8 + j : 16 + j) : (FP8C ? (j < 2 ? 8 + j : 16 + j) : j); return true;
    }
    __device__ __forceinline__ void a_ready(const pg8::Unit&) const {}
    __device__ __forceinline__ void done(const pg8::Unit&) const {}
};

struct EpiNullProbe {
    static constexpr bool PERM = true, AFTER_DRAIN = false, MIDK = false;
    float* O; int flag; int pad;
    __device__ __forceinline__ void operator()(AccRef acc, const pg8::Unit& u, int wr, int wc, int fr, int fq) const {
        f32x4 t = {0.f, 0.f, 0.f, 0.f};
#pragma unroll
        for (int ai = 0; ai < 2; ++ai)
#pragma unroll
            for (int bj = 0; bj < 2; ++bj)
#pragma unroll
                for (int m = 0; m < 4; ++m) t += acc[ai][bj][m][0] + acc[ai][bj][m][1];
        if (flag) O[threadIdx.x] = (t[0] + t[1]) + (t[2] + t[3]);
    }
};
template <int SAME> struct ProbeOrder { pg8::StaticOrder base;
    __device__ __forceinline__ bool next(int i, pg8::Unit& u) const { const bool ok = base.next(i, u); if (SAME & 1) u.pm = 0; if (SAME & 2) u.pn = 0; return ok; }
    __device__ __forceinline__ void a_ready(const pg8::Unit&) const {}
    __device__ __forceinline__ void done(const pg8::Unit&) const {} };
#ifndef P11_WGM
#define P11_WGM 8
#endif
#ifndef TUNE_ALIGN
#define TUNE_ALIGN true
#endif
#ifndef TUNE_SP2
#define TUNE_SP2 true
#endif
static_assert(sizeof(Args) == 22 * 8 + 16, "kernarg layout");
__global__ void __launch_bounds__(NWAVES * 64, 2) fwd(Args args) {
    extern __shared__ __attribute__((aligned(16))) unsigned char lds[];
    Frame F;
    F.lds = (LAS unsigned char*)lds;
    F.MISC = (volatile LAS unsigned*)(F.lds + MISC_OFF);
    F.tid = threadIdx.x; F.lane = F.tid & 63; F.wave = __builtin_amdgcn_readfirstlane(F.tid >> 6);
    F.G = gridDim.x; { const int bx = blockIdx.x; F.vcu = (F.G % 8 == 0) ? (bx % 8) * (F.G / 8) + bx / 8 : bx; }
    F.ctl = (gu32*)(args.ws + WS_CTL);
    for (int u = F.tid; u < (LDS_BYTES - LDSCTL_OFF) / 4; u += NWAVES * 64) ((LAS unsigned*)(F.lds + LDSCTL_OFF))[u] = 0u;
    __syncthreads();
    XcdBarrier bar; bar.bar = (unsigned*)(F.ctl + CW_BAR); bar.x = 0; bar.st = nullptr;
    if (N_LAUNCHES == 1) bar = xcd_barrier_post((unsigned*)(F.ctl + CW_BAR), F.MISC + 8);
#ifdef TPROBE_LO
    unsigned long long t_lo = 0, t_hi = 0; int tcnt = 0;
    if (TPROBE_LO == 0) t_lo = __builtin_amdgcn_s_memrealtime();
#define TSTAMP() do { ++tcnt; const unsigned long long tn = __builtin_amdgcn_s_memrealtime(); if (tcnt == TPROBE_LO) t_lo = tn; if (tcnt == TPROBE_HI) t_hi = tn; } while (0)
#else
#define TSTAMP() do { } while (0)
#endif
#define GRID_BAR() do { if (N_LAUNCHES == 1) xcd_barrier(bar); TSTAMP(); } while (0)
    const int lo = args.ph_lo, hi = args.ph_hi;
#ifndef PH_MASK
#define PH_MASK 0x1fff
#endif
#define IN(k) (((PH_MASK >> (k)) & 1) && lo <= (k) && (k) < hi)
#define BOTH(k) (IN(k) && IN((k) + 1))
#ifndef REP2
#define REP2 0
#endif
#define NREP(k) (((REP2 >> (k)) & 1) ? 2 : 1)
    LAS unsigned char* ring = F.lds + RING_OFF;
    typedef const pg8::bf16_t* cbp;

    if (IN(0)) { p0a_prologue(F); GRID_BAR();
                 p1_norm1(F); __syncthreads(); p0_transpose_runs(F, CW_QUEUE, 0, P0_RUN_SPLIT);
                 if (BOTH(0)) GRID_BAR();
                 if ((INPROJ_MODE == 2 && wq_true(F, 0) > wq_clip(F, 0)) || (WOUT_MODE == 2 && wq_true(F, 1) > wq_clip(F, 1))) {
                     p0_transpose_runs(F, CW_QUEUE5, 0, P0_RUN_UP0, true, P0_RUN_IN1, P0_RUN_OUT0); if (BOTH(0)) GRID_BAR(); } }
    if (IN(2)) { for (int rep = 0; rep < NREP(2); ++rep) {
        { pg8::Gemm g = pg8::gemm_rowmajor((cbp)F.H(), (cbp)F.Win(), M + MC, NT_IN16 * 256, D, D, D); InProjOrder<false> Sd; Sd.init(F.G, (int)blockIdx.x);
          EpiInProj<false> E{F.QO(), F.KA(), F.VA(), F.KB(), F.VB(), F.GA(), F.GB(), nullptr, 1.0f};
          pg8::gemm_phase<EpiInProj<false>, InProjOrder<false>, true, true, 0>(ring, g, Sd, E); }
        { pg8::Gemm g = pg8::gemm_rowmajor((cbp)F.ACT(), (cbp)((unsigned char*)F.Win() + WIN8_OFF), M + MC, NT_IN8 * 256, D / 2, D / 2, D / 2); InProjOrder<true> Sd; Sd.init(F.G, F.G - 1 - (int)blockIdx.x);
          EpiInProj<true> E{F.QO(), F.KA(), F.VA(), F.KB(), F.VB(), F.GA(), F.GB(), F.rsh(), wq_range(F, 0) * (1.0f / 127.0f)};
          pg8::gemm_phase<EpiInProj<true>, InProjOrder<true>, true, true, INPROJ_MODE>(ring, g, Sd, E); }
        if (DEFER_UP_RUNS > 0) { __syncthreads(); p0_transpose_runs(F, CW_QUEUE3, P0_RUN_SPLIT, P0_RUN_DN0); }
        if (BOTH(2)) GRID_BAR();
    } }
    if (IN(3)) { p3_qkfix(F); if (BOTH(3)) GRID_BAR(); }
    if (IN(4)) { p4_attention(F); if (BOTH(4)) GRID_BAR(); }
    if (IN(5)) { for (int rep = 0; rep < NREP(5); ++rep) {
        pg8::Gemm g = BR_FP8 ? pg8::gemm_rowmajor((cbp)F.ACT(), (cbp)F.Wbr(), M, D, 2048, 2048, 2048) : pg8::gemm_rowmajor((cbp)F.QO(), (cbp)F.Wbr(), M, D, 4096, 4096, 4096);
        pg8::StaticOrder Sd; Sd.init(M, D, F.G, (int)blockIdx.x);
        EpiGateMerged E{F.H(), (const unsigned char*)F.GA(), (const unsigned char*)F.GB(), (unsigned char*)F.KB()};
        pg8::gemm_phase<EpiGateMerged, pg8::StaticOrder, true, true, BR_FP8 ? 1 : 0>(ring, g, Sd, E);
        if (BOTH(5)) GRID_BAR();
    } }
    if (IN(6) && WOUT_MODE == 2) { p6_quant_y(F); if (BOTH(6)) GRID_BAR(); }
    if (IN(7)) { for (int rep = 0; rep < NREP(7); ++rep) {
        pg8::StaticOrder Sd; Sd.init(M, D, F.G, (int)blockIdx.x);
        if constexpr (WOUT_MODE == 2) { pg8::Gemm g = pg8::gemm_rowmajor((cbp)F.KB(), (cbp)F.Wout(), M, D, D / 2, D / 2, D / 2);
            EpiResidI8 E{F.out(), F.x(), F.modf() + 2 * D, F.rsy(), wq_range(F, 1) * (1.0f / 127.0f), 0};
            pg8::gemm_phase<EpiResidI8, pg8::StaticOrder, true, true, 2>(ring, g, Sd, E); }
        else if constexpr (WOUT_FP8) { pg8::Gemm g = pg8::gemm_rowmajor((cbp)F.KB(), (cbp)F.Wout(), M, D, D / 2, D / 2, D / 2);
            EpiResid E{F.out(), F.x(), F.modf() + 2 * D, 1.0f / (SC_WOUT * SC_Y), 0};
            pg8::gemm_phase<EpiResid, pg8::StaticOrder, true, true, 1>(ring, g, Sd, E); }
        else { pg8::Gemm g = pg8::gemm_rowmajor((cbp)F.H(), (cbp)F.Wout(), M, D, D, D, D);
            EpiResid E{F.out(), F.x(), F.modf() + 2 * D, 1.0f, 0};
            pg8::gemm_phase<EpiResid, pg8::StaticOrder, true, true, 0>(ring, g, Sd, E); }
        if (BOTH(7)) GRID_BAR();
    } }
    if (IN(8)) { for (int rep = 0; rep < NREP(8); ++rep) { p7_norm2(F); if (BOTH(8)) GRID_BAR(); } }
#ifdef GEMM_PROBE
    if (IN(9)) { pg8::Gemm g = pg8::gemm_rowmajor((cbp)F.QO(), (cbp)F.Wup(), M, F2, D, D, D); ProbeOrder<GEMM_PROBE & 3> Sd; Sd.base.init(M, F2, F.G, (int)blockIdx.x);
        EpiNullProbe E{(float*)F.ACT(), args.pad, 0};
        pg8::gemm_phase<EpiNullProbe, ProbeOrder<GEMM_PROBE & 3>, true, true>(ring, g, Sd, E); GRID_BAR(); }
#endif
    if (IN(9)) { for (int rep = 0; rep < NREP(9); ++rep) {
        pg8::Gemm g = pg8::gemm_rowmajor((cbp)F.QO(), (cbp)F.Wup(), M, F2, D, D, D);
        pg8::StaticOrder Sd; Sd.init(M, F2, F.G, (int)blockIdx.x);
        EpiConvAct E{F.ACT(), (float*)F.Win(), F.conv_w(), F.conv_b(), (LAS f32x4*)(F.lds + XCH_OFF)};
        pg8::gemm_phase<EpiConvAct, pg8::StaticOrder, true, TUNE_SP2>(ring, g, Sd, E);
        __syncthreads(); p0_transpose_runs(F, CW_QUEUE4, P0_RUN_DN0, P0_RUN_END);
        if (BOTH(9)) GRID_BAR();
    } }
    if (IN(10)) { for (int rep = 0; rep < NREP(10); ++rep) { p10_convfix(F); if (BOTH(10)) GRID_BAR(); } }
    if (IN(11)) {
        pg8::Gemm g = pg8::gemm_rowmajor((cbp)F.ACT(), (cbp)F.Wdn(), M, D, DFF, DFF, DFF); pg8::StaticOrder Sd; Sd.init(M, D, F.G, (int)blockIdx.x, P11_WGM);
        EpiResid E{F.out(), F.out(), F.modf() + 5 * D, 1.0f, 0};
        pg8::gemm_phase<EpiResid, pg8::StaticOrder, TUNE_ALIGN, TUNE_SP2>(ring, g, Sd, E);
        if (BOTH(11)) GRID_BAR();
    }
#ifdef TPROBE_LO
    if (IN(12)) { const float us = (float)(long long)(t_hi - t_lo) * 0.01f - (float)TPROBE_OFF; p11_final(F, 1.0f + sqrtf(fmaxf(us, 0.f) * 1e-7f)); }
#else
    if (IN(12)) { p11_final(F); }
#endif
#undef IN
#undef BOTH
#undef GRID_BAR
}

extern "C" void kernel_launch(void* const* d_in, const int* in_sizes, int n_in, void* d_out, int out_size, void* d_ws, size_t ws_size, hipStream_t stream) {
    static int grid = 0;
    if (grid == 0) {
        if (n_in != 20 || in_sizes[0] != M * D || out_size != M * D || ws_size < WS_END) { fprintf(stderr, "kernel_launch: unexpected shapes (n_in %d, in0 %d, out %d, ws %zu < %zu?)\n", n_in, n_in > 0 ? in_sizes[0] : -1, out_size, ws_size, (size_t)WS_END); grid = -1; return; }
        int dev = 0, cus = 0, per_cu = 0;
        if (hipGetDevice(&dev) != hipSuccess || hipDeviceGetAttribute(&cus, hipDeviceAttributeMultiprocessorCount, dev) != hipSuccess) { grid = -1; return; }
        if (hipFuncSetAttribute((const void*)fwd, hipFuncAttributeMaxDynamicSharedMemorySize, LDS_BYTES) != hipSuccess) { fprintf(stderr, "kernel_launch: hipFuncSetAttribute failed\n"); grid = -1; return; }
        if (hipOccupancyMaxActiveBlocksPerMultiprocessor(&per_cu, (const void*)fwd, NWAVES * 64, LDS_BYTES) != hipSuccess || per_cu < 1) fprintf(stderr, "kernel_launch: occupancy query reports %d\n", per_cu);
        (void)hipGetLastError();
        grid = cus < 256 ? cus : 256;
    }
    if (grid < 0) return;
    if (hipMemsetAsync((char*)d_ws + WS_CTL, 0, CTL_ZERO_BYTES, stream) != hipSuccess) return;
    Args a{};
    for (int i = 0; i < 20; ++i) a.in[i] = (const float*)d_in[i];
    a.out = (float*)d_out; a.ws = (unsigned char*)d_ws;
    for (int li = 0; li < N_LAUNCHES; ++li) {
        if (N_LAUNCHES == 1) { a.ph_lo = 0; a.ph_hi = N_PHASES; } else { a.ph_lo = li; a.ph_hi = li + 1; }
        a.li = li;
        hipLaunchKernelGGL(fwd, dim3(grid), dim3(NWAVES * 64), LDS_BYTES, stream, a);
        const hipError_t le = hipPeekAtLastError();
        if (le != hipSuccess) { fprintf(stderr, "kernel_launch: launch %d failed: %s\n", li, hipGetErrorName(le)); break; }
    }
}
```

```cpp
#include <hip/hip_runtime.h>
#include <cstdio>
#include <cstdint>
namespace pg8 {
#define PG8_LAS __attribute__((address_space(3)))
typedef unsigned short bf16_t;
typedef short bf16x8 __attribute__((ext_vector_type(8)));
typedef float f32x4 __attribute__((ext_vector_type(4)));
typedef unsigned u32x4 __attribute__((ext_vector_type(4)));
typedef int i32x8 __attribute__((ext_vector_type(8)));
typedef short s16x16 __attribute__((ext_vector_type(16)));
template <bool FP8> struct Frag { bf16x8 h[2]; };
template <> struct Frag<true> { s16x16 v; };
__device__ __forceinline__ void fset(Frag<false>& f, int k, bf16x8 x) { f.h[k] = x; }
__device__ __forceinline__ void fset(Frag<true>& f, int k, bf16x8 x) { if (k == 0) f.v.lo = x; else f.v.hi = x; }
__device__ __forceinline__ f32x4 fmma(const Frag<false>& b, const Frag<false>& a, f32x4 c) { c = __builtin_amdgcn_mfma_f32_16x16x32_bf16(b.h[0], a.h[0], c, 0, 0, 0); return __builtin_amdgcn_mfma_f32_16x16x32_bf16(b.h[1], a.h[1], c, 0, 0, 0); }
typedef int i32x4 __attribute__((ext_vector_type(4)));
__device__ __forceinline__ f32x4 fmma_i8(const Frag<false>& b, const Frag<false>& a, f32x4 c) {
    i32x4 ci = __builtin_bit_cast(i32x4, c);
    ci = __builtin_amdgcn_mfma_i32_16x16x64_i8(__builtin_bit_cast(i32x4, b.h[0]), __builtin_bit_cast(i32x4, a.h[0]), ci, 0, 0, 0);
    ci = __builtin_amdgcn_mfma_i32_16x16x64_i8(__builtin_bit_cast(i32x4, b.h[1]), __builtin_bit_cast(i32x4, a.h[1]), ci, 0, 0, 0);
    return __builtin_bit_cast(f32x4, ci); }
__device__ __forceinline__ f32x4 fmma(const Frag<true>& b, const Frag<true>& a, f32x4 c) { const int one = 0x7F7F7F7F;
    asm volatile("v_mfma_scale_f32_16x16x128_f8f6f4 %0, %1, %2, %0, %3, %3 op_sel_hi:[0,0,0]" : "+v"(c) : "v"(__builtin_bit_cast(i32x8, b.v)), "v"(__builtin_bit_cast(i32x8, a.v)), "v"(one)); return c; }
constexpr int BM = 256, BK = 64, HALF = 128, HTB = HALF * BK * 2  , STAGE_BYTES = 8 * HTB, NXCD = 8, WGM = 8;

__host__ __device__ __forceinline__ int lds_byte(int r, int c) { const int st = (r >> 4) * 2 + (c >> 5), rr = r & 15, cc = c & 31, ob = rr * 64 + cc * 2; return st * 1024 + (ob ^ (((ob >> 9) & 1) << 5)); }
__host__ __device__ __forceinline__ void stage_rc(int b, int& R, int& C) { const int st = b / 1024, sb = b % 1024, swz = sb ^ (((sb >> 9) & 1) << 5); R = (st >> 1) * 16 + swz / 64; C = (st & 1) * 32 + (swz % 64) / 2; }
__host__ __device__ __forceinline__ int perm32(int rho) { const int n = rho >> 4, i = rho & 15; return 8 * (i >> 2) + 4 * n + (i & 3); }

struct Unit { int pm, pn; };
struct Gemm { const bf16_t* A; const bf16_t* Bt; int M, N, K, lda, ldb; unsigned ksA, ksB; size_t tsA, tsB; };
__host__ __device__ __forceinline__ Gemm gemm_rowmajor(const bf16_t* A, const bf16_t* Bt, int M, int N, int K, int lda, int ldb) { return Gemm{A, Bt, M, N, K, lda, ldb, 128u, 128u, (size_t)512 * lda, (size_t)512 * ldb}; }

struct StaticOrder {
    int nM, nN, nwg, G, c, wgm;
    __host__ __device__ void init(int M, int N, int G_, int c_, int wgm_ = WGM) { nM = M / BM; nN = N / BM; nwg = nM * nN; G = G_; c = c_; wgm = wgm_; }
    __host__ __device__ bool next(int i, Unit& u) const {
        const long L = (long)i * G + c; if (L >= nwg) return false;
        int wgid = (int)L; { const int q = nwg / NXCD, r = nwg % NXCD, xcd = wgid % NXCD, off = wgid / NXCD; wgid = (xcd < r ? xcd * (q + 1) : r * (q + 1) + (xcd - r) * q) + off; }
        const int nig = wgm * nN, gid = wgid / nig, fm = gid * wgm, gsz = (nM - fm) < wgm ? (nM - fm) : wgm;
        u.pm = fm + ((wgid % nig) % gsz); u.pn = (wgid % nig) / gsz; return true;
    }
    __device__ __forceinline__ void a_ready(const Unit&) const {}
    __device__ __forceinline__ void done(const Unit&) const {}
};

template <class Epi, class Sched, bool ALIGN_EPI = false, bool SP2 = false, int MODE = 0  >
__device__ __forceinline__ void gemm_phase(PG8_LAS unsigned char* lds, const Gemm g, const Sched& S, const Epi& E) {
    int tid_o = threadIdx.x; asm volatile("" : "+v"(tid_o));
    const int tid = tid_o, wid = __builtin_amdgcn_readfirstlane(tid >> 6), lane = tid & 63, wr = wid >> 2, wc = wid & 3, fr = lane & 15, fq = lane >> 4;
    const int K = g.K, nt = K / BK;
    unsigned voffA[2], voffB[2];
#pragma unroll
    for (int i = 0; i < 2; ++i) { int R, C; stage_rc(tid * 16 + i * 8192, R, C); const int Rb = Epi::PERM ? ((R & ~31) + perm32(R & 31)) : R;
        voffA[i] = (unsigned)(R * g.lda + C) * 2u; voffB[i] = (unsigned)(Rb * g.ldb + C) * 2u; }
    const size_t kstepA = g.ksA, kstepB = g.ksB;
    const size_t hstepA = (size_t)HALF * g.lda * 2, hstepB = (size_t)HALF * g.ldb * 2;
    const size_t tstepA = g.tsA, tstepB = g.tsB;
    const unsigned ldsw = (unsigned)wid * 1024u;
    const int aoff = lds_byte(wr * 64 + fr, fq * 8), boff = lds_byte(wc * 32 + fr, fq * 8);
#define PG8_SA(b, h) (((b) * 2 + (h)) * HTB)
#define PG8_SB(b, h) ((4 + (b) * 2 + (h)) * HTB)
#define PG8_STAGE(bufoff, gbase, voff) do { _Pragma("unroll") for (int _i = 0; _i < 2; ++_i) \
        __builtin_amdgcn_global_load_lds((const unsigned*)((const char*)(gbase) + (voff)[_i]), (PG8_LAS unsigned*)(lds + (bufoff) + ldsw + _i * 8192), 16, 0, 0); } while (0)
#define PG8_LDA(dst, b, h) do { _Pragma("unroll") for (int m = 0; m < 4; ++m) _Pragma("unroll") for (int k = 0; k < 2; ++k) fset(dst[m], k, *(const PG8_LAS bf16x8*)(lds + PG8_SA(b, h) + aoff + m * 2048 + k * 1024)); } while (0)
#define PG8_LDB(dst, b, h) do { _Pragma("unroll") for (int n = 0; n < 2; ++n) _Pragma("unroll") for (int k = 0; k < 2; ++k) fset(dst[n], k, *(const PG8_LAS bf16x8*)(lds + PG8_SB(b, h) + boff + n * 2048 + k * 1024)); } while (0)
#define PG8_MMA(ai, bj, At, Bt) do { __builtin_amdgcn_s_setprio(1); _Pragma("unroll") for (int m = 0; m < 4; ++m) _Pragma("unroll") for (int n = 0; n < 2; ++n) { if constexpr (MODE == 2) acc[ai][bj][m][n] = fmma_i8(Bt[n], At[m], acc[ai][bj][m][n]); else acc[ai][bj][m][n] = fmma(Bt[n], At[m], acc[ai][bj][m][n]); } __builtin_amdgcn_s_setprio(0); } while (0)
#define PG8_WAIT_V(n) asm volatile("s_waitcnt vmcnt(" #n ")" ::: "memory")
#define PG8_WAIT_L(n) asm volatile("s_waitcnt lgkmcnt(" #n ")" ::: "memory")
#define PG8_BAR __builtin_amdgcn_s_barrier()
#define PG8_SCHED __builtin_amdgcn_sched_barrier(0)
    Unit cur, nxt; int ui = 0;
    if (!S.next(0, cur)) return;
    f32x4 acc[2][2][4][2];
#pragma unroll
    for (int a = 0; a < 2; ++a)
#pragma unroll
        for (int b = 0; b < 2; ++b)
#pragma unroll
            for (int m = 0; m < 4; ++m)
#pragma unroll
                for (int n = 0; n < 2; ++n) acc[a][b][m][n] = (f32x4){0.f, 0.f, 0.f, 0.f};
    constexpr bool FP8 = (MODE == 1);
    Frag<FP8> At[4], B0[2], B1[2];
    const char* cA = (const char*)g.A + (size_t)cur.pm * tstepA; const char* cB = (const char*)g.Bt + (size_t)cur.pn * tstepB;
    S.a_ready(cur);
    if constexpr (SP2) {
        PG8_STAGE(PG8_SB(0, 0), cB, voffB); PG8_STAGE(PG8_SB(0, 1), cB + hstepB, voffB); PG8_STAGE(PG8_SA(0, 0), cA, voffA); PG8_STAGE(PG8_SA(0, 1), cA + hstepA, voffA);
        if (wr == 1) PG8_BAR;
        PG8_WAIT_V(2); PG8_BAR;
        PG8_STAGE(PG8_SB(1, 0), cB + kstepB, voffB); PG8_STAGE(PG8_SA(1, 0), cA + kstepA, voffA); PG8_STAGE(PG8_SB(1, 1), cB + hstepB + kstepB, voffB);
        PG8_WAIT_V(6); PG8_BAR;
    } else {
        PG8_STAGE(PG8_SB(0, 0), cB, voffB); PG8_STAGE(PG8_SA(0, 0), cA, voffA); PG8_STAGE(PG8_SB(0, 1), cB + hstepB, voffB); PG8_STAGE(PG8_SA(0, 1), cA + hstepA, voffA);
        if (wr == 1) PG8_BAR;
        PG8_WAIT_V(4); PG8_BAR;
        PG8_STAGE(PG8_SB(1, 0), cB + kstepB, voffB); PG8_STAGE(PG8_SA(1, 0), cA + kstepA, voffA); PG8_STAGE(PG8_SB(1, 1), cB + hstepB + kstepB, voffB);
        PG8_WAIT_V(6); PG8_BAR;
    }
    for (;;) {
        const bool has_next = S.next(ui + 1, nxt);
        const char* nA = has_next ? (const char*)g.A + (size_t)nxt.pm * tstepA : cA; const char* nB = has_next ? (const char*)g.Bt + (size_t)nxt.pn * tstepB : cB;
        constexpr int NPASS = Epi::MIDK ? 2 : 1;
#pragma unroll
        for (int hp = 0; hp < NPASS; ++hp) {
        const int t_lo = hp == 0 ? 0 : (nt >> 1), t_hi = (NPASS == 2 && hp == 0) ? (nt >> 1) : nt;
        if constexpr (Epi::MIDK) { if (hp == 1) { if constexpr (FP8) asm volatile("s_nop 15\n\ts_nop 15" ::: "memory"); E.mid(acc, cur, wr, wc, fr, fq); } }
        for (int t = t_lo; t < t_hi; t += 2) {
            const bool last = (t == nt - 2);
            const char* a1 = cA + (size_t)(t + 1) * kstepA;
            const char* a2 = last ? nA : cA + (size_t)(t + 2) * kstepA; const char* b2 = last ? nB : cB + (size_t)(t + 2) * kstepB;
            const char* a3 = a2 + kstepA; const char* b3 = b2 + kstepB;
            if (last && has_next) S.a_ready(nxt);
            if constexpr (SP2) {
            PG8_LDB(B0, 0, 0); PG8_LDB(B1, 0, 1); PG8_SCHED; PG8_LDA(At, 0, 0); PG8_STAGE(PG8_SA(1, 1), a1 + hstepA, voffA);
            PG8_WAIT_V(8); PG8_WAIT_L(0); PG8_BAR; PG8_MMA(0, 0, At, B0); PG8_MMA(0, 1, At, B1); PG8_BAR; PG8_SCHED;
            PG8_LDA(At, 0, 1); PG8_STAGE(PG8_SB(0, 0), b2, voffB); PG8_STAGE(PG8_SB(0, 1), b2 + hstepB, voffB); PG8_STAGE(PG8_SA(0, 0), a2, voffA);
            PG8_WAIT_V(8); PG8_WAIT_L(0); PG8_BAR; PG8_MMA(1, 0, At, B0); PG8_MMA(1, 1, At, B1); PG8_BAR; PG8_SCHED;
            PG8_LDB(B0, 1, 0); PG8_LDB(B1, 1, 1); PG8_SCHED; PG8_LDA(At, 1, 0); PG8_STAGE(PG8_SA(0, 1), a2 + hstepA, voffA);
            PG8_WAIT_V(8); PG8_WAIT_L(0); PG8_BAR; PG8_MMA(0, 0, At, B0); PG8_MMA(0, 1, At, B1); PG8_BAR; PG8_SCHED;
            PG8_LDA(At, 1, 1); PG8_STAGE(PG8_SB(1, 0), b3, voffB); PG8_STAGE(PG8_SB(1, 1), b3 + hstepB, voffB); PG8_STAGE(PG8_SA(1, 0), a3, voffA);
            PG8_WAIT_V(8); PG8_WAIT_L(0); PG8_BAR; PG8_MMA(1, 0, At, B0); PG8_MMA(1, 1, At, B1); PG8_BAR; PG8_SCHED;
            } else {
            PG8_LDB(B0, 0, 0); PG8_SCHED; PG8_LDA(At, 0, 0); PG8_STAGE(PG8_SA(1, 1), a1 + hstepA, voffA);
            PG8_WAIT_L(8); PG8_BAR; PG8_WAIT_L(0); PG8_MMA(0, 0, At, B0); PG8_BAR; PG8_SCHED;
            PG8_LDB(B1, 0, 1); PG8_STAGE(PG8_SB(0, 0), b2, voffB);
            PG8_BAR; PG8_WAIT_L(0); PG8_MMA(0, 1, At, B1); PG8_BAR;
            PG8_LDA(At, 0, 1); PG8_STAGE(PG8_SA(0, 0), a2, voffA);
            PG8_BAR; PG8_WAIT_L(0); PG8_MMA(1, 0, At, B0); PG8_BAR; PG8_SCHED;
            PG8_STAGE(PG8_SB(0, 1), b2 + hstepB, voffB);
            PG8_WAIT_V(6); PG8_BAR; PG8_MMA(1, 1, At, B1); PG8_BAR;
            PG8_LDB(B0, 1, 0); PG8_SCHED; PG8_LDA(At, 1, 0); PG8_STAGE(PG8_SA(0, 1), a2 + hstepA, voffA);
            PG8_WAIT_L(8); PG8_BAR; PG8_WAIT_L(0); PG8_MMA(0, 0, At, B0); PG8_BAR; PG8_SCHED;
            PG8_LDB(B1, 1, 1); PG8_STAGE(PG8_SB(1, 0), b3, voffB);
            PG8_BAR; PG8_WAIT_L(0); PG8_MMA(0, 1, At, B1); PG8_BAR;
            PG8_LDA(At, 1, 1); PG8_STAGE(PG8_SA(1, 0), a3, voffA);
            PG8_BAR; PG8_WAIT_L(0); PG8_MMA(1, 0, At, B0); PG8_BAR; PG8_SCHED;
            PG8_STAGE(PG8_SB(1, 1), b3 + hstepB, voffB);
            PG8_WAIT_V(6); PG8_BAR; PG8_MMA(1, 1, At, B1); PG8_BAR;
            }
        }
        }
        if constexpr (ALIGN_EPI) { if (wr == 0) PG8_BAR; }
        if constexpr (FP8) asm volatile("s_nop 15\n\ts_nop 15" ::: "memory");
        if constexpr (!Epi::AFTER_DRAIN) { E(acc, cur, wr, wc, fr, fq); S.done(cur); }
        if (!has_next) break;
#pragma unroll
        for (int a = 0; a < 2; ++a)
#pragma unroll
            for (int b = 0; b < 2; ++b)
#pragma unroll
                for (int m = 0; m < 4; ++m)
#pragma unroll
                    for (int n = 0; n < 2; ++n) acc[a][b][m][n] = (f32x4){0.f, 0.f, 0.f, 0.f};
        cur = nxt; cA = nA; cB = nB; ++ui;
        if constexpr (ALIGN_EPI) { if (wr == 1) PG8_BAR; }
    }
    PG8_WAIT_V(0);
    if constexpr (!ALIGN_EPI) { if (wr == 0) PG8_BAR; }
    PG8_BAR;
    if constexpr (Epi::AFTER_DRAIN) { E.fused(acc, cur, wr, wc, fr, fq, lds, wid, lane); S.done(cur); }
#undef PG8_SA
#undef PG8_SB
#undef PG8_STAGE
#undef PG8_LDA
#undef PG8_LDB
#undef PG8_MMA
#undef PG8_WAIT_V
#undef PG8_WAIT_L
#undef PG8_BAR
#undef PG8_SCHED
}
}

constexpr int D = 4096, NB = 4, S = 4096, L = 256, HD = 128, HA = 16, KVA = 4, HB = 16, GQ = HA / KVA;
constexpr int NIN = 17408, DFF = 11008, F2 = 2 * DFF, GW = 64, KT = L + S;
constexpr int M = NB * S, MC = NB * L;
constexpr int MODN = 6 * D, MOD_SPLIT = 8, MOD_KC = D / MOD_SPLIT, MOD_WAVES = 3;
constexpr float EPS = 1e-6f;
constexpr float SCALE = 0.088388347648318440f;
constexpr int NT_IN = NIN / 256;
constexpr float SC_WIN = 64.f, SC_WOUT = 64.f, SC_Y = 16.f;
#ifndef INPROJ_MODE_DEF
#define INPROJ_MODE_DEF 2
#endif
constexpr int INPROJ_MODE = INPROJ_MODE_DEF;
#ifndef TILED_B
#define TILED_B 1
#endif
#ifndef QFIX_ATT_DEF
#define QFIX_ATT_DEF 1
#endif
constexpr bool QFIX_ATT = QFIX_ATT_DEF;
#ifndef BR_FP8_DEF
#define BR_FP8_DEF 1
#endif
constexpr bool BR_FP8 = BR_FP8_DEF;
constexpr float SC_OA = 32.f, SC_OB = 16.f, SC_WBR = 32.f;
#ifndef WOUT_MODE_DEF
#define WOUT_MODE_DEF 2
#endif
constexpr int WOUT_MODE = WOUT_MODE_DEF;
constexpr bool WOUT_FP8 = (WOUT_MODE == 1);
constexpr bool V_FP8 = true;
constexpr int NT_IN16 = V_FP8 ? 0 : 10, NT_IN8 = V_FP8 ? 68 : 58;
__host__ __device__ constexpr bool inproj_is_fp8(int pn) { return V_FP8 || !(pn == 10 || pn == 11 || (pn >= 28 && pn < 36)); }
__host__ __device__ constexpr int inproj_local_tile(int pn) { return V_FP8 ? pn : (inproj_is_fp8(pn) ? (pn < 10 ? pn : (pn < 28 ? pn - 2 : pn - 10)) : (pn < 12 ? pn - 10 : pn - 26)); }
__host__ __device__ constexpr int inproj_global_tile(bool fp8, int t) { return V_FP8 ? t : (fp8 ? (t < 10 ? t : (t < 26 ? t + 2 : t + 10)) : (t < 2 ? 10 + t : 26 + t)); }
constexpr size_t WIN8_OFF = (size_t)NT_IN16 * 256 * D * 2;

constexpr size_t MiB = 1u << 20;
constexpr size_t WS_CTL = 0, CTL_ZERO_BYTES = 1 * MiB;
constexpr size_t WS_MODP = 266 * MiB;
constexpr size_t WS_MODF = 5 * MiB;
constexpr size_t WS_ROPE = 6 * MiB;
constexpr size_t WS_RSH = 7 * MiB;
constexpr size_t WS_RSY = 7 * MiB + 256 * 1024;
constexpr size_t WS_WUP = 8 * MiB;
constexpr size_t WS_WDN = 180 * MiB;
constexpr size_t WS_QO = 266 * MiB;
constexpr size_t WS_WIN = 394 * MiB;
constexpr size_t WS_WBR = 530 * MiB;
constexpr size_t WS_WOUT = 562 * MiB;
constexpr size_t WS_H = 594 * MiB;
constexpr size_t WS_KA = 730 * MiB;
constexpr size_t WS_VA = 747 * MiB;
constexpr size_t WS_KB = 764 * MiB;
constexpr size_t WS_VB = 832 * MiB;
constexpr size_t WS_GA = 900 * MiB;
constexpr size_t WS_GB = 1028 * MiB;
constexpr size_t WS_U = 394 * MiB;
constexpr size_t WS_ACT = 1156 * MiB;
constexpr size_t WS_END = 1500 * MiB;
static_assert(WS_U + (size_t)M * F2 * 2 <= WS_ACT && WS_GB + (size_t)M * D * 2 <= WS_ACT && WS_ACT + (size_t)M * DFF * 2 <= WS_END, "d_ws map");
static_assert(WS_WUP + (size_t)F2 * D * 2 <= WS_WDN && WS_WDN + (size_t)D * DFF * 2 <= WS_QO && WS_QO + (size_t)M * 4096 * 2 <= WS_WIN && WS_WIN + (size_t)NIN * D * 2 <= WS_WBR, "d_ws map 2");
static_assert(WS_H + (size_t)(M + MC) * D * 2 <= WS_KA && WS_KA + (size_t)NB * KT * 512 * 2 <= WS_VA && WS_VA + (size_t)NB * KT * 512 * 2 <= WS_KB && WS_KB + (size_t)NB * KT * 2048 * 2 <= WS_VB && WS_VB + (size_t)NB * KT * 2048 * 2 <= WS_GA, "d_ws map 3");
constexpr int CW_BAR = 4096;
constexpr int CW_QUEUE = 8192;
constexpr int CW_QUEUE3 = 8448, CW_QUEUE4 = 8512;
constexpr int CW_TMAX = 8576, CW_TMAX2 = 8640, CW_QUEUE5 = 8704;
constexpr int CW_QUEUE2 = 8256, CW_WMAX = 8320, CW_WMAX2 = 8384;

constexpr int RING_OFF = 0, RING_BYTES = 131072;
constexpr int LDSCTL_OFF = RING_BYTES, MISC_OFF = LDSCTL_OFF + 320;
constexpr int LDS_BYTES = 147456;
constexpr int NWAVES = 8;

#ifndef MK_N_LAUNCHES
#define MK_N_LAUNCHES 1
#endif
constexpr int N_PHASES = 13;
constexpr int N_LAUNCHES = MK_N_LAUNCHES;

#define GAS __attribute__((address_space(1)))
#define LAS __attribute__((address_space(3)))
typedef unsigned short bf16;
typedef unsigned v4u __attribute__((ext_vector_type(4)));
typedef unsigned v2u __attribute__((ext_vector_type(2)));
typedef float f32x4 __attribute__((ext_vector_type(4)));
typedef float f32x2 __attribute__((ext_vector_type(2)));
typedef GAS unsigned gu32;
#define RLX_AGENT __ATOMIC_RELAXED, __HIP_MEMORY_SCOPE_AGENT
#define LDS_WAIT() asm volatile("s_waitcnt lgkmcnt(0)" ::: "memory")
#define VM_WAIT() asm volatile("s_waitcnt vmcnt(0)" ::: "memory")
__device__ __forceinline__ unsigned pk2(float lo, float hi) { unsigned r; asm volatile("v_cvt_pk_bf16_f32 %0, %1, %2" : "=v"(r) : "v"(lo), "v"(hi)); return r; }
__device__ __forceinline__ unsigned pk4_fp8(float a, float b, float c, float d) { int w = 0; w = __builtin_amdgcn_cvt_pk_fp8_f32(a, b, w, false); w = __builtin_amdgcn_cvt_pk_fp8_f32(c, d, w, true); return (unsigned)w; }
__device__ __forceinline__ unsigned pk4_i8(float a, float b, float c, float d) {
    const int q0 = __float2int_rn(a), q1 = __float2int_rn(b), q2 = __float2int_rn(c), q3 = __float2int_rn(d);
    return (unsigned)(q0 & 255) | ((unsigned)(q1 & 255) << 8) | ((unsigned)(q2 & 255) << 16) | ((unsigned)q3 << 24); }
__device__ __forceinline__ unsigned pk4_u8(float a, float b, float c, float d) {
    const int q0 = __float2int_rn(a), q1 = __float2int_rn(b), q2 = __float2int_rn(c), q3 = __float2int_rn(d);
    return (unsigned)q0 | ((unsigned)q1 << 8) | ((unsigned)q2 << 16) | ((unsigned)q3 << 24); }
__device__ __forceinline__ float ub(unsigned w, int e) { return (float)((w >> (8 * e)) & 255u); }
__device__ __forceinline__ float bf_lo(unsigned w) { return __uint_as_float(w << 16); }
__device__ __forceinline__ float bf_hi(unsigned w) { return __uint_as_float(w & 0xffff0000u); }
__device__ __forceinline__ float sigmoid_f(float x) { return __builtin_amdgcn_rcpf(1.0f + __expf(-x)); }
__device__ __forceinline__ float wave_sum(float v) {
#pragma unroll
    for (int o = 1; o < 64; o <<= 1) v += __shfl_xor(v, o);
    return v;
}

#define XB_TMO      128
#define XB_XCNT(j)  (256  + 64 * (j))
#define XB_XSUB(j)  (1280 + 64 * (j))
#define XB_XGEN(j)  (2304 + 64 * (j))
#define XB_TOP      3328
#define XB_TOPGEN   3392
#define XCD_BAR_WORDS 3456
#define XB_SPIN_CAP (1u << 18)
__device__ __forceinline__ unsigned xb_ld(unsigned* p)              { return __hip_atomic_load(p, __ATOMIC_RELAXED, __HIP_MEMORY_SCOPE_AGENT); }
__device__ __forceinline__ unsigned xb_add(unsigned* p, unsigned v) { return __hip_atomic_fetch_add(p, v, __ATOMIC_RELAXED, __HIP_MEMORY_SCOPE_AGENT); }
__device__ __forceinline__ unsigned xb_xcc_id() { return (unsigned)__builtin_amdgcn_s_getreg((3 << 11) | 20) & 0xFu; }
#define XB_SPIN(cond, bar) do { unsigned _sp = 0; while (cond) { __builtin_amdgcn_s_sleep(1); \
    if ((++_sp & 255u) == 0u) { if (xb_ld(&(bar)[XB_TMO])) break; if (_sp > XB_SPIN_CAP) { atomicAdd(&(bar)[XB_TMO], 1u); break; } } } } while (0)
struct XcdBarrier { unsigned* bar; unsigned x; volatile LAS unsigned* st; };
__device__ __forceinline__ XcdBarrier xcd_barrier_post(unsigned* bar, volatile LAS unsigned* st) {
    XcdBarrier b; b.bar = bar; b.x = xb_xcc_id(); b.st = st;
    if (threadIdx.x == 0) (void)xb_add(&bar[XB_XCNT(b.x)], 1u);
    return b;
}
__device__ __forceinline__ void xcd_barrier_complete(unsigned* bar, unsigned x, unsigned& nloc, unsigned& nx) {
    const unsigned G = gridDim.x * gridDim.y * gridDim.z;
    unsigned sum, cnt, mine, sp = 0u;
    for (;;) {
        sum = 0u; cnt = 0u; mine = 0u;
#pragma unroll
        for (unsigned j = 0; j < 16; ++j) { const unsigned c = xb_ld(&bar[XB_XCNT(j)]); sum += c; cnt += (c > 0u) ? 1u : 0u; mine = (j == x) ? c : mine; }
        if (sum == G) break;
        __builtin_amdgcn_s_sleep(1);
        if ((++sp & 255u) == 0u) { if (xb_ld(&bar[XB_TMO])) break; if (sp > XB_SPIN_CAP) { atomicAdd(&bar[XB_TMO], 1u); break; } }
    }
    nloc = mine > 0u ? mine : 1u; nx = cnt > 0u ? cnt : 1u;
}
__device__ __forceinline__ void xcd_barrier(const XcdBarrier& b) {
    asm volatile("s_waitcnt vmcnt(0)" ::: "memory");
    __syncthreads();
    if (threadIdx.x == 0) {
        unsigned* bar = b.bar;
        __builtin_amdgcn_s_waitcnt(0);
        unsigned nloc = b.st[0], nx = b.st[1];
        if (nloc == 0u) { xcd_barrier_complete(bar, b.x, nloc, nx); b.st[0] = nloc; b.st[1] = nx; }
        const unsigned old = xb_add(&bar[XB_XSUB(b.x)], 1u);
        const unsigned gen = old / nloc;
        if (old + 1u == (gen + 1u) * nloc) {
            __builtin_amdgcn_fence(__ATOMIC_RELEASE, "agent");
            asm volatile("s_waitcnt vmcnt(0)" ::: "memory");
            const unsigned og = xb_add(&bar[XB_TOP], 1u);
            const unsigned tg = og / nx;
            if (og + 1u == (tg + 1u) * nx) xb_add(&bar[XB_TOPGEN], 1u);
            else XB_SPIN(xb_ld(&bar[XB_TOPGEN]) == tg, bar);
            __builtin_amdgcn_fence(__ATOMIC_ACQUIRE, "agent");
            xb_add(&bar[XB_XGEN(b.x)], 1u);
            asm volatile("s_waitcnt vmcnt(0)" ::: "memory");
        } else {
            XB_SPIN(xb_ld(&bar[XB_XGEN(b.x)]) == gen, bar);
            __builtin_amdgcn_fence(__ATOMIC_ACQUIRE, "agent");
            asm volatile("s_waitcnt vmcnt(0)" ::: "memory");
        }
    }
    __syncthreads();
}

struct Args { const float* in[20]; float* out; unsigned char* ws; int ph_lo, ph_hi, li, pad; };
__device__ __forceinline__ const float* karg_in(int i) { return *(const float* const volatile __attribute__((address_space(4)))*)((const __attribute__((address_space(4))) char*)__builtin_amdgcn_kernarg_segment_ptr() + 8 * i); }
__device__ __forceinline__ unsigned char* karg_ws() { return (unsigned char*)karg_in(21); }
struct Frame {
    LAS unsigned char* lds;
    volatile LAS unsigned* MISC;
    gu32* ctl;
    int tid, lane, wave;
    int vcu, G;
#define KIN(name, i) __device__ __forceinline__ const float* name() const { return karg_in(i); }
    KIN(x, 0) KIN(c, 1) KIN(ctx, 2) KIN(cctx, 3) KIN(ada_w, 4) KIN(ada_b, 5) KIN(norm1_g, 6) KIN(w_in, 7) KIN(qnorm, 8) KIN(knorm, 9) KIN(rpb, 10) KIN(w_br_a, 11) KIN(w_br_b, 12) KIN(w_out, 13)
    KIN(norm2_g, 14) KIN(w_up, 15) KIN(conv_w, 16) KIN(conv_b, 17) KIN(w_down, 18) KIN(final_g, 19)
#undef KIN
    __device__ __forceinline__ float* out() const { return (float*)karg_in(20); }
#define KWS(T, name, off) __device__ __forceinline__ T* name() const { return (T*)(karg_ws() + (off)); }
    KWS(float, modp, WS_MODP) KWS(float, modf, WS_MODF) KWS(float2, rope, WS_ROPE) KWS(float, rsh, WS_RSH) KWS(float, rsy, WS_RSY)
    KWS(bf16, Wup, WS_WUP) KWS(bf16, Wdn, WS_WDN) KWS(bf16, QO, WS_QO) KWS(bf16, Win, WS_WIN) KWS(bf16, Wbr, WS_WBR) KWS(bf16, Wout, WS_WOUT) KWS(bf16, H, WS_H)
    KWS(bf16, KA, WS_KA) KWS(bf16, VA, WS_VA) KWS(bf16, KB, WS_KB) KWS(bf16, VB, WS_VB) KWS(bf16, GA, WS_GA) KWS(bf16, GB, WS_GB) KWS(bf16, U, WS_U) KWS(bf16, ACT, WS_ACT)
#undef KWS
};

__device__ __forceinline__ void p0_mod_item(Frame& F, LAS float* sv, int item) {
    const int kc = item / (MODN / 256), nb = item % (MODN / 256), k0 = kc * MOD_KC;
    const float* cc = F.c(); const float* cx = F.cctx();
    for (int i = F.lane; i < 5 * MOD_KC; i += 64) { const int r = i / MOD_KC, k = i % MOD_KC; const float v = (r < 4) ? cc[r * D + k0 + k] : cx[k0 + k]; sv[i] = v * sigmoid_f(v); }
    LDS_WAIT(); asm volatile("" ::: "memory");
    f32x4 a0 = {0.f, 0.f, 0.f, 0.f}, a1 = a0, a2 = a0, a3 = a0, a4 = a0;
    const GAS f32x4* wp = (const GAS f32x4*)(F.ada_w() + (size_t)k0 * MODN + 256 * nb) + F.lane;
#pragma unroll 16
    for (int k = 0; k < MOD_KC; ++k) { const f32x4 w = wp[(size_t)k * (MODN / 4)];
        a0 += sv[k] * w; a1 += sv[MOD_KC + k] * w; a2 += sv[2 * MOD_KC + k] * w; a3 += sv[3 * MOD_KC + k] * w; a4 += sv[4 * MOD_KC + k] * w; }
    GAS f32x4* o = (GAS f32x4*)(F.modp() + (size_t)kc * 5 * MODN + 256 * nb) + F.lane;
    o[0] = a0; o[MODN / 4] = a1; o[2 * (MODN / 4)] = a2; o[3 * (MODN / 4)] = a3; o[4 * (MODN / 4)] = a4;
    LDS_WAIT(); asm volatile("" ::: "memory");
}
struct TItem { const float* src; unsigned char* dst; int N, ldT, fp8; float scale; };
constexpr int P0_NBW = 8, P0_KBL = 16;
constexpr int P0_BLK_IN = (D / 64 / P0_KBL) * (NIN / 32 / P0_NBW), P0_BLK_BR = (2048 / 64 / P0_KBL) * (D / 32 / P0_NBW), P0_BLK_OUT = (D / 64 / P0_KBL) * (D / 32 / P0_NBW), P0_BLK_UP = (D / 64 / P0_KBL) * (F2 / 32 / P0_NBW), P0_BLK_DN = ((DFF / 64 + P0_KBL - 1) / P0_KBL) * (D / 32 / P0_NBW);
static_assert((NIN / 32) % P0_NBW == 0 && (F2 / 32) % P0_NBW == 0 && (D / 32) % P0_NBW == 0 && (2048 / 64) % P0_KBL == 0, "P0 block shape");
constexpr int P0_NBLK = P0_BLK_IN + 2 * P0_BLK_BR + P0_BLK_OUT + P0_BLK_UP + P0_BLK_DN;
struct TRun { int mat, kb0, nb; };
__device__ __forceinline__ void p0_run_of(int blk, int slot, TRun& r) {
    int nbg_per;
    if (blk < P0_BLK_IN) { r.mat = 0; nbg_per = NIN / 32 / P0_NBW; }
    else if ((blk -= P0_BLK_IN) < P0_BLK_BR) { r.mat = 1; nbg_per = D / 32 / P0_NBW; }
    else if ((blk -= P0_BLK_BR) < P0_BLK_BR) { r.mat = 2; nbg_per = D / 32 / P0_NBW; }
    else if ((blk -= P0_BLK_BR) < P0_BLK_OUT) { r.mat = 3; nbg_per = D / 32 / P0_NBW; }
    else if ((blk -= P0_BLK_OUT) < P0_BLK_UP) { r.mat = 4; nbg_per = F2 / 32 / P0_NBW; }
    else { blk -= P0_BLK_UP; r.mat = 5; nbg_per = D / 32 / P0_NBW; }
    r.kb0 = (blk / nbg_per) * P0_KBL; r.nb = (blk % nbg_per) * P0_NBW + slot;
}
__device__ __forceinline__ bool p0_decode(Frame& F, int mat, int kb, int nb, TItem& t, float win_qscale, float wout_qscale) {
    t.fp8 = 0; t.scale = 1.0f;
    if (mat == 0) { const int pn = nb >> 3, nbd = inproj_local_tile(pn) * 8 + (nb & 7);
        t.src = F.w_in() + (size_t)(64 * kb) * NIN + 32 * nb; t.N = NIN;
        if (inproj_is_fp8(pn)) { t.dst = (unsigned char*)F.Win() + WIN8_OFF + (size_t)(32 * nbd) * D + 64 * kb; t.ldT = D; t.fp8 = INPROJ_MODE; t.scale = INPROJ_MODE == 2 ? win_qscale : SC_WIN; }
        else { t.dst = (unsigned char*)F.Win() + ((size_t)(32 * nbd) * D + 64 * kb) * 2; t.ldT = 2 * D; }
        return true; }
    if (mat == 1 || mat == 2) { const int second = mat - 1;
        t.src = (second ? F.w_br_b() : F.w_br_a()) + (size_t)(64 * kb) * D + 32 * nb; t.N = D;
        if (BR_FP8) { t.dst = (unsigned char*)F.Wbr() + (size_t)(32 * nb) * 4096 + second * 2048 + 64 * kb; t.ldT = 4096; t.fp8 = 1; t.scale = SC_WBR; }
        else { t.dst = (unsigned char*)F.Wbr() + ((size_t)(32 * nb) * 4096 + second * 2048 + 64 * kb) * 2; t.ldT = 2 * 4096; }
        return true; }
    if (mat == 3) { t.src = F.w_out() + (size_t)(64 * kb) * D + 32 * nb; t.N = D;
        if (WOUT_MODE) { t.dst = (unsigned char*)F.Wout() + (size_t)(32 * nb) * D + 64 * kb; t.ldT = D; t.fp8 = WOUT_MODE; t.scale = WOUT_MODE == 2 ? wout_qscale : SC_WOUT; }
        else { t.dst = (unsigned char*)F.Wout() + ((size_t)(32 * nb) * D + 64 * kb) * 2; t.ldT = 2 * D; }
        return true; }
    if (mat == 4) { const int fb = nb < DFF / 32 ? nb : nb - DFF / 32, nbd = (fb >> 2) * 8 + (nb < DFF / 32 ? 0 : 4) + (fb & 3);
        t.src = F.w_up() + (size_t)(64 * kb) * F2 + 32 * nb; t.N = F2; t.dst = (unsigned char*)F.Wup() + ((size_t)(32 * nbd) * D + 64 * kb) * 2; t.ldT = 2 * D; return true; }
    if (kb >= DFF / 64) return false;
    t.src = F.w_down() + (size_t)(64 * kb) * D + 32 * nb; t.N = D; t.dst = (unsigned char*)F.Wdn() + ((size_t)(32 * nb) * DFF + 64 * kb) * 2; t.ldT = 2 * DFF; return true;
}
__device__ __forceinline__ void p0_load(const TItem& t, float (&v)[32], int lane) {
    const float* p = t.src + (size_t)(lane >> 5) * t.N + (lane & 31);
#pragma unroll
    for (int i = 0; i < 32; ++i) v[i] = p[(size_t)(2 * i) * t.N];
}
#ifndef WQ_MARGIN
#define WQ_MARGIN 1.3f
#endif
constexpr int WQ_SAMPLE = 8;
__device__ __forceinline__ float wq_clip(Frame& F, int k) { return WQ_MARGIN * __uint_as_float(__hip_atomic_load((unsigned*)(F.ctl + (k ? CW_WMAX2 : CW_WMAX)), RLX_AGENT)); }
__device__ __forceinline__ float wq_true(Frame& F, int k) { return __uint_as_float(__hip_atomic_load((unsigned*)(F.ctl + (k ? CW_TMAX2 : CW_TMAX)), RLX_AGENT)); }
__device__ __forceinline__ float wq_range(Frame& F, int k) { const float c = wq_clip(F, k), t = wq_true(F, k); return t > c ? t : c; }
__device__ __forceinline__ void p0a_prologue(Frame& F) {
    LAS float* scr = (LAS float*)(F.lds + RING_OFF + F.wave * 16384);
    { const int gt = F.vcu * (NWAVES * 64) + F.tid; if (gt < 64 * 32) { const int pos = gt >> 5, i = gt & 31; const float fr = powf(10000.0f, -(float)i / 32.0f), a = (float)pos * fr; F.rope()[gt] = make_float2(cosf(a), sinf(a)); } }
    if (F.wave < MOD_WAVES) { for (int item = F.vcu * MOD_WAVES + F.wave; item < MOD_SPLIT * (MODN / 256); item += MOD_WAVES * F.G) p0_mod_item(F, scr, item); }
    if (INPROJ_MODE == 2 || WOUT_MODE == 2) {
        constexpr int NCH1 = INPROJ_MODE == 2 ? (int)((size_t)D * NIN / 16384 / WQ_SAMPLE) : 0, NCH2 = WOUT_MODE == 2 ? (int)((size_t)D * D / 16384 / WQ_SAMPLE) : 0;
        const GAS f32x4* w1 = (const GAS f32x4*)F.w_in(); const GAS f32x4* w2 = (const GAS f32x4*)F.w_out(); float m1 = 0.f, m2 = 0.f;
        for (;;) {
            int ch = 0; if (F.lane == 0) ch = (int)__hip_atomic_fetch_add((unsigned*)(F.ctl + CW_QUEUE2), 1u, RLX_AGENT);
            ch = __builtin_amdgcn_readfirstlane(ch);
            if (ch >= NCH1 + NCH2) break;
            const bool second = ch >= NCH1; const GAS f32x4* p = (second ? w2 + (size_t)(ch - NCH1) * (4096 * WQ_SAMPLE) : w1 + (size_t)ch * (4096 * WQ_SAMPLE)) + F.lane; f32x4 v[8]; float m = 0.f;
#pragma unroll
            for (int h = 0; h < 8; ++h) {
#pragma unroll
                for (int i = 0; i < 8; ++i) v[i] = p[(h * 8 + i) * 64];
#pragma unroll
                for (int i = 0; i < 8; ++i) m = fmaxf(m, fmaxf(fmaxf(fabsf(v[i].x), fabsf(v[i].y)), fmaxf(fabsf(v[i].z), fabsf(v[i].w)))); }
            if (second) m2 = fmaxf(m2, m); else m1 = fmaxf(m1, m);
        }
#pragma unroll
        for (int o = 1; o < 64; o <<= 1) { m1 = fmaxf(m1, __shfl_xor(m1, o)); m2 = fmaxf(m2, __shfl_xor(m2, o)); }
        if (F.lane == 0) { if (NCH1) __hip_atomic_fetch_max((unsigned*)(F.ctl + CW_WMAX), __float_as_uint(m1), RLX_AGENT);
                           if (NCH2) __hip_atomic_fetch_max((unsigned*)(F.ctl + CW_WMAX2), __float_as_uint(m2), RLX_AGENT); }
    }
}
#ifndef DEFER_UP_RUNS
#define DEFER_UP_RUNS 1024
#endif
constexpr int P0_RUN_UP0 = (P0_BLK_IN + 2 * P0_BLK_BR + P0_BLK_OUT) * P0_NBW, P0_RUN_DN0 = P0_RUN_UP0 + P0_BLK_UP * P0_NBW, P0_RUN_END = P0_NBLK * P0_NBW, P0_RUN_SPLIT = P0_RUN_DN0 - DEFER_UP_RUNS;
static_assert(DEFER_UP_RUNS >= 0 && DEFER_UP_RUNS <= P0_BLK_UP * P0_NBW, "deferred w_up runs");
constexpr int P0_RUN_IN1 = P0_BLK_IN * P0_NBW, P0_RUN_OUT0 = (P0_BLK_IN + 2 * P0_BLK_BR) * P0_NBW;
__device__ __forceinline__ void p0_transpose_runs(Frame& F, int qw, int run_lo, int run_hi, bool exact = false, int skip_lo = 0, int skip_hi = 0) {
    LAS float* scr = (LAS float*)(F.lds + RING_OFF + F.wave * 16384);
    const float win_qscale = INPROJ_MODE == 2 ? 127.0f / fmaxf(exact ? wq_range(F, 0) : wq_clip(F, 0), 1e-30f) : 1.0f;
    const float wout_qscale = WOUT_MODE == 2 ? 127.0f / fmaxf(exact ? wq_range(F, 1) : wq_clip(F, 1), 1e-30f) : 1.0f;
    float tm1 = 0.f, tm2 = 0.f;
    int lane = F.lane; asm volatile("" : "+v"(lane));
    const int c = lane & 7;
    for (;;) {
        int run = 0; if (lane == 0) run = (int)__hip_atomic_fetch_add((unsigned*)(F.ctl + qw), 1u, RLX_AGENT);
        run = run_lo + __builtin_amdgcn_readfirstlane(run);
        if (run >= run_hi) break;
        if (run >= skip_lo && run < skip_hi) continue;
        TRun R; p0_run_of(run / P0_NBW, run % P0_NBW, R);
        TItem cur, nxt; float v[32]; float tm = 0.f;
        bool have = p0_decode(F, R.mat, R.kb0, R.nb, cur, win_qscale, wout_qscale); if (have) p0_load(cur, v, lane);
        for (int j = 0; j < P0_KBL; ++j) {
            if (have) {
#pragma unroll
                for (int i = 0; i < 32; ++i) { scr[(2 * i + (lane >> 5)) * 33 + (lane & 31)] = v[i] * cur.scale; tm = fmaxf(tm, fabsf(v[i])); }
                LDS_WAIT(); asm volatile("" ::: "memory"); }
            nxt = cur; const bool more = (j + 1 < P0_KBL) && p0_decode(F, R.mat, R.kb0 + j + 1, R.nb, nxt, win_qscale, wout_qscale);
            if (more) p0_load(nxt, v, lane);
            if (have) {
#pragma unroll
                for (int q = 0; q < 4; ++q) { const int n = (lane >> 3) + 8 * q; const LAS float* sp = scr + (8 * c) * 33 + n;
                    if (cur.fp8 == 2) { v2u o; o.x = pk4_i8(sp[0 * 33], sp[1 * 33], sp[2 * 33], sp[3 * 33]); o.y = pk4_i8(sp[4 * 33], sp[5 * 33], sp[6 * 33], sp[7 * 33]); *(GAS v2u*)(cur.dst + (size_t)n * cur.ldT + 8 * c) = o; }
                    else if (cur.fp8) { v2u o; o.x = pk4_fp8(sp[0 * 33], sp[1 * 33], sp[2 * 33], sp[3 * 33]); o.y = pk4_fp8(sp[4 * 33], sp[5 * 33], sp[6 * 33], sp[7 * 33]); *(GAS v2u*)(cur.dst + (size_t)n * cur.ldT + 8 * c) = o; }
                    else { v4u o; o.x = pk2(sp[0 * 33], sp[1 * 33]); o.y = pk2(sp[2 * 33], sp[3 * 33]); o.z = pk2(sp[4 * 33], sp[5 * 33]); o.w = pk2(sp[6 * 33], sp[7 * 33]); *(GAS v4u*)(cur.dst + (size_t)n * cur.ldT + 16 * c) = o; } }
                LDS_WAIT(); asm volatile("" ::: "memory"); }
            cur = nxt; have = more;
        }
        if (R.mat == 0) tm1 = fmaxf(tm1, tm); else if (R.mat == 3) tm2 = fmaxf(tm2, tm);
    }
    if ((INPROJ_MODE == 2 || WOUT_MODE == 2) && run_lo < P0_RUN_UP0) {
#pragma unroll
        for (int o = 1; o < 64; o <<= 1) { tm1 = fmaxf(tm1, __shfl_xor(tm1, o)); tm2 = fmaxf(tm2, __shfl_xor(tm2, o)); }
        if (lane == 0) { if (INPROJ_MODE == 2 && tm1 > 0.f) __hip_atomic_fetch_max((unsigned*)(F.ctl + CW_TMAX), __float_as_uint(tm1), RLX_AGENT);
                         if (WOUT_MODE == 2 && tm2 > 0.f) __hip_atomic_fetch_max((unsigned*)(F.ctl + CW_TMAX2), __float_as_uint(tm2), RLX_AGENT); }
    }
}

template <int OUT_MODE  , bool HAS_B, int NDELTA = 0>
__device__ __forceinline__ void norm_row(const float* xrow, void* orow, const LAS float* A, const LAS float* B, int lane, void* orow8 = nullptr, float* rs = nullptr, const bf16* d1row = nullptr, const bf16* d2row = nullptr) {
    const GAS f32x4* xr = (const GAS f32x4*)xrow + lane;
    f32x4 v[16]; float s = 0.f;
#pragma unroll
    for (int j = 0; j < 16; ++j) { v[j] = xr[64 * j];
        if (NDELTA >= 1) { const v2u w = ((const GAS v2u*)d1row)[lane + 64 * j]; v[j].x += bf_lo(w.x); v[j].y += bf_hi(w.x); v[j].z += bf_lo(w.y); v[j].w += bf_hi(w.y); }
        if (NDELTA >= 2) { const v2u w = ((const GAS v2u*)d2row)[lane + 64 * j]; v[j].x += bf_lo(w.x); v[j].y += bf_hi(w.x); v[j].z += bf_lo(w.y); v[j].w += bf_hi(w.y); }
        s += (v[j].x * v[j].x + v[j].y * v[j].y) + (v[j].z * v[j].z + v[j].w * v[j].w); }
    const float rstd = 1.0f / sqrtf(wave_sum(s) * (1.0f / D) + EPS);
#pragma unroll
    for (int j = 0; j < 16; ++j) {
        const f32x4 a = ((const LAS f32x4*)A)[lane + 64 * j]; f32x4 o = v[j] * rstd * a;
        if (HAS_B) o += ((const LAS f32x4*)B)[lane + 64 * j];
        if (OUT_MODE == 4) { v[j] = o; continue; }
        if (OUT_MODE == 1 || OUT_MODE == 3) { v2u w; w.x = pk2(o.x, o.y); w.y = pk2(o.z, o.w); ((GAS v2u*)orow)[lane + 64 * j] = w; if (OUT_MODE == 3) ((GAS unsigned*)orow8)[lane + 64 * j] = pk4_fp8(o.x, o.y, o.z, o.w); }
        else if (OUT_MODE == 2) ((GAS unsigned*)orow)[lane + 64 * j] = pk4_fp8(o.x, o.y, o.z, o.w);
        else ((GAS f32x4*)orow)[lane + 64 * j] = o;
    }
    if (OUT_MODE == 4) {
        float m = 0.f;
#pragma unroll
        for (int j = 0; j < 16; ++j) m = fmaxf(m, fmaxf(fmaxf(fabsf(v[j].x), fabsf(v[j].y)), fmaxf(fabsf(v[j].z), fabsf(v[j].w))));
#pragma unroll
        for (int o = 1; o < 64; o <<= 1) m = fmaxf(m, __shfl_xor(m, o));
        const float inv = m > 0.f ? 127.0f / m : 0.f;
#pragma unroll
        for (int j = 0; j < 16; ++j) ((GAS unsigned*)orow)[lane + 64 * j] = pk4_i8(v[j].x * inv, v[j].y * inv, v[j].z * inv, v[j].w * inv);
        if (lane == 0) *rs = m * (1.0f / 127.0f);
    }
}
__device__ __forceinline__ float mod_sum(const float* ada_b, const float* modp, int r, int n) {
    float s = ada_b[n];
#pragma unroll
    for (int kc = 0; kc < MOD_SPLIT; ++kc) s += modp[(size_t)(kc * 5 + r) * MODN + n];
    return s;
}
__device__ __forceinline__ void p1_norm1(Frame& F) {
    LAS float* Al = (LAS float*)(F.lds + RING_OFF); LAS float* Bl = Al + D; LAS float* Ac = Bl + D; LAS float* Bc = Ac + D;
    const int c = blockIdx.x, b = c / 64;
    const float* ada_b = F.ada_b(); const float* modp = F.modp(); const float* n1g = F.norm1_g();
    for (int k = F.tid; k < D; k += NWAVES * 64) { const float g = n1g[k];
        Al[k] = g * (1.0f + mod_sum(ada_b, modp, b, D + k)); Bl[k] = mod_sum(ada_b, modp, b, k); Ac[k] = g * (1.0f + mod_sum(ada_b, modp, 4, D + k)); Bc[k] = mod_sum(ada_b, modp, 4, k); }
    { const int per = (5 * MODN) / 256; if (F.tid < per) { const int i = c * per + F.tid; F.modf()[i] = mod_sum(ada_b, modp, i / MODN, i % MODN); } }
    __syncthreads();
    const float* xp = F.x(); const float* cxp = F.ctx(); unsigned char* h8 = (unsigned char*)F.ACT(); bf16* h16 = F.H(); float* rsh = F.rsh();
    for (int j = F.wave; j < 68; j += NWAVES) {
        if (j < 64) { const size_t row = (size_t)c * 64 + j; if (V_FP8 && INPROJ_MODE == 2) norm_row<4, true>(xp + row * D, h8 + row * D, Al, Bl, F.lane, nullptr, rsh + row); else if (V_FP8) norm_row<2, true>(xp + row * D, h8 + row * D, Al, Bl, F.lane); else norm_row<3, true>(xp + row * D, h16 + row * D, Al, Bl, F.lane, h8 + row * D); }
        else { const size_t row = (size_t)c * 4 + (j - 64); if (V_FP8 && INPROJ_MODE == 2) norm_row<4, true>(cxp + row * D, h8 + ((size_t)M + row) * D, Ac, Bc, F.lane, nullptr, rsh + M + row); else if (V_FP8) norm_row<2, true>(cxp + row * D, h8 + ((size_t)M + row) * D, Ac, Bc, F.lane); else norm_row<3, true>(cxp + row * D, h16 + ((size_t)M + row) * D, Ac, Bc, F.lane, h8 + ((size_t)M + row) * D); }
    }
}
__device__ __forceinline__ void p7_norm2(Frame& F) {
    LAS float* Al = (LAS float*)(F.lds + RING_OFF); LAS float* Bl = Al + D;
    const int c = blockIdx.x, b = c / 64; const float* mb = F.modf() + (size_t)b * MODN;
    const float* n2g = F.norm2_g();
    for (int k = F.tid; k < D; k += NWAVES * 64) { Al[k] = n2g[k] * (1.0f + mb[4 * D + k]); Bl[k] = mb[3 * D + k]; }
    __syncthreads();
    const float* xp = F.x(); const bf16* d1 = F.H(); bf16* h2 = F.QO();
    for (int j = F.wave; j < 64; j += NWAVES) { const size_t row = (size_t)c * 64 + j; norm_row<1, true, 1>(xp + row * D, h2 + row * D, Al, Bl, F.lane, nullptr, nullptr, d1 + row * D); }
}
__device__ __forceinline__ void p11_final(Frame& F, float osc = 1.0f) {
    LAS float* Al = (LAS float*)(F.lds + RING_OFF);
    const int c = blockIdx.x;
    const float* fg = F.final_g(); float* outp = F.out(); const float* xp = F.x(); const bf16* d1 = F.H(); const bf16* d2 = F.QO();
    for (int k = F.tid; k < D; k += NWAVES * 64) Al[k] = fg[k] * osc;
    __syncthreads();
    for (int j = F.wave; j < 64; j += NWAVES) { const size_t row = (size_t)c * 64 + j; norm_row<0, false, 2>(xp + row * D, outp + row * D, Al, Al, F.lane, nullptr, nullptr, d1 + row * D, d2 + row * D); }
}

__device__ __forceinline__ void p6_quant_y(Frame& F) {
    const bf16* Y = F.H(); unsigned char* Y8 = (unsigned char*)F.KB(); float* rsy = F.rsy();
    for (int j = F.wave; j < 64; j += NWAVES) { const size_t row = (size_t)blockIdx.x * 64 + j;
        const GAS v4u* yr = (const GAS v4u*)(Y + row * D) + F.lane; v4u r[8]; float m = 0.f;
#pragma unroll
        for (int q = 0; q < 8; ++q) { r[q] = yr[64 * q]; const unsigned w[4] = {r[q].x, r[q].y, r[q].z, r[q].w};
#pragma unroll
            for (int e = 0; e < 4; ++e) m = fmaxf(m, fmaxf(fabsf(bf_lo(w[e])), fabsf(bf_hi(w[e])))); }
#pragma unroll
        for (int o = 1; o < 64; o <<= 1) m = fmaxf(m, __shfl_xor(m, o));
        const float inv = m > 0.f ? 127.0f / m : 0.f;
#pragma unroll
        for (int q = 0; q < 8; ++q) { v2u o; o.x = pk4_i8(bf_lo(r[q].x) * inv, bf_hi(r[q].x) * inv, bf_lo(r[q].y) * inv, bf_hi(r[q].y) * inv); o.y = pk4_i8(bf_lo(r[q].z) * inv, bf_hi(r[q].z) * inv, bf_lo(r[q].w) * inv, bf_hi(r[q].w) * inv);
            ((GAS v2u*)(Y8 + row * D))[F.lane + 64 * q] = o; }
        if (F.lane == 0) rsy[row] = m * (1.0f / 127.0f);
    }
}

__device__ __forceinline__ void p3_qkfix(Frame& F) {
    constexpr int NPQ = QFIX_ATT ? 0 : M * HA, NPK = M * KVA, NPC = MC * KVA, NP = NPQ + NPK + NPC;
    const int gw = F.vcu * NWAVES + F.wave, NGW = F.G * NWAVES, sub = F.lane & 15;
    bf16* QOp = F.QO(); bf16* KAp = F.KA(); const float* qn = F.qnorm(); const float* kn = F.knorm(); const float2* ropep = F.rope();
    for (int wi = gw; wi < NP / 4; wi += NGW) {
        int p = 4 * wi + (F.lane >> 4); bf16* ptr; const float* gain; int t; bool rope = true;
        if (p < NPQ) { const int row = p >> 4, h = p & 15; ptr = QOp + (size_t)row * 4096 + h * HD; gain = qn; t = row & (S - 1); }
        else if (p < NPQ + NPK) { p -= NPQ; const int row = p >> 2, h = p & 3, b = row >> 12; t = row & (S - 1); ptr = KAp + ((size_t)b * KT + L + t) * 512 + h * HD; gain = kn; }
        else { p -= NPQ + NPK; const int row = p >> 2, h = p & 3, b = row >> 8, j = row & (L - 1); ptr = KAp + ((size_t)b * KT + j) * 512 + h * HD; gain = kn; t = 0; rope = false; }
        const v4u raw = *(const GAS v4u*)(ptr + 8 * sub);
        float v[8] = {bf_lo(raw.x), bf_hi(raw.x), bf_lo(raw.y), bf_hi(raw.y), bf_lo(raw.z), bf_hi(raw.z), bf_lo(raw.w), bf_hi(raw.w)};
        float ss = 0.f;
#pragma unroll
        for (int e = 0; e < 8; ++e) ss += v[e] * v[e];
        ss += __shfl_xor(ss, 1); ss += __shfl_xor(ss, 2); ss += __shfl_xor(ss, 4); ss += __shfl_xor(ss, 8);
        const float rstd = 1.0f / sqrtf(ss * (1.0f / HD) + EPS);
        const f32x4 g0 = *(const GAS f32x4*)(gain + 8 * sub), g1 = *(const GAS f32x4*)(gain + 8 * sub + 4);
        v[0] *= rstd * g0.x; v[1] *= rstd * g0.y; v[2] *= rstd * g0.z; v[3] *= rstd * g0.w; v[4] *= rstd * g1.x; v[5] *= rstd * g1.y; v[6] *= rstd * g1.z; v[7] *= rstd * g1.w;
        const int pos = (sub < 8) ? (t >> 6) : (t & 63); const float2* rp = ropep + pos * 32 + 8 * (sub & 3);
        float o[8];
#pragma unroll
        for (int e = 0; e < 8; ++e) { const float q = __shfl_xor(v[e], 4); const float2 cs = rp[e]; o[e] = rope ? ((sub & 4) ? (v[e] * cs.x + q * cs.y) : (v[e] * cs.x - q * cs.y)) : v[e]; }
        v4u w; w.x = pk2(o[0], o[1]); w.y = pk2(o[2], o[3]); w.z = pk2(o[4], o[5]); w.w = pk2(o[6], o[7]);
        *(GAS v4u*)(ptr + 8 * sub) = w;
    }
}

__device__ __forceinline__ void ld8f(const float* p, float (&v)[8]) { const f32x4 a = *(const GAS f32x4*)p, b = *(const GAS f32x4*)(p + 4); v[0] = a.x; v[1] = a.y; v[2] = a.z; v[3] = a.w; v[4] = b.x; v[5] = b.y; v[6] = b.z; v[7] = b.w; }
__device__ __forceinline__ void p10_convfix(Frame& F) {
    constexpr int NFG = DFF / 8, NBD = NB * 15;
    const int gt = F.vcu * (NWAVES * 64) + F.tid, NT_ = F.G * NWAVES * 64;
    const float* cw = F.conv_w(); const float* cbp_ = F.conv_b(); const float* halo = (const float*)F.Win(); bf16* actp = F.ACT();
    for (int item = gt; item < NFG * NBD; item += NT_) {
        const int fg = item % NFG, bd = item / NFG, pm = (bd / 15) * 16 + (bd % 15), f0 = 8 * fg, cg = 256 * (f0 >> 7) + (f0 & 127);
        float w[3][8], bb[8], r254[8], r255[8], r0[8], r1[8], og[2][8], ov[2][8];
#pragma unroll
        for (int half = 0; half < 2; ++half) {
            const int fo = half * DFF + f0, co = cg + half * 128;
#pragma unroll
            for (int j = 0; j < 3; ++j) ld8f(cw + j * F2 + fo, w[j]);
            ld8f(cbp_ + fo, bb);
            ld8f(halo + ((size_t)pm * 4 + 2) * F2 + co, r254); ld8f(halo + ((size_t)pm * 4 + 3) * F2 + co, r255);
            ld8f(halo + ((size_t)(pm + 1) * 4 + 0) * F2 + co, r0); ld8f(halo + ((size_t)(pm + 1) * 4 + 1) * F2 + co, r1);
#pragma unroll
            for (int e = 0; e < 8; ++e) { const float a = r254[e] * w[0][e] + r255[e] * w[1][e] + r0[e] * w[2][e] + bb[e], b = r255[e] * w[0][e] + r0[e] * w[1][e] + r1[e] * w[2][e] + bb[e];
                if (half == 0) { og[0][e] = a; og[1][e] = b; } else { ov[0][e] = a; ov[1][e] = b; } }
        }
#pragma unroll
        for (int rr = 0; rr < 2; ++rr) { float o[8];
#pragma unroll
            for (int e = 0; e < 8; ++e) o[e] = og[rr][e] * sigmoid_f(og[rr][e]) * ov[rr][e];
            v4u wv; wv.x = pk2(o[0], o[1]); wv.y = pk2(o[2], o[3]); wv.z = pk2(o[4], o[5]); wv.w = pk2(o[6], o[7]);
            *(GAS v4u*)(actp + (size_t)(pm * 256 + 255 + rr) * DFF + f0) = wv; }
    }
}

namespace att {
using bf16x8 = __attribute__((ext_vector_type(8))) short;
using s16x4  = __attribute__((ext_vector_type(4))) short;
using f32x16 = __attribute__((ext_vector_type(16))) float;
using u32x4  = __attribute__((ext_vector_type(4))) unsigned;
constexpr int AD = 128, NW = 8, QBLK = 32, KVBLK = 64;
constexpr float THR = 8.f;
constexpr size_t SHM_V = KVBLK * AD * 2, SHM_K = KVBLK * AD * 2, SHM_ATTN = 2 * SHM_V + 2 * SHM_K + NW * 64 * 4;
constexpr int BIAS_OFF = (int)SHM_ATTN;
constexpr int ATT_LDS = BIAS_OFF + 2048;
#define KSWZ(row, colB) ((row) * 256 + ((colB) ^ (((row) & 7) << 4)))
#define SBAR() __builtin_amdgcn_sched_barrier(0)
__device__ __forceinline__ int crow(int r, int hi) { return (r & 3) + 8 * (r >> 2) + 4 * hi; }
__device__ __forceinline__ unsigned cvtpk(float lo, float hi) { unsigned r; asm volatile("v_cvt_pk_bf16_f32 %0, %1, %2" : "=v"(r) : "v"(lo), "v"(hi)); return r; }
template <int FIXM = 0>
__device__ __forceinline__ void partialSM(f32x16& p0, f32x16& p1, float& m_reg, float& mn, float& alpha, float m0c = 0.f) {
  constexpr float C = SCALE * 1.4426950408889634f;
  if (FIXM == 2) { alpha = 1.f; mn = 0.f;
    for (int r = 0; r < 16; ++r) p0[r] = __builtin_amdgcn_exp2f(p0[r]);
    return; }
  if (FIXM == 1) { alpha = 1.f; mn = 0.f;
    for (int r = 0; r < 16; ++r) p0[r] = fmaf(p0[r], C, -m0c); for (int r = 0; r < 16; ++r) p1[r] = fmaf(p1[r], C, -m0c);
    for (int r = 0; r < 16; ++r) p0[r] = __builtin_amdgcn_exp2f(p0[r]);
    return; }
  float pmax = p0[0]; for (int r = 1; r < 16; ++r) pmax = fmaxf(pmax, p0[r]); for (int r = 0; r < 16; ++r) pmax = fmaxf(pmax, p1[r]);
  { auto rr = __builtin_amdgcn_permlane32_swap(__float_as_uint(pmax), __float_as_uint(pmax), false, false);
    pmax = fmaxf(__uint_as_float(rr[0]), __uint_as_float(rr[1])); }
  if (__builtin_expect(__all(pmax - m_reg <= THR / SCALE), 1)) { mn = m_reg; alpha = 1.f; }
  else { mn = fmaxf(m_reg, pmax); alpha = __builtin_amdgcn_exp2f((m_reg - mn) * C); m_reg = mn; }
  float mnC = -mn * C;
  for (int r = 0; r < 16; ++r) p0[r] = fmaf(p0[r], C, mnC); for (int r = 0; r < 16; ++r) p1[r] = fmaf(p1[r], C, mnC);
  for (int r = 0; r < 16; ++r) p0[r] = __builtin_amdgcn_exp2f(p0[r]);
}
__device__ __forceinline__ void finishSM(f32x16& p0, f32x16& p1, float alpha, float& l_reg, bf16x8& pa0, bf16x8& pa1, bf16x8& pa2, bf16x8& pa3) {
  for (int r = 0; r < 16; ++r) p1[r] = __builtin_amdgcn_exp2f(p1[r]);
  float ps = 0; for (int r = 0; r < 16; ++r) ps += p0[r]; for (int r = 0; r < 16; ++r) ps += p1[r];
  { auto rr = __builtin_amdgcn_permlane32_swap(__float_as_uint(ps), __float_as_uint(ps), false, false);
    ps = __uint_as_float(rr[0]) + __uint_as_float(rr[1]); }
  l_reg = l_reg * alpha + ps;
#define PK4(P, BASE, OUT) do { unsigned a0 = cvtpk(P[BASE + 0], P[BASE + 1]), a1 = cvtpk(P[BASE + 2], P[BASE + 3]);   \
    unsigned b0 = cvtpk(P[BASE + 4], P[BASE + 5]), b1 = cvtpk(P[BASE + 6], P[BASE + 7]);                              \
    auto r0 = __builtin_amdgcn_permlane32_swap(a0, b0, false, false); auto r1 = __builtin_amdgcn_permlane32_swap(a1, b1, false, false); \
    u32x4 w = {r0[0], r1[0], r0[1], r1[1]}; OUT = *reinterpret_cast<bf16x8*>(&w); } while (0)
  PK4(p0, 0, pa0); PK4(p0, 8, pa1); PK4(p1, 0, pa2); PK4(p1, 8, pa3);
#undef PK4
}
__device__ __forceinline__ void qkt(f32x16& p0, f32x16& p1, const char* Ks, const bf16x8* qr, int r32, int hi) {
  p0 = f32x16{}; p1 = f32x16{};
  for (int d0 = 0; d0 < 8; ++d0) { int cb = (d0 * 16 + hi * 8) * 2;
    bf16x8 b0 = *reinterpret_cast<const bf16x8*>(Ks + KSWZ(r32, cb));
    bf16x8 b1 = *reinterpret_cast<const bf16x8*>(Ks + KSWZ(32 + r32, cb));
    p0 = __builtin_amdgcn_mfma_f32_32x32x16_bf16(b0, qr[d0], p0, 0, 0, 0);
    p1 = __builtin_amdgcn_mfma_f32_32x32x16_bf16(b1, qr[d0], p1, 0, 0, 0); }
}
__device__ __forceinline__ int v_st(int k, int c) { const int kk = (k & ~0xC) | ((k & 4) << 1) | ((k & 8) >> 1); return ((kk >> 3) * 4 + (c >> 5)) * 512 + ((kk & 7) * 32 + (c & 31)) * 2; }
__device__ __forceinline__ int v_rd_base(int lane) { return ((lane & 3) << 3) | (((lane >> 2) & 3) << 6) | (((lane >> 4) & 1) << 5) | (((lane >> 5) & 1) << 8); }
constexpr int v_rd_off(int d0, int ks, int half) { return d0 * 512 + ks * 4096 + half * 2048; }
template <int OFF> __device__ __forceinline__ s16x4 tr_read(int vb) {
  s16x4 r; asm volatile("ds_read_b64_tr_b16 %0, %1 offset:%2" : "=&v"(r) : "v"(vb), "i"(OFF) : "memory"); return r;
}
template <int D0> __device__ __forceinline__ void pv_one(f32x16& od, int vb, bf16x8 pa0, bf16x8 pa1, bf16x8 pa2, bf16x8 pa3) {
  const s16x4 l0 = tr_read<v_rd_off(D0, 0, 0)>(vb), h0 = tr_read<v_rd_off(D0, 0, 1)>(vb), l1 = tr_read<v_rd_off(D0, 1, 0)>(vb), h1 = tr_read<v_rd_off(D0, 1, 1)>(vb);
  const s16x4 l2 = tr_read<v_rd_off(D0, 2, 0)>(vb), h2 = tr_read<v_rd_off(D0, 2, 1)>(vb), l3 = tr_read<v_rd_off(D0, 3, 0)>(vb), h3 = tr_read<v_rd_off(D0, 3, 1)>(vb);
  asm volatile("s_waitcnt lgkmcnt(0)" ::: "memory"); SBAR();
#define PK(L, H) (bf16x8){L[0], L[1], L[2], L[3], H[0], H[1], H[2], H[3]}
  od = __builtin_amdgcn_mfma_f32_32x32x16_bf16(pa0, PK(l0, h0), od, 0, 0, 0);
  od = __builtin_amdgcn_mfma_f32_32x32x16_bf16(pa1, PK(l1, h1), od, 0, 0, 0);
  od = __builtin_amdgcn_mfma_f32_32x32x16_bf16(pa2, PK(l2, h2), od, 0, 0, 0);
  od = __builtin_amdgcn_mfma_f32_32x32x16_bf16(pa3, PK(l3, h3), od, 0, 0, 0);
#undef PK
}
__device__ __forceinline__ void pv_d0(f32x16* o, int vb, bf16x8 pa0, bf16x8 pa1, bf16x8 pa2, bf16x8 pa3) {
  pv_one<0>(o[0], vb, pa0, pa1, pa2, pa3); pv_one<1>(o[1], vb, pa0, pa1, pa2, pa3); pv_one<2>(o[2], vb, pa0, pa1, pa2, pa3); pv_one<3>(o[3], vb, pa0, pa1, pa2, pa3);
}
struct NatGeo { int R_lo, nloc, qr, rs, qc, cs; };
__device__ __forceinline__ void nat_mask(f32x16& p0, f32x16& p1, int kr, const NatGeo& g, const float* btab, int hi) {
  const float ninf = -__builtin_inff();
  const float* tb = btab + (kr - g.qr + 7) * 31 + 15 - g.qc + 4 * hi;
#pragma unroll
  for (int q = 0; q < 4; ++q) {
    float bb[8];
#pragma unroll
    for (int e = 0; e < 4; ++e) { bb[e] = tb[8 * q + e]; bb[4 + e] = tb[32 + 8 * q + e]; }
#pragma unroll
    for (int e = 0; e < 4; ++e) { const int r = 4 * q + e, k0 = 8 * q + e + 4 * hi, k1 = k0 + 32;
      p0[r] = ((unsigned)(k0 - g.cs) < 16u) ? p0[r] + bb[e] : ninf; p1[r] = ((unsigned)(k1 - g.cs) < 16u) ? p1[r] + bb[4 + e] : ninf; }
    asm volatile("" ::: "memory");
  }
}
template <int LDQ, int LDK, int LDO, int FIXM = 0, bool QFIX = false>
__device__ __forceinline__ void attn_body(const bf16* Qb, const bf16* __restrict__ Kh, const bf16* __restrict__ Vh, bf16* Ob, int NT, char* lds, unsigned char* Ob8 = nullptr, float oscale8 = 1.f, float m0c = 0.f,
                                          const float* qg = nullptr, const float2* ropet = nullptr, int t0 = 0) {
  int tid_o = threadIdx.x; asm volatile("" : "+v"(tid_o));
  const int tid = tid_o, wid = tid >> 6, lane = tid & 63, r32 = lane & 31, hi = lane >> 5;
  char* V_lds = lds; char* K_lds = lds + 2 * SHM_V;
  float* ws = (float*)(lds + 2 * SHM_V + 2 * SHM_K) + wid * 64; float* li_l = ws; float* al_l = ws + 32;
  float m_reg = -1e30f, l_reg = 0; f32x16 o[4] = {}; bf16x8 qr[8];
  const bf16* Qw = Qb + (long)(wid * QBLK + r32) * LDQ + hi * 8;
#pragma unroll
  for (int d0 = 0; d0 < 8; ++d0) qr[d0] = *reinterpret_cast<const bf16x8*>(Qw + d0 * 16);
  if (QFIX) {
    float x[8][8]; float ss = 0.f;
#pragma unroll
    for (int d0 = 0; d0 < 8; ++d0) { const u32x4 w = *reinterpret_cast<const u32x4*>(&qr[d0]);
      x[d0][0] = bf_lo(w.x); x[d0][1] = bf_hi(w.x); x[d0][2] = bf_lo(w.y); x[d0][3] = bf_hi(w.y); x[d0][4] = bf_lo(w.z); x[d0][5] = bf_hi(w.z); x[d0][6] = bf_lo(w.w); x[d0][7] = bf_hi(w.w);
#pragma unroll
      for (int e = 0; e < 8; ++e) ss += x[d0][e] * x[d0][e]; }
    { auto rr = __builtin_amdgcn_permlane32_swap(__float_as_uint(ss), __float_as_uint(ss), false, false); ss = __uint_as_float(rr[0]) + __uint_as_float(rr[1]); }
    const float rstd = (FIXM == 2 ? SCALE * 1.4426950408889634f : 1.0f) / sqrtf(ss * (1.0f / AD) + EPS);
#pragma unroll
    for (int d0 = 0; d0 < 8; ++d0) { const f32x4 g0 = *reinterpret_cast<const f32x4*>(qg + d0 * 16 + hi * 8), g1 = *reinterpret_cast<const f32x4*>(qg + d0 * 16 + hi * 8 + 4);
      x[d0][0] *= rstd * g0.x; x[d0][1] *= rstd * g0.y; x[d0][2] *= rstd * g0.z; x[d0][3] *= rstd * g0.w; x[d0][4] *= rstd * g1.x; x[d0][5] *= rstd * g1.y; x[d0][6] *= rstd * g1.z; x[d0][7] *= rstd * g1.w; }
    const int tok = t0 + wid * QBLK + r32;
#pragma unroll
    for (int half = 0; half < 2; ++half) { const float2* rp = ropet + (half == 0 ? (tok >> 6) : (tok & 63)) * 32 + hi * 8;
#pragma unroll
      for (int dd = 0; dd < 2; ++dd)
#pragma unroll
        for (int e = 0; e < 8; ++e) { const float2 cs = rp[dd * 16 + e]; const float a = x[4 * half + dd][e], b = x[4 * half + dd + 2][e];
          x[4 * half + dd][e] = a * cs.x - b * cs.y; x[4 * half + dd + 2][e] = b * cs.x + a * cs.y; } }
#pragma unroll
    for (int d0 = 0; d0 < 8; ++d0) { u32x4 w = {cvtpk(x[d0][0], x[d0][1]), cvtpk(x[d0][2], x[d0][3]), cvtpk(x[d0][4], x[d0][5]), cvtpk(x[d0][6], x[d0][7])}; qr[d0] = *reinterpret_cast<bf16x8*>(&w); }
  }
  const int sr = tid >> 4, sc = (tid & 15) * 8, vst0 = v_st(sr, sc), vst1 = v_st(32 + sr, sc);
  const int vb0 = (int)(uintptr_t)V_lds + v_rd_base(lane);
  struct { bf16x8 vs0, vs1, ks0, ks1; } sr_[2];
#define TROW(j) (64 * (j))
#define SLOAD(i, j) do { const long k0_ = TROW(j); sr_[i].vs0 = *reinterpret_cast<const bf16x8*>(&Vh[(k0_ + sr) * LDK + sc]); sr_[i].vs1 = *reinterpret_cast<const bf16x8*>(&Vh[(k0_ + 32 + sr) * LDK + sc]); \
    sr_[i].ks0 = *reinterpret_cast<const bf16x8*>(&Kh[(k0_ + sr) * LDK + sc]); sr_[i].ks1 = *reinterpret_cast<const bf16x8*>(&Kh[(k0_ + 32 + sr) * LDK + sc]); } while (0)
#define SWRITE(b, i) do { *(bf16x8*)(V_lds + (b) * SHM_V + vst0) = sr_[i].vs0;          \
    *(bf16x8*)(V_lds + (b) * SHM_V + vst1) = sr_[i].vs1; int kc = sc * 2;               \
    *(bf16x8*)(K_lds + (b) * SHM_K + KSWZ(sr, kc)) = sr_[i].ks0;                       \
    *(bf16x8*)(K_lds + (b) * SHM_K + KSWZ(32 + sr, kc)) = sr_[i].ks1; } while (0)
#define SWAIT() asm volatile("s_waitcnt vmcnt(4)" ::: "memory")
#define RESC(a) do { if (__any((a) < 1.f)) { if (hi == 0) al_l[r32] = (a); asm volatile("s_waitcnt lgkmcnt(0)" ::: "memory"); \
    for (int d = 0; d < 4; ++d) for (int r = 0; r < 16; ++r) o[d][r] *= al_l[crow(r, hi)]; } } while (0)
#define MASK(P0, P1, j) do { } while (0)
  f32x16 pA0, pA1, pB0, pB1; float mnA, mnB, alA, alB; bf16x8 pa0, pa1, pa2, pa3;
  constexpr int SE = 0, SO = 1;
  SLOAD(SE, 0); asm volatile("s_waitcnt vmcnt(0)" ::: "memory"); SWRITE(0, SE); __syncthreads();
  qkt(pA0, pA1, K_lds, qr, r32, hi); MASK(pA0, pA1, 0); partialSM<FIXM>(pA0, pA1, m_reg, mnA, alA, m0c);
  SLOAD(SO, 1); if (2 < NT) SLOAD(SE, 2);
  SWAIT(); SWRITE(1, SO); __syncthreads();
  for (int j = 1; j + 1 < NT; j += 2) {
    SBAR(); qkt(pB0, pB1, K_lds + SHM_K, qr, r32, hi);
    finishSM(pA0, pA1, alA, l_reg, pa0, pa1, pa2, pa3); SBAR();
    SLOAD(SO, j + 2); SBAR();
    pv_d0(o, vb0, pa0, pa1, pa2, pa3); MASK(pB0, pB1, j); partialSM<FIXM>(pB0, pB1, m_reg, mnB, alB, m0c);
    __syncthreads(); SWAIT(); SWRITE(0, SE);
    RESC(alB); __syncthreads();
    SBAR(); qkt(pA0, pA1, K_lds, qr, r32, hi);
    finishSM(pB0, pB1, alB, l_reg, pa0, pa1, pa2, pa3); SBAR();
    if (j + 3 < NT) SLOAD(SE, j + 3); SBAR();
    pv_d0(o, vb0 + (int)SHM_V, pa0, pa1, pa2, pa3); MASK(pA0, pA1, j + 1); partialSM<FIXM>(pA0, pA1, m_reg, mnA, alA, m0c);
    __syncthreads(); SWAIT(); SWRITE(1, SO);
    RESC(alA); __syncthreads();
  }
  SBAR(); qkt(pB0, pB1, K_lds + SHM_K, qr, r32, hi);
  finishSM(pA0, pA1, alA, l_reg, pa0, pa1, pa2, pa3); SBAR();
  pv_d0(o, vb0, pa0, pa1, pa2, pa3); MASK(pB0, pB1, NT - 1); partialSM<FIXM>(pB0, pB1, m_reg, mnB, alB, m0c);
  __syncthreads(); RESC(alB);
  finishSM(pB0, pB1, alB, l_reg, pa0, pa1, pa2, pa3); SBAR();
  pv_d0(o, vb0 + (int)SHM_V, pa0, pa1, pa2, pa3);
  if (hi == 0) li_l[r32] = l_reg; asm volatile("s_waitcnt lgkmcnt(0)" ::: "memory");
  float rli[16];
#pragma unroll
  for (int r = 0; r < 16; ++r) rli[r] = __builtin_amdgcn_rcpf(li_l[crow(r, hi)]);
  bf16* Ow = Ob + (long)(wid * QBLK) * LDO;
#pragma unroll
  for (int r = 0; r < 16; ++r) { int orow = crow(r, hi);
    if (BR_FP8) { unsigned char* Ow8 = Ob8 + (long)(wid * QBLK + orow) * LDO;
      for (int d0 = 0; d0 < 4; ++d0) Ow8[d0 * 32 + r32] = (unsigned char)(pk4_fp8(o[d0][r] * rli[r] * oscale8, 0.f, 0.f, 0.f) & 0xffu); }
    else for (int d0 = 0; d0 < 4; ++d0) Ow[(long)orow * LDO + d0 * 32 + r32] = (bf16)(cvtpk(o[d0][r] * rli[r], 0.f) & 0xffffu); }
#undef TROW
#undef SLOAD
#undef SWRITE
#undef SWAIT
#undef RESC
#undef MASK
}

template <int LDQ, int LDK, int LDO>
__device__ __forceinline__ void nat_body(const bf16* Qb, const bf16* __restrict__ Kh, const bf16* __restrict__ Vh, bf16* Ob, const NatGeo g, char* lds, unsigned char* Ob8 = nullptr, float oscale8 = 1.f) {
  int tid_o = threadIdx.x; asm volatile("" : "+v"(tid_o));
  const int tid = tid_o, wid = tid >> 6, lane = tid & 63, r32 = lane & 31, hi = lane >> 5;
  char* V_lds = lds; char* K_lds = lds + 2 * SHM_V;
  float* ws = (float*)(lds + 2 * SHM_V + 2 * SHM_K) + wid * 64; float* li_l = ws; float* al_l = ws + 32;
  const float* btab = (const float*)(lds + BIAS_OFF);
  float m_reg = -1e30f, l_reg = 0; f32x16 o[4] = {}; bf16x8 qr[8];
  const bf16* Qw = Qb + (long)(wid * QBLK + r32) * LDQ + hi * 8;
#pragma unroll
  for (int d0 = 0; d0 < 8; ++d0) qr[d0] = *reinterpret_cast<const bf16x8*>(Qw + d0 * 16);
  const int sr = tid >> 4, sc = (tid & 15) * 8, vst0 = v_st(sr, sc), vst1 = v_st(32 + sr, sc);
  const int vb0 = (int)(uintptr_t)V_lds + v_rd_base(lane);
  bf16x8 vs0, vs1, ks0, ks1;
#define TROW(j) ((j) < 4 ? 64 * (j) : L + 64 * (g.R_lo + (j) - 4))
#define SLOAD(j) do { const long k0_ = TROW(j); vs0 = *reinterpret_cast<const bf16x8*>(&Vh[(k0_ + sr) * LDK + sc]); vs1 = *reinterpret_cast<const bf16x8*>(&Vh[(k0_ + 32 + sr) * LDK + sc]); \
    ks0 = *reinterpret_cast<const bf16x8*>(&Kh[(k0_ + sr) * LDK + sc]); ks1 = *reinterpret_cast<const bf16x8*>(&Kh[(k0_ + 32 + sr) * LDK + sc]); } while (0)
#define SWRITE(b) do { *(bf16x8*)(V_lds + (b) * SHM_V + vst0) = vs0; *(bf16x8*)(V_lds + (b) * SHM_V + vst1) = vs1; int kc = sc * 2;               \
    *(bf16x8*)(K_lds + (b) * SHM_K + KSWZ(sr, kc)) = ks0; *(bf16x8*)(K_lds + (b) * SHM_K + KSWZ(32 + sr, kc)) = ks1; } while (0)
  const int NT = 4 + g.nloc;
  SLOAD(0); asm volatile("s_waitcnt vmcnt(0)" ::: "memory"); SWRITE(0); __syncthreads();
  for (int j = 0; j < NT; ++j) {
    const int b = j & 1;
    if (j + 1 < NT) SLOAD(j + 1);
    const int kr = g.R_lo + j - 4;
    const bool skip = (j >= 4) && ((unsigned)(kr - g.rs) >= 8u);
    if (!skip) {
      f32x16 p0, p1; float mn, al; bf16x8 pa0, pa1, pa2, pa3;
      qkt(p0, p1, K_lds + b * SHM_K, qr, r32, hi);
      if (j >= 4) nat_mask(p0, p1, kr, g, btab, hi);
      partialSM(p0, p1, m_reg, mn, al);
      if (__any(al < 1.f)) { if (hi == 0) al_l[r32] = al; asm volatile("s_waitcnt lgkmcnt(0)" ::: "memory");
        for (int d = 0; d < 4; ++d) for (int r = 0; r < 16; ++r) o[d][r] *= al_l[crow(r, hi)]; }
      finishSM(p0, p1, al, l_reg, pa0, pa1, pa2, pa3); SBAR();
      pv_d0(o, vb0 + b * (int)SHM_V, pa0, pa1, pa2, pa3);
    }
    if (j + 1 < NT) { asm volatile("s_waitcnt vmcnt(0)" ::: "memory"); SWRITE(b ^ 1); }
    __syncthreads();
  }
  if (hi == 0) li_l[r32] = l_reg; asm volatile("s_waitcnt lgkmcnt(0)" ::: "memory");
  float rli[16];
#pragma unroll
  for (int r = 0; r < 16; ++r) rli[r] = __builtin_amdgcn_rcpf(li_l[crow(r, hi)]);
  bf16* Ow = Ob + (long)(wid * QBLK) * LDO;
#pragma unroll
  for (int r = 0; r < 16; ++r) { int orow = crow(r, hi);
    if (BR_FP8) { unsigned char* Ow8 = Ob8 + (long)(wid * QBLK + orow) * LDO;
      for (int d0 = 0; d0 < 4; ++d0) Ow8[d0 * 32 + r32] = (unsigned char)(pk4_fp8(o[d0][r] * rli[r] * oscale8, 0.f, 0.f, 0.f) & 0xffu); }
    else for (int d0 = 0; d0 < 4; ++d0) Ow[(long)orow * LDO + d0 * 32 + r32] = (bf16)(cvtpk(o[d0][r] * rli[r], 0.f) & 0xffffu); }
#undef TROW
#undef SLOAD
#undef SWRITE
}
}

__device__ __forceinline__ void p4_attention(Frame& F) {
    char* lds = (char*)(F.lds + RING_OFF);
    bf16* QOp = F.QO(); const bf16* KAp = F.KA(); const bf16* VAp = F.VA(); const bf16* KBp = F.KB(); const bf16* VBp = F.VB(); const float* rpbp = F.rpb(); bf16* scrp = F.ACT(); unsigned char* o8p = (unsigned char*)F.ACT(); const float* qgp = F.qnorm(); const float2* ropep = F.rope();
    float m0c, m0c_raw; { const float gq = fmaxf(fabsf(F.qnorm()[F.lane]), fabsf(F.qnorm()[64 + F.lane])), gk = fmaxf(fabsf(F.knorm()[F.lane]), fabsf(F.knorm()[64 + F.lane])); float a = gq, b = gk;
#pragma unroll
      for (int o = 1; o < 64; o <<= 1) { a = fmaxf(a, __shfl_xor(a, o)); b = fmaxf(b, __shfl_xor(b, o)); }
      m0c_raw = __uint_as_float(__builtin_amdgcn_readfirstlane(__float_as_uint(128.0f * 1.01f * a * b * SCALE * 1.4426950408889634f))); m0c = fminf(m0c_raw, 60.0f); }
#ifndef ATT_NO_A
    for (int u = F.vcu; u < NB * KVA * GQ * (S / 256); u += F.G) {
        const int grp = u >> 6, j = u & 63, b = grp >> 2, kvh = grp & 3, gq = j >> 4, qblk = j & 15;
        bf16* Q = QOp + ((size_t)(b * S + qblk * 256)) * 4096 + (kvh * GQ + gq) * HD;
        const bf16* K = KAp + (size_t)b * KT * 512 + kvh * HD; const bf16* V = VAp + (size_t)b * KT * 512 + kvh * HD;
        __syncthreads();
#if defined(ATT_PROBE) && (ATT_PROBE & 1)
        att::attn_body<4096, 512, 4096>(Q, K, V, scrp + (Q - QOp), KT / 64, lds); __syncthreads();
#endif
        if (QFIX_ATT && m0c_raw <= 40.0f) att::attn_body<4096, 512, 4096, 2, QFIX_ATT>(Q, K, V, Q, KT / 64, lds, o8p + (Q - QOp), SC_OA, 0.f, qgp, ropep, qblk * 256);
        else att::attn_body<4096, 512, 4096, 1, QFIX_ATT>(Q, K, V, Q, KT / 64, lds, o8p + (Q - QOp), SC_OA, m0c, qgp, ropep, qblk * 256);
    }
#endif
#ifndef ATT_NO_B
    for (int u = F.vcu; u < NB * HB * (S / 256); u += F.G) {
        const int pair = u >> 4, rblk = u & 15, b = pair >> 4, h = pair & 15, r0 = 4 * rblk;
        bf16* Q = QOp + ((size_t)(b * S + r0 * GW)) * 4096 + 2048 + h * HD;
        const bf16* K = KBp + (size_t)b * KT * 2048 + h * HD; const bf16* V = VBp + (size_t)b * KT * 2048 + h * HD;
        int R_lo = r0 - 4; R_lo = R_lo < 0 ? 0 : (R_lo > GW - 8 ? GW - 8 : R_lo);
        int R_hi = r0 + 3 - 4; R_hi = (R_hi < 0 ? 0 : (R_hi > GW - 8 ? GW - 8 : R_hi)) + 7;
        att::NatGeo g; g.R_lo = R_lo; g.nloc = R_hi - R_lo + 1; g.qr = r0 + (F.wave >> 1); g.qc = 32 * (F.wave & 1) + (F.lane & 31);
        g.rs = g.qr - 4; g.rs = g.rs < 0 ? 0 : (g.rs > GW - 8 ? GW - 8 : g.rs); g.cs = g.qc - 8; g.cs = g.cs < 0 ? 0 : (g.cs > GW - 16 ? GW - 16 : g.cs);
        __syncthreads();
        if (F.tid < 15 * 31) ((LAS float*)(F.lds + RING_OFF + att::BIAS_OFF))[F.tid] = rpbp[h * (15 * 31) + F.tid] * (1.0f / SCALE);
        __syncthreads();
#if defined(ATT_PROBE) && (ATT_PROBE & 2)
        att::nat_body<4096, 2048, 4096>(Q, K, V, scrp + (Q - QOp), g, lds); __syncthreads();
#endif
        att::nat_body<4096, 2048, 4096>(Q, K, V, Q, g, lds, o8p + (Q - QOp), SC_OB);
    }
#endif
    __syncthreads();
}

typedef const f32x4 (&AccRef)[2][2][4][2];
__device__ __forceinline__ v4u pack8(const f32x4 v0, const f32x4 v1) { v4u w; w.x = pk2(v0[0], v0[1]); w.y = pk2(v0[2], v0[3]); w.z = pk2(v1[0], v1[1]); w.w = pk2(v1[2], v1[3]); return w; }
template <bool FP8C> struct EpiInProj {
    static constexpr bool PERM = true, AFTER_DRAIN = false, MIDK = false;
    bf16 *QO, *KA, *VA, *KB, *VB, *GA, *GB; const float* rsh; float wscale;
    __device__ __forceinline__ void operator()(AccRef acc, const pg8::Unit& u, int wr, int wc, int fr, int fq) const {
        constexpr bool I8 = FP8C && INPROJ_MODE == 2;
        const int pm = u.pm, pn = inproj_global_tile(FP8C, u.pn); const bool ctx = pm >= 64; const float osc = FP8C ? 1.0f / SC_WIN : 1.0f; const int b = ctx ? pm - 64 : pm >> 4; const size_t krow0 = (size_t)b * KT + (ctx ? 0 : L + (pm & 15) * 256);
        bf16* tile; int ldc; bool sig = false;
        if (pn < 8) { tile = QO + (size_t)pm * 256 * 4096 + pn * 256; ldc = 4096; }
        else if (pn < 10) { tile = KA + krow0 * 512 + (pn - 8) * 256; ldc = 512; }
        else if (pn < 12) { tile = VA + krow0 * 512 + (pn - 10) * 256; ldc = 512; }
        else if (pn < 20) { tile = QO + (size_t)pm * 256 * 4096 + 2048 + (pn - 12) * 256; ldc = 4096; }
        else if (pn < 28) { tile = KB + krow0 * 2048 + (pn - 20) * 256; ldc = 2048; }
        else if (pn < 36) { tile = VB + krow0 * 2048 + (pn - 28) * 256; ldc = 2048; }
        else { tile = QO; ldc = 4096; sig = true; }
        unsigned char* gt = (unsigned char*)(pn < 52 ? GA : GB) + (size_t)pm * 256 * 4096 + (pn - (pn < 52 ? 36 : 52)) * 256;
#pragma unroll
        for (int ai = 0; ai < 2; ++ai)
#pragma unroll
            for (int m = 0; m < 4; ++m) { bf16* rowp = tile + (size_t)(ai * 128 + wr * 64 + m * 16 + fr) * ldc + wc * 32 + 8 * fq;
                const float rsc = I8 ? rsh[pm * 256 + ai * 128 + wr * 64 + m * 16 + fr] * wscale : osc;
#pragma unroll
                for (int bj = 0; bj < 2; ++bj) { f32x4 v0, v1;
                    if (I8) { typedef int i32x4_ __attribute__((ext_vector_type(4)));
                        const f32x4 a0 = acc[ai][bj][m][0], a1 = acc[ai][bj][m][1];
                        v0 = __builtin_convertvector(__builtin_bit_cast(i32x4_, a0), f32x4) * rsc; v1 = __builtin_convertvector(__builtin_bit_cast(i32x4_, a1), f32x4) * rsc; }
                    else { v0 = acc[ai][bj][m][0] * rsc; v1 = acc[ai][bj][m][1] * rsc; }
                    if (sig) {
#pragma unroll
                        for (int e = 0; e < 4; ++e) { v0[e] = 255.0f * sigmoid_f(v0[e]); v1[e] = 255.0f * sigmoid_f(v1[e]); }
                        v2u w; w.x = pk4_u8(v0[0], v0[1], v0[2], v0[3]); w.y = pk4_u8(v1[0], v1[1], v1[2], v1[3]);
                        *(GAS v2u*)(gt + (size_t)(ai * 128 + wr * 64 + m * 16 + fr) * 4096 + wc * 32 + 8 * fq + bj * 128) = w; }
                    else *(GAS v4u*)(rowp + bj * 128) = pack8(v0, v1); } }
    }
};
struct EpiPlain {
    static constexpr bool PERM = true, AFTER_DRAIN = false, MIDK = false;
    bf16* O; int ldc; int pad;
    __device__ __forceinline__ void operator()(AccRef acc, const pg8::Unit& u, int wr, int wc, int fr, int fq) const {
        bf16* tile = O + (size_t)u.pm * 256 * ldc + u.pn * 256;
#pragma unroll
        for (int ai = 0; ai < 2; ++ai)
#pragma unroll
            for (int m = 0; m < 4; ++m) { bf16* rowp = tile + (size_t)(ai * 128 + wr * 64 + m * 16 + fr) * ldc + wc * 32 + 8 * fq;
#pragma unroll
                for (int bj = 0; bj < 2; ++bj) *(GAS v4u*)(rowp + bj * 128) = pack8(acc[ai][bj][m][0], acc[ai][bj][m][1]); }
    }
};
template <bool ACCUM> struct EpiGate {
    static constexpr bool PERM = true, AFTER_DRAIN = false, MIDK = false;
    bf16* Y; const bf16* G; unsigned char* Y8;
    __device__ __forceinline__ void operator()(AccRef acc, const pg8::Unit& u, int wr, int wc, int fr, int fq) const {
        const size_t t0 = (size_t)u.pm * 256 * 4096 + u.pn * 256;
#pragma unroll
        for (int ai = 0; ai < 2; ++ai)
#pragma unroll
            for (int m = 0; m < 4; ++m) { const size_t ro = t0 + (size_t)(ai * 128 + wr * 64 + m * 16 + fr) * 4096 + wc * 32 + 8 * fq;
#pragma unroll
                for (int bj = 0; bj < 2; ++bj) { const v4u g = *(const GAS v4u*)(G + ro + bj * 128); f32x4 v0 = acc[ai][bj][m][0], v1 = acc[ai][bj][m][1];
                    v0[0] *= bf_lo(g.x); v0[1] *= bf_hi(g.x); v0[2] *= bf_lo(g.y); v0[3] *= bf_hi(g.y); v1[0] *= bf_lo(g.z); v1[1] *= bf_hi(g.z); v1[2] *= bf_lo(g.w); v1[3] *= bf_hi(g.w);
                    if (ACCUM) { const v4u y = *(const GAS v4u*)(Y + ro + bj * 128);
                        v0[0] += bf_lo(y.x); v0[1] += bf_hi(y.x); v0[2] += bf_lo(y.y); v0[3] += bf_hi(y.y); v1[0] += bf_lo(y.z); v1[1] += bf_hi(y.z); v1[2] += bf_lo(y.w); v1[3] += bf_hi(y.w); }
                    if (ACCUM && WOUT_FP8) { v0 = v0 * SC_Y; v1 = v1 * SC_Y; v2u w; w.x = pk4_fp8(v0[0], v0[1], v0[2], v0[3]); w.y = pk4_fp8(v1[0], v1[1], v1[2], v1[3]); *(GAS v2u*)(Y8 + ro + bj * 128) = w; }
                    else *(GAS v4u*)(Y + ro + bj * 128) = pack8(v0, v1); } }
    }
};
struct EpiGateMerged {
    static constexpr bool PERM = true, AFTER_DRAIN = false, MIDK = true;
    static constexpr float MIDS = BR_FP8 ? SC_OB / SC_OA : 1.0f, ENDS = BR_FP8 ? 1.0f / (SC_OB * SC_WBR) : 1.0f;
    bf16* Y; const unsigned char* GA; const unsigned char* GB; unsigned char* Y8;
    __device__ __forceinline__ void mid(f32x4 (&acc)[2][2][4][2], const pg8::Unit& u, int wr, int wc, int fr, int fq) const {
        size_t rb = (size_t)u.pm * 256 * 4096 + u.pn * 256 + (size_t)(wr * 64 + fr) * 4096 + wc * 32 + 8 * fq;
        asm volatile("" : "+v"(rb));
#pragma unroll
        for (int ai = 0; ai < 2; ++ai)
#pragma unroll
            for (int m = 0; m < 4; ++m) { const size_t ro = rb + (size_t)(ai * 128 + m * 16) * 4096;
#pragma unroll
                for (int bj = 0; bj < 2; ++bj) { const v2u a = *(const GAS v2u*)(GA + ro + bj * 128), b = *(const GAS v2u*)(GB + ro + bj * 128);
                    const unsigned aw[2] = {a.x, a.y}, bw[2] = {b.x, b.y};
#pragma unroll
                    for (int n = 0; n < 2; ++n)
#pragma unroll
                        for (int e = 0; e < 4; ++e) acc[ai][bj][m][n][e] *= ub(aw[n], e) * MIDS * __builtin_amdgcn_rcpf(fmaxf(ub(bw[n], e), 1e-20f));
                    asm volatile("" : "+v"(acc[ai][bj][m][0]), "+v"(acc[ai][bj][m][1])); }
                __builtin_amdgcn_sched_barrier(0); }
    }
    __device__ __forceinline__ void operator()(AccRef acc, const pg8::Unit& u, int wr, int wc, int fr, int fq) const {
        size_t rb = (size_t)u.pm * 256 * 4096 + u.pn * 256 + (size_t)(wr * 64 + fr) * 4096 + wc * 32 + 8 * fq;
        asm volatile("" : "+v"(rb));
#pragma unroll
        for (int ai = 0; ai < 2; ++ai)
#pragma unroll
            for (int m = 0; m < 4; ++m) { const size_t ro = rb + (size_t)(ai * 128 + m * 16) * 4096;
#pragma unroll
                for (int bj = 0; bj < 2; ++bj) { const v2u g = *(const GAS v2u*)(GB + ro + bj * 128); f32x4 v0 = acc[ai][bj][m][0], v1 = acc[ai][bj][m][1];
#pragma unroll
                    for (int e = 0; e < 4; ++e) { v0[e] *= (ENDS / 255.0f) * fmaxf(ub(g.x, e), 1e-20f); v1[e] *= (ENDS / 255.0f) * fmaxf(ub(g.y, e), 1e-20f); }
                    if (WOUT_FP8) { v0 = v0 * SC_Y; v1 = v1 * SC_Y; v2u w; w.x = pk4_fp8(v0[0], v0[1], v0[2], v0[3]); w.y = pk4_fp8(v1[0], v1[1], v1[2], v1[3]); *(GAS v2u*)(Y8 + ro + bj * 128) = w; }
                    else *(GAS v4u*)(Y + ro + bj * 128) = pack8(v0, v1); } }
    }
};
struct EpiDelta {
    static constexpr bool PERM = true, AFTER_DRAIN = false, MIDK = false;
    bf16* dout; const float* gate; float oscale; int pad;
    __device__ __forceinline__ void operator()(AccRef acc, const pg8::Unit& u, int wr, int wc, int fr, int fq) const {
        const float* gb = gate + (size_t)(u.pm >> 4) * MODN + u.pn * 256 + wc * 32 + 8 * fq;
        f32x4 gv[2][2];
#pragma unroll
        for (int bj = 0; bj < 2; ++bj)
#pragma unroll
            for (int n = 0; n < 2; ++n) gv[bj][n] = *(const GAS f32x4*)(gb + bj * 128 + n * 4) * oscale;
#pragma unroll
        for (int ai = 0; ai < 2; ++ai)
#pragma unroll
            for (int m = 0; m < 4; ++m) { bf16* rowp = dout + (size_t)(u.pm * 256 + ai * 128 + wr * 64 + m * 16 + fr) * D + u.pn * 256 + wc * 32 + 8 * fq;
#pragma unroll
                for (int bj = 0; bj < 2; ++bj) *(GAS v4u*)(rowp + bj * 128) = pack8(gv[bj][0] * acc[ai][bj][m][0], gv[bj][1] * acc[ai][bj][m][1]); }
    }
};
struct EpiDeltaI8 {
    static constexpr bool PERM = true, AFTER_DRAIN = false, MIDK = false;
    bf16* dout; const float* gate; const float* rs; float wscale; int pad;
    __device__ __forceinline__ void operator()(AccRef acc, const pg8::Unit& u, int wr, int wc, int fr, int fq) const {
        typedef int i32x4_ __attribute__((ext_vector_type(4)));
        const float* gb = gate + (size_t)(u.pm >> 4) * MODN + u.pn * 256 + wc * 32 + 8 * fq;
        f32x4 gv[2][2]; float rsc[2][4];
#pragma unroll
        for (int bj = 0; bj < 2; ++bj)
#pragma unroll
            for (int n = 0; n < 2; ++n) gv[bj][n] = *(const GAS f32x4*)(gb + bj * 128 + n * 4) * wscale;
#pragma unroll
        for (int ai = 0; ai < 2; ++ai)
#pragma unroll
            for (int m = 0; m < 4; ++m) rsc[ai][m] = rs[u.pm * 256 + ai * 128 + wr * 64 + m * 16 + fr];
#pragma unroll
        for (int ai = 0; ai < 2; ++ai)
#pragma unroll
            for (int m = 0; m < 4; ++m) { bf16* rowp = dout + (size_t)(u.pm * 256 + ai * 128 + wr * 64 + m * 16 + fr) * D + u.pn * 256 + wc * 32 + 8 * fq;
#pragma unroll
                for (int bj = 0; bj < 2; ++bj) { const f32x4 a0 = acc[ai][bj][m][0], a1 = acc[ai][bj][m][1];
                    *(GAS v4u*)(rowp + bj * 128) = pack8(gv[bj][0] * (__builtin_convertvector(__builtin_bit_cast(i32x4_, a0), f32x4) * rsc[ai][m]), gv[bj][1] * (__builtin_convertvector(__builtin_bit_cast(i32x4_, a1), f32x4) * rsc[ai][m])); } }
    }
};
#ifndef RESID_BATCH
#define RESID_BATCH 2
#endif
#ifndef RESID_NT
#define RESID_NT 0
#endif
#if RESID_NT
#define NT_LOAD(p) __builtin_nontemporal_load(p)
#define NT_STORE(v, p) __builtin_nontemporal_store(v, p)
#else
#define NT_LOAD(p) (*(p))
#define NT_STORE(v, p) (*(p) = (v))
#endif
struct EpiResid {
    static constexpr bool PERM = true, AFTER_DRAIN = false, MIDK = false;
    float* out; const float* base; const float* gate; float oscale; int pad;
    __device__ __forceinline__ void operator()(AccRef acc, const pg8::Unit& u, int wr, int wc, int fr, int fq) const {
        const float* gb = gate + (size_t)(u.pm >> 4) * MODN + u.pn * 256 + wc * 32 + 8 * fq;
        f32x4 gv[2][2];
#pragma unroll
        for (int bj = 0; bj < 2; ++bj)
#pragma unroll
            for (int n = 0; n < 2; ++n) gv[bj][n] = *(const GAS f32x4*)(gb + bj * 128 + n * 4) * oscale;
#pragma unroll
        for (int q = 0; q < 2 * (4 / RESID_BATCH); ++q) { const int ai = q / (4 / RESID_BATCH), m0 = (q % (4 / RESID_BATCH)) * RESID_BATCH;
            const size_t r0 = (size_t)(u.pm * 256 + ai * 128 + wr * 64 + m0 * 16 + fr) * D + u.pn * 256 + wc * 32 + 8 * fq; f32x4 bs[RESID_BATCH][2][2];
#pragma unroll
            for (int m = 0; m < RESID_BATCH; ++m)
#pragma unroll
                for (int bj = 0; bj < 2; ++bj)
#pragma unroll
                    for (int n = 0; n < 2; ++n) bs[m][bj][n] = NT_LOAD((const GAS f32x4*)(base + r0 + (size_t)(m * 16) * D + bj * 128 + n * 4));
#pragma unroll
            for (int m = 0; m < RESID_BATCH; ++m)
#pragma unroll
                for (int bj = 0; bj < 2; ++bj)
#pragma unroll
                    for (int n = 0; n < 2; ++n) NT_STORE(bs[m][bj][n] + gv[bj][n] * acc[ai][bj][m0 + m][n], (GAS f32x4*)(out + r0 + (size_t)(m * 16) * D + bj * 128 + n * 4)); }
    }
};
__device__ __forceinline__ float dpp_f(float old, float src, const int ctrl_sel) {
    const int o = __builtin_bit_cast(int, old), x = __builtin_bit_cast(int, src); int r;
    if (ctrl_sel == 0) r = __builtin_amdgcn_update_dpp(o, x, 0x111, 0xf, 0xf, false);
    else if (ctrl_sel == 1) r = __builtin_amdgcn_update_dpp(o, x, 0x101, 0xf, 0xf, false);
    else if (ctrl_sel == 2) r = __builtin_amdgcn_update_dpp(o, x, 0x121, 0xf, 0xf, false);
    else r = __builtin_amdgcn_update_dpp(o, x, 0x12F, 0xf, 0xf, false);
    return __builtin_bit_cast(float, r);
}
template <int SEL> __device__ __forceinline__ f32x4 dpp4(const f32x4 old, const f32x4 src) { f32x4 r; r.x = dpp_f(old.x, src.x, SEL); r.y = dpp_f(old.y, src.y, SEL); r.z = dpp_f(old.z, src.z, SEL); r.w = dpp_f(old.w, src.w, SEL); return r; }
constexpr int XCH_OFF = LDSCTL_OFF + 1024;
static_assert(XCH_OFF + 8192 <= LDS_BYTES, "LDS map");
struct EpiConvAct {
    static constexpr bool PERM = true, AFTER_DRAIN = false, MIDK = false;
    bf16* ACT; float* HALO; const float* cw; const float* cb; LAS f32x4* xch;
    __device__ __forceinline__ void operator()(f32x4 (&acc)[2][2][4][2], const pg8::Unit& u, int wr, int wc, int fr, int fq) const {
        const int wid = wr * 4 + wc, fbase = 128 * u.pn + 32 * wc + 8 * fq;
        const f32x4 zero4 = {0.f, 0.f, 0.f, 0.f};
        f32x4 W0[2][2], W1[2][2], W2[2][2], Bb[2][2];
#pragma unroll
        for (int bj = 0; bj < 2; ++bj)
#pragma unroll
            for (int n = 0; n < 2; ++n) { const int fo = bj * DFF + fbase + 4 * n; W0[bj][n] = *(const GAS f32x4*)(cw + fo); W1[bj][n] = *(const GAS f32x4*)(cw + F2 + fo); W2[bj][n] = *(const GAS f32x4*)(cw + 2 * F2 + fo); Bb[bj][n] = *(const GAS f32x4*)(cb + fo); }
        LAS f32x4* mine = xch + wid * 64;
        if (fr == 0) {
#pragma unroll
            for (int ai = 0; ai < 2; ++ai)
#pragma unroll
                for (int bj = 0; bj < 2; ++bj)
#pragma unroll
                    for (int n = 0; n < 2; ++n) mine[((ai * 2 + 0) * 4 + fq) * 4 + bj * 2 + n] = acc[ai][bj][0][n]; }
        if (fr == 15) {
#pragma unroll
            for (int ai = 0; ai < 2; ++ai)
#pragma unroll
                for (int bj = 0; bj < 2; ++bj)
#pragma unroll
                    for (int n = 0; n < 2; ++n) mine[((ai * 2 + 1) * 4 + fq) * 4 + bj * 2 + n] = acc[ai][bj][3][n]; }
        { const int slot = wr == 0 ? fr : fr - 12;
          if ((wr == 0 && fr < 2) || (wr == 1 && fr >= 14)) { float* hp = HALO + ((size_t)u.pm * 4 + slot) * F2 + 256 * u.pn + 32 * wc + 8 * fq;
#pragma unroll
              for (int bj = 0; bj < 2; ++bj)
#pragma unroll
                  for (int n = 0; n < 2; ++n) *(GAS f32x4*)(hp + bj * 128 + 4 * n) = wr == 0 ? acc[0][bj][0][n] : acc[1][bj][3][n]; } }
        asm volatile("s_waitcnt vmcnt(0) lgkmcnt(0)" ::: "memory"); __builtin_amdgcn_s_barrier(); asm volatile("" ::: "memory");
#pragma unroll
        for (int bj = 0; bj < 2; ++bj)
#pragma unroll
            for (int n = 0; n < 2; ++n) asm volatile("" : "+v"(W0[bj][n]), "+v"(W1[bj][n]), "+v"(W2[bj][n]), "+v"(Bb[bj][n]));
        __builtin_amdgcn_sched_barrier(0);
#pragma unroll
        for (int bj = 0; bj < 2; ++bj) {
#pragma unroll
            for (int ai = 0; ai < 2; ++ai) {
                const int rho = 2 * ai + wr;
                f32x4 carry[2], eN[2];
#pragma unroll
                for (int n = 0; n < 2; ++n) {
                    carry[n] = rho > 0 ? xch[(((rho - 1) & 1) * 4 + wc) * 64 + ((((rho - 1) >> 1) * 2 + 1) * 4 + fq) * 4 + bj * 2 + n] : zero4;
                    eN[n] = rho < 3 ? xch[(((rho + 1) & 1) * 4 + wc) * 64 + ((((rho + 1) >> 1) * 2 + 0) * 4 + fq) * 4 + bj * 2 + n] : zero4; }
#pragma unroll
                for (int m = 0; m < 4; ++m)
#pragma unroll
                    for (int n = 0; n < 2; ++n) {
                        const f32x4 cur = acc[ai][bj][m][n];
                        const f32x4 prv = dpp4<0>(carry[n], cur);
                        const f32x4 tn = m < 3 ? dpp4<3>(zero4, acc[ai][bj][m < 3 ? m + 1 : 3][n]) : eN[n];
                        const f32x4 nxt = dpp4<1>(tn, cur);
                        carry[n] = dpp4<2>(zero4, cur);
                        acc[ai][bj][m][n] = W0[bj][n] * prv + W1[bj][n] * cur + W2[bj][n] * nxt + Bb[bj][n];
                        asm volatile("" : "+v"(acc[ai][bj][m][n]));
                        __builtin_amdgcn_sched_barrier(0);
                    }
            }
        }
#pragma unroll
        for (int ai = 0; ai < 2; ++ai)
#pragma unroll
            for (int m = 0; m < 4; ++m) { bf16* rowp = ACT + (size_t)(u.pm * 256 + ai * 128 + wr * 64 + m * 16 + fr) * DFF + fbase;
                f32x4 o[2];
#pragma unroll
                for (int n = 0; n < 2; ++n) { const f32x4 g = acc[ai][0][m][n], v = acc[ai][1][m][n];
#pragma unroll
                    for (int e = 0; e < 4; ++e) o[n][e] = g[e] * sigmoid_f(g[e]) * v[e]; }
                *(GAS v4u*)rowp = pack8(o[0], o[1]); __builtin_amdgcn_sched_barrier(0); }
    }
};
struct EpiResidI8 {
    static constexpr bool PERM = true, AFTER_DRAIN = false, MIDK = false;
    float* out; const float* base; const float* gate; const float* rs; float wscale; int pad;
    __device__ __forceinline__ void operator()(AccRef acc, const pg8::Unit& u, int wr, int wc, int fr, int fq) const {
        typedef int i32x4_ __attribute__((ext_vector_type(4)));
        const float* gb = gate + (size_t)(u.pm >> 4) * MODN + u.pn * 256 + wc * 32 + 8 * fq;
        f32x4 gv[2][2];
#pragma unroll
        for (int bj = 0; bj < 2; ++bj)
#pragma unroll
            for (int n = 0; n < 2; ++n) gv[bj][n] = *(const GAS f32x4*)(gb + bj * 128 + n * 4) * wscale;
#pragma unroll
        for (int q = 0; q < 2 * (4 / RESID_BATCH); ++q) { const int ai = q / (4 / RESID_BATCH), m0 = (q % (4 / RESID_BATCH)) * RESID_BATCH;
            const int g0 = u.pm * 256 + ai * 128 + wr * 64 + m0 * 16 + fr; const size_t r0 = (size_t)g0 * D + u.pn * 256 + wc * 32 + 8 * fq; f32x4 bs[RESID_BATCH][2][2]; float rsc[RESID_BATCH];
#pragma unroll
            for (int m = 0; m < RESID_BATCH; ++m) { rsc[m] = rs[g0 + m * 16];
#pragma unroll
                for (int bj = 0; bj < 2; ++bj)
#pragma unroll
                    for (int n = 0; n < 2; ++n) bs[m][bj][n] = NT_LOAD((const GAS f32x4*)(base + r0 + (size_t)(m * 16) * D + bj * 128 + n * 4)); }
#pragma unroll
            for (int m = 0; m < RESID_BATCH; ++m)
#pragma unroll
                for (int bj = 0; bj < 2; ++bj)
#pragma unroll
                    for (int n = 0; n < 2; ++n) { const f32x4 a = acc[ai][bj][m0 + m][n];
                        NT_STORE(bs[m][bj][n] + gv[bj][n] * (__builtin_convertvector(__builtin_bit_cast(i32x4_, a), f32x4) * rsc[m]), (GAS f32x4*)(out + r0 + (size_t)(m * 16) * D + bj * 128 + n * 4)); } }
    }
};
template <bool FP8C> struct InProjOrder {
    static constexpr int NT = FP8C ? NT_IN8 : NT_IN16;
    pg8::StaticOrder base; int G, c;
    __device__ __forceinline__ void init(int G_, int c_) { base.init(M, NT * 256, G_, c_); G = G_; c = c_; }
    __device__ __forceinline__ bool next(int i, pg8::Unit& u) const {
        if (base.next(i, u)) return true;
        constexpr int NCT = V_FP8 ? (FP8C ? 20 : 0) : 10;
        const long e = (long)i * G + c - (long)(M / 256) * NT; if (e < 0 || e >= 4 * NCT) return false;
        u.pm = 64 + (int)(e & 3); const int j = (int)(e >> 2); u.pn = V_FP8 ? (j < 4 ? 8 + j : 16 + j) : (FP8C ? (j < 2 ? 8 + j : 16 + j) : j); return true;
    }
    __device__ __forceinline__ void a_ready(const pg8::Unit&) const {}
    __device__ __forceinline__ void done(const pg8::Unit&) const {}
};

struct EpiNullProbe {
    static constexpr bool PERM = true, AFTER_DRAIN = false, MIDK = false;
    float* O; int flag; int pad;
    __device__ __forceinline__ void operator()(AccRef acc, const pg8::Unit& u, int wr, int wc, int fr, int fq) const {
        f32x4 t = {0.f, 0.f, 0.f, 0.f};
#pragma unroll
        for (int ai = 0; ai < 2; ++ai)
#pragma unroll
            for (int bj = 0; bj < 2; ++bj)
#pragma unroll
                for (int m = 0; m < 4; ++m) t += acc[ai][bj][m][0] + acc[ai][bj][m][1];
        if (flag) O[threadIdx.x] = (t[0] + t[1]) + (t[2] + t[3]);
    }
};
template <int SAME> struct ProbeOrder { pg8::StaticOrder base;
    __device__ __forceinline__ bool next(int i, pg8::Unit& u) const { const bool ok = base.next(i, u); if (SAME & 1) u.pm = 0; if (SAME & 2) u.pn = 0; return ok; }
    __device__ __forceinline__ void a_ready(const pg8::Unit&) const {}
    __device__ __forceinline__ void done(const pg8::Unit&) const {} };
#ifndef P11_WGM
#define P11_WGM 8
#endif
#ifndef TUNE_ALIGN
#define TUNE_ALIGN true
#endif
#ifndef TUNE_SP2
#define TUNE_SP2 true
#endif
static_assert(sizeof(Args) == 22 * 8 + 16, "kernarg layout");
__global__ void __launch_bounds__(NWAVES * 64, 2) fwd(Args args) {
    extern __shared__ __attribute__((aligned(16))) unsigned char lds[];
    Frame F;
    F.lds = (LAS unsigned char*)lds;
    F.MISC = (volatile LAS unsigned*)(F.lds + MISC_OFF);
    F.tid = threadIdx.x; F.lane = F.tid & 63; F.wave = __builtin_amdgcn_readfirstlane(F.tid >> 6);
    F.G = gridDim.x; { const int bx = blockIdx.x; F.vcu = (F.G % 8 == 0) ? (bx % 8) * (F.G / 8) + bx / 8 : bx; }
    F.ctl = (gu32*)(args.ws + WS_CTL);
    for (int u = F.tid; u < (LDS_BYTES - LDSCTL_OFF) / 4; u += NWAVES * 64) ((LAS unsigned*)(F.lds + LDSCTL_OFF))[u] = 0u;
    __syncthreads();
    XcdBarrier bar; bar.bar = (unsigned*)(F.ctl + CW_BAR); bar.x = 0; bar.st = nullptr;
    if (N_LAUNCHES == 1) bar = xcd_barrier_post((unsigned*)(F.ctl + CW_BAR), F.MISC + 8);
#ifdef TPROBE_LO
    unsigned long long t_lo = 0, t_hi = 0; int tcnt = 0;
    if (TPROBE_LO == 0) t_lo = __builtin_amdgcn_s_memrealtime();
#define TSTAMP() do { ++tcnt; const unsigned long long tn = __builtin_amdgcn_s_memrealtime(); if (tcnt == TPROBE_LO) t_lo = tn; if (tcnt == TPROBE_HI) t_hi = tn; } while (0)
#else
#define TSTAMP() do { } while (0)
#endif
#define GRID_BAR() do { if (N_LAUNCHES == 1) xcd_barrier(bar); TSTAMP(); } while (0)
    const int lo = args.ph_lo, hi = args.ph_hi;
#ifndef PH_MASK
#define PH_MASK 0x1fff
#endif
#define IN(k) (((PH_MASK >> (k)) & 1) && lo <= (k) && (k) < hi)
#define BOTH(k) (IN(k) && IN((k) + 1))
#ifndef REP2
#define REP2 0
#endif
#define NREP(k) (((REP2 >> (k)) & 1) ? 2 : 1)
    LAS unsigned char* ring = F.lds + RING_OFF;
    typedef const pg8::bf16_t* cbp;

    if (IN(0)) { p0a_prologue(F); GRID_BAR();
                 p1_norm1(F); __syncthreads(); p0_transpose_runs(F, CW_QUEUE, 0, P0_RUN_SPLIT);
                 if (BOTH(0)) GRID_BAR();
                 if ((INPROJ_MODE == 2 && wq_true(F, 0) > wq_clip(F, 0)) || (WOUT_MODE == 2 && wq_true(F, 1) > wq_clip(F, 1))) {
                     p0_transpose_runs(F, CW_QUEUE5, 0, P0_RUN_UP0, true, P0_RUN_IN1, P0_RUN_OUT0); if (BOTH(0)) GRID_BAR(); } }
    if (IN(2)) { for (int rep = 0; rep < NREP(2); ++rep) {
        { pg8::Gemm g = pg8::gemm_rowmajor((cbp)F.H(), (cbp)F.Win(), M + MC, NT_IN16 * 256, D, D, D); InProjOrder<false> Sd; Sd.init(F.G, (int)blockIdx.x);
          EpiInProj<false> E{F.QO(), F.KA(), F.VA(), F.KB(), F.VB(), F.GA(), F.GB(), nullptr, 1.0f};
          pg8::gemm_phase<EpiInProj<false>, InProjOrder<false>, true, true, 0>(ring, g, Sd, E); }
        { pg8::Gemm g = pg8::gemm_rowmajor((cbp)F.ACT(), (cbp)((unsigned char*)F.Win() + WIN8_OFF), M + MC, NT_IN8 * 256, D / 2, D / 2, D / 2); InProjOrder<true> Sd; Sd.init(F.G, F.G - 1 - (int)blockIdx.x);
          EpiInProj<true> E{F.QO(), F.KA(), F.VA(), F.KB(), F.VB(), F.GA(), F.GB(), F.rsh(), wq_range(F, 0) * (1.0f / 127.0f)};
          pg8::gemm_phase<EpiInProj<true>, InProjOrder<true>, true, true, INPROJ_MODE>(ring, g, Sd, E); }
        if (DEFER_UP_RUNS > 0) { __syncthreads(); p0_transpose_runs(F, CW_QUEUE3, P0_RUN_SPLIT, P0_RUN_DN0); }
        if (BOTH(2)) GRID_BAR();
    } }
    if (IN(3)) { p3_qkfix(F); if (BOTH(3)) GRID_BAR(); }
    if (IN(4)) { p4_attention(F); if (BOTH(4)) GRID_BAR(); }
    if (IN(5)) { for (int rep = 0; rep < NREP(5); ++rep) {
        pg8::Gemm g = BR_FP8 ? pg8::gemm_rowmajor((cbp)F.ACT(), (cbp)F.Wbr(), M, D, 2048, 2048, 2048) : pg8::gemm_rowmajor((cbp)F.QO(), (cbp)F.Wbr(), M, D, 4096, 4096, 4096);
        pg8::StaticOrder Sd; Sd.init(M, D, F.G, (int)blockIdx.x);
        EpiGateMerged E{F.H(), (const unsigned char*)F.GA(), (const unsigned char*)F.GB(), (unsigned char*)F.KB()};
        pg8::gemm_phase<EpiGateMerged, pg8::StaticOrder, true, true, BR_FP8 ? 1 : 0>(ring, g, Sd, E);
        if (BOTH(5)) GRID_BAR();
    } }
    if (IN(6) && WOUT_MODE == 2) { p6_quant_y(F); if (BOTH(6)) GRID_BAR(); }
    static_assert(WOUT_MODE == 2, "the residual-delta scheme below is wired for the int8 w_out GEMM");
    if (IN(7)) { for (int rep = 0; rep < NREP(7); ++rep) {
        pg8::StaticOrder Sd; Sd.init(M, D, F.G, (int)blockIdx.x);
        if constexpr (WOUT_MODE == 2) { pg8::Gemm g = pg8::gemm_rowmajor((cbp)F.KB(), (cbp)F.Wout(), M, D, D / 2, D / 2, D / 2);
            EpiDeltaI8 E{F.H(), F.modf() + 2 * D, F.rsy(), wq_range(F, 1) * (1.0f / 127.0f), 0};
            pg8::gemm_phase<EpiDeltaI8, pg8::StaticOrder, true, true, 2>(ring, g, Sd, E); }
        else if constexpr (WOUT_FP8) { pg8::Gemm g = pg8::gemm_rowmajor((cbp)F.KB(), (cbp)F.Wout(), M, D, D / 2, D / 2, D / 2);
            EpiResid E{F.out(), F.x(), F.modf() + 2 * D, 1.0f / (SC_WOUT * SC_Y), 0};
            pg8::gemm_phase<EpiResid, pg8::StaticOrder, true, true, 1>(ring, g, Sd, E); }
        else { pg8::Gemm g = pg8::gemm_rowmajor((cbp)F.H(), (cbp)F.Wout(), M, D, D, D, D);
            EpiResid E{F.out(), F.x(), F.modf() + 2 * D, 1.0f, 0};
            pg8::gemm_phase<EpiResid, pg8::StaticOrder, true, true, 0>(ring, g, Sd, E); }
        if (BOTH(7)) GRID_BAR();
    } }
    if (IN(8)) { for (int rep = 0; rep < NREP(8); ++rep) { p7_norm2(F); if (BOTH(8)) GRID_BAR(); } }
#ifdef GEMM_PROBE
    if (IN(9)) { pg8::Gemm g = pg8::gemm_rowmajor((cbp)F.QO(), (cbp)F.Wup(), M, F2, D, D, D); ProbeOrder<GEMM_PROBE & 3> Sd; Sd.base.init(M, F2, F.G, (int)blockIdx.x);
        EpiNullProbe E{(float*)F.ACT(), args.pad, 0};
        pg8::gemm_phase<EpiNullProbe, ProbeOrder<GEMM_PROBE & 3>, true, true>(ring, g, Sd, E); GRID_BAR(); }
#endif
    if (IN(9)) { for (int rep = 0; rep < NREP(9); ++rep) {
        pg8::Gemm g = pg8::gemm_rowmajor((cbp)F.QO(), (cbp)F.Wup(), M, F2, D, D, D);
        pg8::StaticOrder Sd; Sd.init(M, F2, F.G, (int)blockIdx.x);
        EpiConvAct E{F.ACT(), (float*)F.Win(), F.conv_w(), F.conv_b(), (LAS f32x4*)(F.lds + XCH_OFF)};
        pg8::gemm_phase<EpiConvAct, pg8::StaticOrder, true, TUNE_SP2>(ring, g, Sd, E);
        __syncthreads(); p0_transpose_runs(F, CW_QUEUE4, P0_RUN_DN0, P0_RUN_END);
        if (BOTH(9)) GRID_BAR();
    } }
    if (IN(10)) { for (int rep = 0; rep < NREP(10); ++rep) { p10_convfix(F); if (BOTH(10)) GRID_BAR(); } }
    if (IN(11)) {
        pg8::Gemm g = pg8::gemm_rowmajor((cbp)F.ACT(), (cbp)F.Wdn(), M, D, DFF, DFF, DFF); pg8::StaticOrder Sd; Sd.init(M, D, F.G, (int)blockIdx.x, P11_WGM);
        EpiDelta E{F.QO(), F.modf() + 5 * D, 1.0f, 0};
        pg8::gemm_phase<EpiDelta, pg8::StaticOrder, TUNE_ALIGN, TUNE_SP2>(ring, g, Sd, E);
        if (BOTH(11)) GRID_BAR();
    }
#ifdef TPROBE_LO
    if (IN(12)) { const float us = (float)(long long)(t_hi - t_lo) * 0.01f - (float)TPROBE_OFF; p11_final(F, 1.0f + sqrtf(fmaxf(us, 0.f) * 1e-7f)); }
#else
    if (IN(12)) { p11_final(F); }
#endif
#undef IN
#undef BOTH
#undef GRID_BAR
}

extern "C" void kernel_launch(void* const* d_in, const int* in_sizes, int n_in, void* d_out, int out_size, void* d_ws, size_t ws_size, hipStream_t stream) {
    static int grid = 0;
    if (grid == 0) {
        if (n_in != 20 || in_sizes[0] != M * D || out_size != M * D || ws_size < WS_END) { fprintf(stderr, "kernel_launch: unexpected shapes (n_in %d, in0 %d, out %d, ws %zu < %zu?)\n", n_in, n_in > 0 ? in_sizes[0] : -1, out_size, ws_size, (size_t)WS_END); grid = -1; return; }
        int dev = 0, cus = 0, per_cu = 0;
        if (hipGetDevice(&dev) != hipSuccess || hipDeviceGetAttribute(&cus, hipDeviceAttributeMultiprocessorCount, dev) != hipSuccess) { grid = -1; return; }
        if (hipFuncSetAttribute((const void*)fwd, hipFuncAttributeMaxDynamicSharedMemorySize, LDS_BYTES) != hipSuccess) { fprintf(stderr, "kernel_launch: hipFuncSetAttribute failed\n"); grid = -1; return; }
        if (hipOccupancyMaxActiveBlocksPerMultiprocessor(&per_cu, (const void*)fwd, NWAVES * 64, LDS_BYTES) != hipSuccess || per_cu < 1) fprintf(stderr, "kernel_launch: occupancy query reports %d\n", per_cu);
        (void)hipGetLastError();
        grid = cus < 256 ? cus : 256;
    }
    if (grid < 0) return;
    if (hipMemsetAsync((char*)d_ws + WS_CTL, 0, CTL_ZERO_BYTES, stream) != hipSuccess) return;
    Args a{};
    for (int i = 0; i < 20; ++i) a.in[i] = (const float*)d_in[i];
    a.out = (float*)d_out; a.ws = (unsigned char*)d_ws;
    for (int li = 0; li < N_LAUNCHES; ++li) {
        if (N_LAUNCHES == 1) { a.ph_lo = 0; a.ph_hi = N_PHASES; } else { a.ph_lo = li; a.ph_hi = li + 1; }
        a.li = li;
        hipLaunchKernelGGL(fwd, dim3(grid), dim3(NWAVES * 64), LDS_BYTES, stream, a);
        const hipError_t le = hipPeekAtLastError();
        if (le != hipSuccess) { fprintf(stderr, "kernel_launch: launch %d failed: %s\n", li, hipGetErrorName(le)); break; }
    }
}
```

```cpp
#include <hip/hip_runtime.h>
#include <cstdio>
#include <cstdint>
namespace pg8 {
#define PG8_LAS __attribute__((address_space(3)))
typedef unsigned short bf16_t;
typedef short bf16x8 __attribute__((ext_vector_type(8)));
typedef float f32x4 __attribute__((ext_vector_type(4)));
typedef unsigned u32x4 __attribute__((ext_vector_type(4)));
typedef int i32x8 __attribute__((ext_vector_type(8)));
typedef short s16x16 __attribute__((ext_vector_type(16)));
template <bool FP8> struct Frag { bf16x8 h[2]; };
template <> struct Frag<true> { s16x16 v; };
__device__ __forceinline__ void fset(Frag<false>& f, int k, bf16x8 x) { f.h[k] = x; }
__device__ __forceinline__ void fset(Frag<true>& f, int k, bf16x8 x) { if (k == 0) f.v.lo = x; else f.v.hi = x; }
__device__ __forceinline__ f32x4 fmma(const Frag<false>& b, const Frag<false>& a, f32x4 c) { c = __builtin_amdgcn_mfma_f32_16x16x32_bf16(b.h[0], a.h[0], c, 0, 0, 0); return __builtin_amdgcn_mfma_f32_16x16x32_bf16(b.h[1], a.h[1], c, 0, 0, 0); }
typedef int i32x4 __attribute__((ext_vector_type(4)));
__device__ __forceinline__ f32x4 fmma_i8(const Frag<false>& b, const Frag<false>& a, f32x4 c) {
    i32x4 ci = __builtin_bit_cast(i32x4, c);
    ci = __builtin_amdgcn_mfma_i32_16x16x64_i8(__builtin_bit_cast(i32x4, b.h[0]), __builtin_bit_cast(i32x4, a.h[0]), ci, 0, 0, 0);
    ci = __builtin_amdgcn_mfma_i32_16x16x64_i8(__builtin_bit_cast(i32x4, b.h[1]), __builtin_bit_cast(i32x4, a.h[1]), ci, 0, 0, 0);
    return __builtin_bit_cast(f32x4, ci); }
__device__ __forceinline__ f32x4 fmma(const Frag<true>& b, const Frag<true>& a, f32x4 c) { const int one = 0x7F7F7F7F;
    asm volatile("v_mfma_scale_f32_16x16x128_f8f6f4 %0, %1, %2, %0, %3, %3 op_sel_hi:[0,0,0]" : "+v"(c) : "v"(__builtin_bit_cast(i32x8, b.v)), "v"(__builtin_bit_cast(i32x8, a.v)), "v"(one)); return c; }
constexpr int BM = 256, BK = 64, HALF = 128, HTB = HALF * BK * 2  , STAGE_BYTES = 8 * HTB, NXCD = 8, WGM = 8;

__host__ __device__ __forceinline__ int lds_byte(int r, int c) { const int st = (r >> 4) * 2 + (c >> 5), rr = r & 15, cc = c & 31, ob = rr * 64 + cc * 2; return st * 1024 + (ob ^ (((ob >> 9) & 1) << 5)); }
__host__ __device__ __forceinline__ void stage_rc(int b, int& R, int& C) { const int st = b / 1024, sb = b % 1024, swz = sb ^ (((sb >> 9) & 1) << 5); R = (st >> 1) * 16 + swz / 64; C = (st & 1) * 32 + (swz % 64) / 2; }
__host__ __device__ __forceinline__ int perm32(int rho) { const int n = rho >> 4, i = rho & 15; return 8 * (i >> 2) + 4 * n + (i & 3); }

struct Unit { int pm, pn; };
struct Gemm { const bf16_t* A; const bf16_t* Bt; int M, N, K, lda, ldb; unsigned ksA, ksB; size_t tsA, tsB; };
__host__ __device__ __forceinline__ Gemm gemm_rowmajor(const bf16_t* A, const bf16_t* Bt, int M, int N, int K, int lda, int ldb) { return Gemm{A, Bt, M, N, K, lda, ldb, 128u, 128u, (size_t)512 * lda, (size_t)512 * ldb}; }

struct StaticOrder {
    int nM, nN, nwg, G, c, wgm;
    __host__ __device__ void init(int M, int N, int G_, int c_, int wgm_ = WGM) { nM = M / BM; nN = N / BM; nwg = nM * nN; G = G_; c = c_; wgm = wgm_; }
    __host__ __device__ bool next(int i, Unit& u) const {
        const long L = (long)i * G + c; if (L >= nwg) return false;
        int wgid = (int)L; { const int q = nwg / NXCD, r = nwg % NXCD, xcd = wgid % NXCD, off = wgid / NXCD; wgid = (xcd < r ? xcd * (q + 1) : r * (q + 1) + (xcd - r) * q) + off; }
        const int nig = wgm * nN, gid = wgid / nig, fm = gid * wgm, gsz = (nM - fm) < wgm ? (nM - fm) : wgm;
        u.pm = fm + ((wgid % nig) % gsz); u.pn = (wgid % nig) / gsz; return true;
    }
    __device__ __forceinline__ void a_ready(const Unit&) const {}
    __device__ __forceinline__ void done(const Unit&) const {}
};

template <class Epi, class Sched, bool ALIGN_EPI = false, bool SP2 = false, int MODE = 0  >
__device__ __forceinline__ void gemm_phase(PG8_LAS unsigned char* lds, const Gemm g, const Sched& S, const Epi& E) {
    int tid_o = threadIdx.x; asm volatile("" : "+v"(tid_o));
    const int tid = tid_o, wid = __builtin_amdgcn_readfirstlane(tid >> 6), lane = tid & 63, wr = wid >> 2, wc = wid & 3, fr = lane & 15, fq = lane >> 4;
    const int K = g.K, nt = K / BK;
    unsigned voffA[2], voffB[2];
#pragma unroll
    for (int i = 0; i < 2; ++i) { int R, C; stage_rc(tid * 16 + i * 8192, R, C); const int Rb = Epi::PERM ? ((R & ~31) + perm32(R & 31)) : R;
        voffA[i] = (unsigned)(R * g.lda + C) * 2u; voffB[i] = (unsigned)(Rb * g.ldb + C) * 2u; }
    const size_t kstepA = g.ksA, kstepB = g.ksB;
    const size_t hstepA = (size_t)HALF * g.lda * 2, hstepB = (size_t)HALF * g.ldb * 2;
    const size_t tstepA = g.tsA, tstepB = g.tsB;
    const unsigned ldsw = (unsigned)wid * 1024u;
    const int aoff = lds_byte(wr * 64 + fr, fq * 8), boff = lds_byte(wc * 32 + fr, fq * 8);
#define PG8_SA(b, h) (((b) * 2 + (h)) * HTB)
#define PG8_SB(b, h) ((4 + (b) * 2 + (h)) * HTB)
#define PG8_STAGE(bufoff, gbase, voff) do { _Pragma("unroll") for (int _i = 0; _i < 2; ++_i) \
        __builtin_amdgcn_global_load_lds((const unsigned*)((const char*)(gbase) + (voff)[_i]), (PG8_LAS unsigned*)(lds + (bufoff) + ldsw + _i * 8192), 16, 0, 0); } while (0)
#define PG8_LDA(dst, b, h) do { _Pragma("unroll") for (int m = 0; m < 4; ++m) _Pragma("unroll") for (int k = 0; k < 2; ++k) fset(dst[m], k, *(const PG8_LAS bf16x8*)(lds + PG8_SA(b, h) + aoff + m * 2048 + k * 1024)); } while (0)
#define PG8_LDB(dst, b, h) do { _Pragma("unroll") for (int n = 0; n < 2; ++n) _Pragma("unroll") for (int k = 0; k < 2; ++k) fset(dst[n], k, *(const PG8_LAS bf16x8*)(lds + PG8_SB(b, h) + boff + n * 2048 + k * 1024)); } while (0)
#define PG8_MMA(ai, bj, At, Bt) do { __builtin_amdgcn_s_setprio(1); _Pragma("unroll") for (int m = 0; m < 4; ++m) _Pragma("unroll") for (int n = 0; n < 2; ++n) { if constexpr (MODE == 2) acc[ai][bj][m][n] = fmma_i8(Bt[n], At[m], acc[ai][bj][m][n]); else acc[ai][bj][m][n] = fmma(Bt[n], At[m], acc[ai][bj][m][n]); } __builtin_amdgcn_s_setprio(0); } while (0)
#define PG8_WAIT_V(n) asm volatile("s_waitcnt vmcnt(" #n ")" ::: "memory")
#define PG8_WAIT_L(n) asm volatile("s_waitcnt lgkmcnt(" #n ")" ::: "memory")
#define PG8_BAR __builtin_amdgcn_s_barrier()
#define PG8_SCHED __builtin_amdgcn_sched_barrier(0)
    Unit cur, nxt; int ui = 0;
    if (!S.next(0, cur)) return;
    f32x4 acc[2][2][4][2];
#pragma unroll
    for (int a = 0; a < 2; ++a)
#pragma unroll
        for (int b = 0; b < 2; ++b)
#pragma unroll
            for (int m = 0; m < 4; ++m)
#pragma unroll
                for (int n = 0; n < 2; ++n) acc[a][b][m][n] = (f32x4){0.f, 0.f, 0.f, 0.f};
    constexpr bool FP8 = (MODE == 1);
    Frag<FP8> At[4], B0[2], B1[2];
    const char* cA = (const char*)g.A + (size_t)cur.pm * tstepA; const char* cB = (const char*)g.Bt + (size_t)cur.pn * tstepB;
    S.a_ready(cur);
    if constexpr (SP2) {
        PG8_STAGE(PG8_SB(0, 0), cB, voffB); PG8_STAGE(PG8_SB(0, 1), cB + hstepB, voffB); PG8_STAGE(PG8_SA(0, 0), cA, voffA); PG8_STAGE(PG8_SA(0, 1), cA + hstepA, voffA);
        if (wr == 1) PG8_BAR;
        PG8_WAIT_V(2); PG8_BAR;
        PG8_STAGE(PG8_SB(1, 0), cB + kstepB, voffB); PG8_STAGE(PG8_SA(1, 0), cA + kstepA, voffA); PG8_STAGE(PG8_SB(1, 1), cB + hstepB + kstepB, voffB);
        PG8_WAIT_V(6); PG8_BAR;
    } else {
        PG8_STAGE(PG8_SB(0, 0), cB, voffB); PG8_STAGE(PG8_SA(0, 0), cA, voffA); PG8_STAGE(PG8_SB(0, 1), cB + hstepB, voffB); PG8_STAGE(PG8_SA(0, 1), cA + hstepA, voffA);
        if (wr == 1) PG8_BAR;
        PG8_WAIT_V(4); PG8_BAR;
        PG8_STAGE(PG8_SB(1, 0), cB + kstepB, voffB); PG8_STAGE(PG8_SA(1, 0), cA + kstepA, voffA); PG8_STAGE(PG8_SB(1, 1), cB + hstepB + kstepB, voffB);
        PG8_WAIT_V(6); PG8_BAR;
    }
    for (;;) {
        const bool has_next = S.next(ui + 1, nxt);
        const char* nA = has_next ? (const char*)g.A + (size_t)nxt.pm * tstepA : cA; const char* nB = has_next ? (const char*)g.Bt + (size_t)nxt.pn * tstepB : cB;
        constexpr int NPASS = Epi::MIDK ? 2 : 1;
#pragma unroll
        for (int hp = 0; hp < NPASS; ++hp) {
        const int t_lo = hp == 0 ? 0 : (nt >> 1), t_hi = (NPASS == 2 && hp == 0) ? (nt >> 1) : nt;
        if constexpr (Epi::MIDK) { if (hp == 1) { if constexpr (FP8) asm volatile("s_nop 15\n\ts_nop 15" ::: "memory"); E.mid(acc, cur, wr, wc, fr, fq); } }
        for (int t = t_lo; t < t_hi; t += 2) {
            const bool last = (t == nt - 2);
            const char* a1 = cA + (size_t)(t + 1) * kstepA;
            const char* a2 = last ? nA : cA + (size_t)(t + 2) * kstepA; const char* b2 = last ? nB : cB + (size_t)(t + 2) * kstepB;
            const char* a3 = a2 + kstepA; const char* b3 = b2 + kstepB;
            if (last && has_next) S.a_ready(nxt);
            if constexpr (SP2) {
            PG8_LDB(B0, 0, 0); PG8_LDB(B1, 0, 1); PG8_SCHED; PG8_LDA(At, 0, 0); PG8_STAGE(PG8_SA(1, 1), a1 + hstepA, voffA);
            PG8_WAIT_V(8); PG8_WAIT_L(0); PG8_BAR; PG8_MMA(0, 0, At, B0); PG8_MMA(0, 1, At, B1); PG8_BAR; PG8_SCHED;
            PG8_LDA(At, 0, 1); PG8_STAGE(PG8_SB(0, 0), b2, voffB); PG8_STAGE(PG8_SB(0, 1), b2 + hstepB, voffB); PG8_STAGE(PG8_SA(0, 0), a2, voffA);
            PG8_WAIT_V(8); PG8_WAIT_L(0); PG8_BAR; PG8_MMA(1, 0, At, B0); PG8_MMA(1, 1, At, B1); PG8_BAR; PG8_SCHED;
            PG8_LDB(B0, 1, 0); PG8_LDB(B1, 1, 1); PG8_SCHED; PG8_LDA(At, 1, 0); PG8_STAGE(PG8_SA(0, 1), a2 + hstepA, voffA);
            PG8_WAIT_V(8); PG8_WAIT_L(0); PG8_BAR; PG8_MMA(0, 0, At, B0); PG8_MMA(0, 1, At, B1); PG8_BAR; PG8_SCHED;
            PG8_LDA(At, 1, 1); PG8_STAGE(PG8_SB(1, 0), b3, voffB); PG8_STAGE(PG8_SB(1, 1), b3 + hstepB, voffB); PG8_STAGE(PG8_SA(1, 0), a3, voffA);
            PG8_WAIT_V(8); PG8_WAIT_L(0); PG8_BAR; PG8_MMA(1, 0, At, B0); PG8_MMA(1, 1, At, B1); PG8_BAR; PG8_SCHED;
            } else {
            PG8_LDB(B0, 0, 0); PG8_SCHED; PG8_LDA(At, 0, 0); PG8_STAGE(PG8_SA(1, 1), a1 + hstepA, voffA);
            PG8_WAIT_L(8); PG8_BAR; PG8_WAIT_L(0); PG8_MMA(0, 0, At, B0); PG8_BAR; PG8_SCHED;
            PG8_LDB(B1, 0, 1); PG8_STAGE(PG8_SB(0, 0), b2, voffB);
            PG8_BAR; PG8_WAIT_L(0); PG8_MMA(0, 1, At, B1); PG8_BAR;
            PG8_LDA(At, 0, 1); PG8_STAGE(PG8_SA(0, 0), a2, voffA);
            PG8_BAR; PG8_WAIT_L(0); PG8_MMA(1, 0, At, B0); PG8_BAR; PG8_SCHED;
            PG8_STAGE(PG8_SB(0, 1), b2 + hstepB, voffB);
            PG8_WAIT_V(6); PG8_BAR; PG8_MMA(1, 1, At, B1); PG8_BAR;
            PG8_LDB(B0, 1, 0); PG8_SCHED; PG8_LDA(At, 1, 0); PG8_STAGE(PG8_SA(0, 1), a2 + hstepA, voffA);
            PG8_WAIT_L(8); PG8_BAR; PG8_WAIT_L(0); PG8_MMA(0, 0, At, B0); PG8_BAR; PG8_SCHED;
            PG8_LDB(B1, 1, 1); PG8_STAGE(PG8_SB(1, 0), b3, voffB);
            PG8_BAR; PG8_WAIT_L(0); PG8_MMA(0, 1, At, B1); PG8_BAR;
            PG8_LDA(At, 1, 1); PG8_STAGE(PG8_SA(1, 0), a3, voffA);
            PG8_BAR; PG8_WAIT_L(0); PG8_MMA(1, 0, At, B0); PG8_BAR; PG8_SCHED;
            PG8_STAGE(PG8_SB(1, 1), b3 + hstepB, voffB);
            PG8_WAIT_V(6); PG8_BAR; PG8_MMA(1, 1, At, B1); PG8_BAR;
            }
        }
        }
        if constexpr (ALIGN_EPI) { if (wr == 0) PG8_BAR; }
        if constexpr (FP8) asm volatile("s_nop 15\n\ts_nop 15" ::: "memory");
        if constexpr (!Epi::AFTER_DRAIN) { E(acc, cur, wr, wc, fr, fq); S.done(cur); }
        if (!has_next) break;
#pragma unroll
        for (int a = 0; a < 2; ++a)
#pragma unroll
            for (int b = 0; b < 2; ++b)
#pragma unroll
                for (int m = 0; m < 4; ++m)
#pragma unroll
                    for (int n = 0; n < 2; ++n) acc[a][b][m][n] = (f32x4){0.f, 0.f, 0.f, 0.f};
        cur = nxt; cA = nA; cB = nB; ++ui;
        if constexpr (ALIGN_EPI) { if (wr == 1) PG8_BAR; }
    }
    PG8_WAIT_V(0);
    if constexpr (!ALIGN_EPI) { if (wr == 0) PG8_BAR; }
    PG8_BAR;
    if constexpr (Epi::AFTER_DRAIN) { E.fused(acc, cur, wr, wc, fr, fq, lds, wid, lane); S.done(cur); }
#undef PG8_SA
#undef PG8_SB
#undef PG8_STAGE
#undef PG8_LDA
#undef PG8_LDB
#undef PG8_MMA
#undef PG8_WAIT_V
#undef PG8_WAIT_L
#undef PG8_BAR
#undef PG8_SCHED
}
}

constexpr int D = 4096, NB = 4, S = 4096, L = 256, HD = 128, HA = 16, KVA = 4, HB = 16, GQ = HA / KVA;
constexpr int NIN = 17408, DFF = 11008, F2 = 2 * DFF, GW = 64, KT = L + S;
constexpr int M = NB * S, MC = NB * L;
constexpr int MODN = 6 * D, MOD_SPLIT = 8, MOD_KC = D / MOD_SPLIT, MOD_WAVES = 3;
constexpr float EPS = 1e-6f;
constexpr float SCALE = 0.088388347648318440f;
constexpr int NT_IN = NIN / 256;
constexpr float SC_WIN = 64.f, SC_WOUT = 64.f, SC_Y = 16.f;
#ifndef INPROJ_MODE_DEF
#define INPROJ_MODE_DEF 2
#endif
constexpr int INPROJ_MODE = INPROJ_MODE_DEF;
#ifndef TILED_B
#define TILED_B 1
#endif
#ifndef QFIX_ATT_DEF
#define QFIX_ATT_DEF 1
#endif
constexpr bool QFIX_ATT = QFIX_ATT_DEF;
#ifndef BR_FP8_DEF
#define BR_FP8_DEF 1
#endif
constexpr bool BR_FP8 = BR_FP8_DEF;
constexpr float SC_OA = 32.f, SC_OB = 16.f, SC_WBR = 32.f;
#ifndef WOUT_MODE_DEF
#define WOUT_MODE_DEF 2
#endif
constexpr int WOUT_MODE = WOUT_MODE_DEF;
constexpr bool WOUT_FP8 = (WOUT_MODE == 1);
constexpr bool V_FP8 = true;
constexpr int NT_IN16 = V_FP8 ? 0 : 10, NT_IN8 = V_FP8 ? 68 : 58;
__host__ __device__ constexpr bool inproj_is_fp8(int pn) { return V_FP8 || !(pn == 10 || pn == 11 || (pn >= 28 && pn < 36)); }
__host__ __device__ constexpr int inproj_local_tile(int pn) { return V_FP8 ? pn : (inproj_is_fp8(pn) ? (pn < 10 ? pn : (pn < 28 ? pn - 2 : pn - 10)) : (pn < 12 ? pn - 10 : pn - 26)); }
__host__ __device__ constexpr int inproj_global_tile(bool fp8, int t) { return V_FP8 ? t : (fp8 ? (t < 10 ? t : (t < 26 ? t + 2 : t + 10)) : (t < 2 ? 10 + t : 26 + t)); }
constexpr size_t WIN8_OFF = (size_t)NT_IN16 * 256 * D * 2;

constexpr size_t MiB = 1u << 20;
constexpr size_t WS_CTL = 0, CTL_ZERO_BYTES = 64 * 1024;
constexpr size_t WS_MODP = 266 * MiB;
constexpr size_t WS_MODF = 5 * MiB;
constexpr size_t WS_ROPE = 6 * MiB;
constexpr size_t WS_RSH = 7 * MiB;
constexpr size_t WS_RSY = 7 * MiB + 256 * 1024;
constexpr size_t WS_WUP = 8 * MiB;
constexpr size_t WS_WDN = 180 * MiB;
constexpr size_t WS_QO = 266 * MiB;
constexpr size_t WS_WIN = 394 * MiB;
constexpr size_t WS_WBR = 530 * MiB;
constexpr size_t WS_WOUT = 562 * MiB;
constexpr size_t WS_H = 594 * MiB;
constexpr size_t WS_KA = 730 * MiB;
constexpr size_t WS_VA = 747 * MiB;
constexpr size_t WS_KB = 764 * MiB;
constexpr size_t WS_VB = 832 * MiB;
constexpr size_t WS_GA = 900 * MiB;
constexpr size_t WS_GB = 1028 * MiB;
constexpr size_t WS_U = 394 * MiB;
constexpr size_t WS_ACT = 1156 * MiB;
constexpr size_t WS_END = 1500 * MiB;
static_assert(WS_U + (size_t)M * F2 * 2 <= WS_ACT && WS_GB + (size_t)M * D * 2 <= WS_ACT && WS_ACT + (size_t)M * DFF * 2 <= WS_END, "d_ws map");
static_assert(WS_WUP + (size_t)F2 * D * 2 <= WS_WDN && WS_WDN + (size_t)D * DFF * 2 <= WS_QO && WS_QO + (size_t)M * 4096 * 2 <= WS_WIN && WS_WIN + (size_t)NIN * D * 2 <= WS_WBR, "d_ws map 2");
static_assert(WS_H + (size_t)(M + MC) * D * 2 <= WS_KA && WS_KA + (size_t)NB * KT * 512 * 2 <= WS_VA && WS_VA + (size_t)NB * KT * 512 * 2 <= WS_KB && WS_KB + (size_t)NB * KT * 2048 * 2 <= WS_VB && WS_VB + (size_t)NB * KT * 2048 * 2 <= WS_GA, "d_ws map 3");
constexpr int CW_BAR = 4096;
constexpr int CW_QUEUE = 8192;
constexpr int CW_QUEUE3 = 8448, CW_QUEUE4 = 8512;
constexpr int CW_TMAX = 8576, CW_TMAX2 = 8640, CW_QUEUE5 = 8704;
constexpr int CW_QUEUE2 = 8256, CW_WMAX = 8320, CW_WMAX2 = 8384;

constexpr int RING_OFF = 0, RING_BYTES = 131072;
constexpr int LDSCTL_OFF = RING_BYTES, MISC_OFF = LDSCTL_OFF + 320;
constexpr int LDS_BYTES = 147456;
constexpr int NWAVES = 8;

#ifndef MK_N_LAUNCHES
#define MK_N_LAUNCHES 1
#endif
constexpr int N_PHASES = 13;
constexpr int N_LAUNCHES = MK_N_LAUNCHES;

#define GAS __attribute__((address_space(1)))
#define LAS __attribute__((address_space(3)))
typedef unsigned short bf16;
typedef unsigned v4u __attribute__((ext_vector_type(4)));
typedef unsigned v2u __attribute__((ext_vector_type(2)));
typedef float f32x4 __attribute__((ext_vector_type(4)));
typedef float f32x2 __attribute__((ext_vector_type(2)));
typedef GAS unsigned gu32;
#define RLX_AGENT __ATOMIC_RELAXED, __HIP_MEMORY_SCOPE_AGENT
#define LDS_WAIT() asm volatile("s_waitcnt lgkmcnt(0)" ::: "memory")
#define VM_WAIT() asm volatile("s_waitcnt vmcnt(0)" ::: "memory")
__device__ __forceinline__ unsigned pk2(float lo, float hi) { unsigned r; asm volatile("v_cvt_pk_bf16_f32 %0, %1, %2" : "=v"(r) : "v"(lo), "v"(hi)); return r; }
__device__ __forceinline__ unsigned pk4_fp8(float a, float b, float c, float d) { int w = 0; w = __builtin_amdgcn_cvt_pk_fp8_f32(a, b, w, false); w = __builtin_amdgcn_cvt_pk_fp8_f32(c, d, w, true); return (unsigned)w; }
__device__ __forceinline__ unsigned pk4_i8(float a, float b, float c, float d) {
    const int q0 = __float2int_rn(a), q1 = __float2int_rn(b), q2 = __float2int_rn(c), q3 = __float2int_rn(d);
    return (unsigned)(q0 & 255) | ((unsigned)(q1 & 255) << 8) | ((unsigned)(q2 & 255) << 16) | ((unsigned)q3 << 24); }
__device__ __forceinline__ unsigned pk4_u8(float a, float b, float c, float d) {
    const int q0 = __float2int_rn(a), q1 = __float2int_rn(b), q2 = __float2int_rn(c), q3 = __float2int_rn(d);
    return (unsigned)q0 | ((unsigned)q1 << 8) | ((unsigned)q2 << 16) | ((unsigned)q3 << 24); }
__device__ __forceinline__ float ub(unsigned w, int e) { return (float)((w >> (8 * e)) & 255u); }
__device__ __forceinline__ float bf_lo(unsigned w) { return __uint_as_float(w << 16); }
__device__ __forceinline__ float bf_hi(unsigned w) { return __uint_as_float(w & 0xffff0000u); }
__device__ __forceinline__ float sigmoid_f(float x) { return __builtin_amdgcn_rcpf(1.0f + __expf(-x)); }
__device__ __forceinline__ float wave_sum(float v) {
#pragma unroll
    for (int o = 1; o < 64; o <<= 1) v += __shfl_xor(v, o);
    return v;
}

#define XB_TMO      128
#define XB_XCNT(j)  (256  + 64 * (j))
#define XB_XSUB(j)  (1280 + 64 * (j))
#define XB_XGEN(j)  (2304 + 64 * (j))
#define XB_TOP      3328
#define XB_TOPGEN   3392
#define XCD_BAR_WORDS 3456
#define XB_SPIN_CAP (1u << 18)
__device__ __forceinline__ unsigned xb_ld(unsigned* p)              { return __hip_atomic_load(p, __ATOMIC_RELAXED, __HIP_MEMORY_SCOPE_AGENT); }
__device__ __forceinline__ unsigned xb_add(unsigned* p, unsigned v) { return __hip_atomic_fetch_add(p, v, __ATOMIC_RELAXED, __HIP_MEMORY_SCOPE_AGENT); }
__device__ __forceinline__ unsigned xb_xcc_id() { return (unsigned)__builtin_amdgcn_s_getreg((3 << 11) | 20) & 0xFu; }
#define XB_SPIN(cond, bar) do { unsigned _sp = 0; while (cond) { __builtin_amdgcn_s_sleep(1); \
    if ((++_sp & 255u) == 0u) { if (xb_ld(&(bar)[XB_TMO])) break; if (_sp > XB_SPIN_CAP) { atomicAdd(&(bar)[XB_TMO], 1u); break; } } } } while (0)
struct XcdBarrier { unsigned* bar; unsigned x; volatile LAS unsigned* st; };
__device__ __forceinline__ XcdBarrier xcd_barrier_post(unsigned* bar, volatile LAS unsigned* st) {
    XcdBarrier b; b.bar = bar; b.x = xb_xcc_id(); b.st = st;
    if (threadIdx.x == 0) (void)xb_add(&bar[XB_XCNT(b.x)], 1u);
    return b;
}
__device__ __forceinline__ void xcd_barrier_complete(unsigned* bar, unsigned x, unsigned& nloc, unsigned& nx) {
    const unsigned G = gridDim.x * gridDim.y * gridDim.z;
    unsigned sum, cnt, mine, sp = 0u;
    for (;;) {
        sum = 0u; cnt = 0u; mine = 0u;
#pragma unroll
        for (unsigned j = 0; j < 16; ++j) { const unsigned c = xb_ld(&bar[XB_XCNT(j)]); sum += c; cnt += (c > 0u) ? 1u : 0u; mine = (j == x) ? c : mine; }
        if (sum == G) break;
        __builtin_amdgcn_s_sleep(1);
        if ((++sp & 255u) == 0u) { if (xb_ld(&bar[XB_TMO])) break; if (sp > XB_SPIN_CAP) { atomicAdd(&bar[XB_TMO], 1u); break; } }
    }
    nloc = mine > 0u ? mine : 1u; nx = cnt > 0u ? cnt : 1u;
}
__device__ __forceinline__ void xcd_barrier(const XcdBarrier& b) {
    asm volatile("s_waitcnt vmcnt(0)" ::: "memory");
    __syncthreads();
    if (threadIdx.x == 0) {
        unsigned* bar = b.bar;
        __builtin_amdgcn_s_waitcnt(0);
        unsigned nloc = b.st[0], nx = b.st[1];
        if (nloc == 0u) { xcd_barrier_complete(bar, b.x, nloc, nx); b.st[0] = nloc; b.st[1] = nx; }
        const unsigned old = xb_add(&bar[XB_XSUB(b.x)], 1u);
        const unsigned gen = old / nloc;
        if (old + 1u == (gen + 1u) * nloc) {
            __builtin_amdgcn_fence(__ATOMIC_RELEASE, "agent");
            asm volatile("s_waitcnt vmcnt(0)" ::: "memory");
            const unsigned og = xb_add(&bar[XB_TOP], 1u);
            const unsigned tg = og / nx;
            if (og + 1u == (tg + 1u) * nx) xb_add(&bar[XB_TOPGEN], 1u);
            else XB_SPIN(xb_ld(&bar[XB_TOPGEN]) == tg, bar);
            __builtin_amdgcn_fence(__ATOMIC_ACQUIRE, "agent");
            xb_add(&bar[XB_XGEN(b.x)], 1u);
            asm volatile("s_waitcnt vmcnt(0)" ::: "memory");
        } else {
            XB_SPIN(xb_ld(&bar[XB_XGEN(b.x)]) == gen, bar);
            __builtin_amdgcn_fence(__ATOMIC_ACQUIRE, "agent");
            asm volatile("s_waitcnt vmcnt(0)" ::: "memory");
        }
    }
    __syncthreads();
}

struct Args { const float* in[20]; float* out; unsigned char* ws; int ph_lo, ph_hi, li, pad; };
__device__ __forceinline__ const float* karg_in(int i) { return *(const float* const volatile __attribute__((address_space(4)))*)((const __attribute__((address_space(4))) char*)__builtin_amdgcn_kernarg_segment_ptr() + 8 * i); }
__device__ __forceinline__ unsigned char* karg_ws() { return (unsigned char*)karg_in(21); }
struct Frame {
    LAS unsigned char* lds;
    volatile LAS unsigned* MISC;
    gu32* ctl;
    int tid, lane, wave;
    int vcu, G;
#define KIN(name, i) __device__ __forceinline__ const float* name() const { return karg_in(i); }
    KIN(x, 0) KIN(c, 1) KIN(ctx, 2) KIN(cctx, 3) KIN(ada_w, 4) KIN(ada_b, 5) KIN(norm1_g, 6) KIN(w_in, 7) KIN(qnorm, 8) KIN(knorm, 9) KIN(rpb, 10) KIN(w_br_a, 11) KIN(w_br_b, 12) KIN(w_out, 13)
    KIN(norm2_g, 14) KIN(w_up, 15) KIN(conv_w, 16) KIN(conv_b, 17) KIN(w_down, 18) KIN(final_g, 19)
#undef KIN
    __device__ __forceinline__ float* out() const { return (float*)karg_in(20); }
#define KWS(T, name, off) __device__ __forceinline__ T* name() const { return (T*)(karg_ws() + (off)); }
    KWS(float, modp, WS_MODP) KWS(float, modf, WS_MODF) KWS(float2, rope, WS_ROPE) KWS(float, rsh, WS_RSH) KWS(float, rsy, WS_RSY)
    KWS(bf16, Wup, WS_WUP) KWS(bf16, Wdn, WS_WDN) KWS(bf16, QO, WS_QO) KWS(bf16, Win, WS_WIN) KWS(bf16, Wbr, WS_WBR) KWS(bf16, Wout, WS_WOUT) KWS(bf16, H, WS_H)
    KWS(bf16, KA, WS_KA) KWS(bf16, VA, WS_VA) KWS(bf16, KB, WS_KB) KWS(bf16, VB, WS_VB) KWS(bf16, GA, WS_GA) KWS(bf16, GB, WS_GB) KWS(bf16, U, WS_U) KWS(bf16, ACT, WS_ACT)
#undef KWS
};

__device__ __forceinline__ void p0_mod_item(Frame& F, LAS float* sv, int item) {
    const int kc = item / (MODN / 256), nb = item % (MODN / 256), k0 = kc * MOD_KC;
    const float* cc = F.c(); const float* cx = F.cctx();
    for (int i = F.lane; i < 5 * MOD_KC; i += 64) { const int r = i / MOD_KC, k = i % MOD_KC; const float v = (r < 4) ? cc[r * D + k0 + k] : cx[k0 + k]; sv[i] = v * sigmoid_f(v); }
    LDS_WAIT(); asm volatile("" ::: "memory");
    f32x4 a0 = {0.f, 0.f, 0.f, 0.f}, a1 = a0, a2 = a0, a3 = a0, a4 = a0;
    const GAS f32x4* wp = (const GAS f32x4*)(F.ada_w() + (size_t)k0 * MODN + 256 * nb) + F.lane;
#pragma unroll 16
    for (int k = 0; k < MOD_KC; ++k) { const f32x4 w = wp[(size_t)k * (MODN / 4)];
        a0 += sv[k] * w; a1 += sv[MOD_KC + k] * w; a2 += sv[2 * MOD_KC + k] * w; a3 += sv[3 * MOD_KC + k] * w; a4 += sv[4 * MOD_KC + k] * w; }
    GAS f32x4* o = (GAS f32x4*)(F.modp() + (size_t)kc * 5 * MODN + 256 * nb) + F.lane;
    o[0] = a0; o[MODN / 4] = a1; o[2 * (MODN / 4)] = a2; o[3 * (MODN / 4)] = a3; o[4 * (MODN / 4)] = a4;
    LDS_WAIT(); asm volatile("" ::: "memory");
}
struct TItem { const float* src; unsigned char* dst; int N, ldT, fp8; float scale; };
constexpr int P0_NBW = 8, P0_KBL = 16;
constexpr int P0_BLK_IN = (D / 64 / P0_KBL) * (NIN / 32 / P0_NBW), P0_BLK_BR = (2048 / 64 / P0_KBL) * (D / 32 / P0_NBW), P0_BLK_OUT = (D / 64 / P0_KBL) * (D / 32 / P0_NBW), P0_BLK_UP = (D / 64 / P0_KBL) * (F2 / 32 / P0_NBW), P0_BLK_DN = ((DFF / 64 + P0_KBL - 1) / P0_KBL) * (D / 32 / P0_NBW);
static_assert((NIN / 32) % P0_NBW == 0 && (F2 / 32) % P0_NBW == 0 && (D / 32) % P0_NBW == 0 && (2048 / 64) % P0_KBL == 0, "P0 block shape");
constexpr int P0_NBLK = P0_BLK_IN + 2 * P0_BLK_BR + P0_BLK_OUT + P0_BLK_UP + P0_BLK_DN;
struct TRun { int mat, kb0, nb; };
__device__ __forceinline__ void p0_run_of(int blk, int slot, TRun& r) {
    int nbg_per;
    if (blk < P0_BLK_IN) { r.mat = 0; nbg_per = NIN / 32 / P0_NBW; }
    else if ((blk -= P0_BLK_IN) < P0_BLK_BR) { r.mat = 1; nbg_per = D / 32 / P0_NBW; }
    else if ((blk -= P0_BLK_BR) < P0_BLK_BR) { r.mat = 2; nbg_per = D / 32 / P0_NBW; }
    else if ((blk -= P0_BLK_BR) < P0_BLK_OUT) { r.mat = 3; nbg_per = D / 32 / P0_NBW; }
    else if ((blk -= P0_BLK_OUT) < P0_BLK_UP) { r.mat = 4; nbg_per = F2 / 32 / P0_NBW; }
    else { blk -= P0_BLK_UP; r.mat = 5; nbg_per = D / 32 / P0_NBW; }
    r.kb0 = (blk / nbg_per) * P0_KBL; r.nb = (blk % nbg_per) * P0_NBW + slot;
}
__device__ __forceinline__ bool p0_decode(Frame& F, int mat, int kb, int nb, TItem& t, float win_qscale, float wout_qscale) {
    t.fp8 = 0; t.scale = 1.0f;
    if (mat == 0) { const int pn = nb >> 3, nbd = inproj_local_tile(pn) * 8 + (nb & 7);
        t.src = F.w_in() + (size_t)(64 * kb) * NIN + 32 * nb; t.N = NIN;
        if (inproj_is_fp8(pn)) { t.dst = (unsigned char*)F.Win() + WIN8_OFF + (size_t)(32 * nbd) * D + 64 * kb; t.ldT = D; t.fp8 = INPROJ_MODE; t.scale = INPROJ_MODE == 2 ? win_qscale : SC_WIN; }
        else { t.dst = (unsigned char*)F.Win() + ((size_t)(32 * nbd) * D + 64 * kb) * 2; t.ldT = 2 * D; }
        return true; }
    if (mat == 1 || mat == 2) { const int second = mat - 1;
        t.src = (second ? F.w_br_b() : F.w_br_a()) + (size_t)(64 * kb) * D + 32 * nb; t.N = D;
        if (BR_FP8) { t.dst = (unsigned char*)F.Wbr() + (size_t)(32 * nb) * 4096 + second * 2048 + 64 * kb; t.ldT = 4096; t.fp8 = 1; t.scale = SC_WBR; }
        else { t.dst = (unsigned char*)F.Wbr() + ((size_t)(32 * nb) * 4096 + second * 2048 + 64 * kb) * 2; t.ldT = 2 * 4096; }
        return true; }
    if (mat == 3) { t.src = F.w_out() + (size_t)(64 * kb) * D + 32 * nb; t.N = D;
        if (WOUT_MODE) { t.dst = (unsigned char*)F.Wout() + (size_t)(32 * nb) * D + 64 * kb; t.ldT = D; t.fp8 = WOUT_MODE; t.scale = WOUT_MODE == 2 ? wout_qscale : SC_WOUT; }
        else { t.dst = (unsigned char*)F.Wout() + ((size_t)(32 * nb) * D + 64 * kb) * 2; t.ldT = 2 * D; }
        return true; }
    if (mat == 4) { const int fb = nb < DFF / 32 ? nb : nb - DFF / 32, nbd = (fb >> 2) * 8 + (nb < DFF / 32 ? 0 : 4) + (fb & 3);
        t.src = F.w_up() + (size_t)(64 * kb) * F2 + 32 * nb; t.N = F2; t.dst = (unsigned char*)F.Wup() + ((size_t)(32 * nbd) * D + 64 * kb) * 2; t.ldT = 2 * D; return true; }
    if (kb >= DFF / 64) return false;
    t.src = F.w_down() + (size_t)(64 * kb) * D + 32 * nb; t.N = D; t.dst = (unsigned char*)F.Wdn() + ((size_t)(32 * nb) * DFF + 64 * kb) * 2; t.ldT = 2 * DFF; return true;
}
__device__ __forceinline__ void p0_load(const TItem& t, float (&v)[32], int lane) {
    const float* p = t.src + (size_t)(lane >> 5) * t.N + (lane & 31);
#pragma unroll
    for (int i = 0; i < 32; ++i) v[i] = p[(size_t)(2 * i) * t.N];
}
#ifndef WQ_MARGIN
#define WQ_MARGIN 1.3f
#endif
constexpr int WQ_SAMPLE = 8;
__device__ __forceinline__ float wq_clip(Frame& F, int k) { return WQ_MARGIN * __uint_as_float(__hip_atomic_load((unsigned*)(F.ctl + (k ? CW_WMAX2 : CW_WMAX)), RLX_AGENT)); }
__device__ __forceinline__ float wq_true(Frame& F, int k) { return __uint_as_float(__hip_atomic_load((unsigned*)(F.ctl + (k ? CW_TMAX2 : CW_TMAX)), RLX_AGENT)); }
__device__ __forceinline__ float wq_range(Frame& F, int k) { const float c = wq_clip(F, k), t = wq_true(F, k); return t > c ? t : c; }
__device__ __forceinline__ void p0a_prologue(Frame& F) {
    LAS float* scr = (LAS float*)(F.lds + RING_OFF + F.wave * 16384);
    if (F.wave >= MOD_WAVES) { const int gt = F.vcu * ((NWAVES - MOD_WAVES) * 64) + (F.tid - MOD_WAVES * 64); if (gt < 64 * 32) { const int pos = gt >> 5, i = gt & 31; const float fr = powf(10000.0f, -(float)i / 32.0f), a = (float)pos * fr; F.rope()[gt] = make_float2(cosf(a), sinf(a)); } }
    if (F.wave < MOD_WAVES) { for (int item = F.vcu * MOD_WAVES + F.wave; item < MOD_SPLIT * (MODN / 256); item += MOD_WAVES * F.G) p0_mod_item(F, scr, item); }
    if (INPROJ_MODE == 2 || WOUT_MODE == 2) {
        constexpr int NCH1 = INPROJ_MODE == 2 ? (int)((size_t)D * NIN / 16384 / WQ_SAMPLE) : 0, NCH2 = WOUT_MODE == 2 ? (int)((size_t)D * D / 16384 / WQ_SAMPLE) : 0;
        const GAS f32x4* w1 = (const GAS f32x4*)F.w_in(); const GAS f32x4* w2 = (const GAS f32x4*)F.w_out(); float m1 = 0.f, m2 = 0.f;
        for (;;) {
            int ch = 0; if (F.lane == 0) ch = (int)__hip_atomic_fetch_add((unsigned*)(F.ctl + CW_QUEUE2), 1u, RLX_AGENT);
            ch = __builtin_amdgcn_readfirstlane(ch);
            if (ch >= NCH1 + NCH2) break;
            const bool second = ch >= NCH1; const GAS f32x4* p = (second ? w2 + (size_t)(ch - NCH1) * (4096 * WQ_SAMPLE) : w1 + (size_t)ch * (4096 * WQ_SAMPLE)) + F.lane; f32x4 v[8]; float m = 0.f;
#pragma unroll
            for (int h = 0; h < 8; ++h) {
#pragma unroll
                for (int i = 0; i < 8; ++i) v[i] = p[(h * 8 + i) * 64];
#pragma unroll
                for (int i = 0; i < 8; ++i) m = fmaxf(m, fmaxf(fmaxf(fabsf(v[i].x), fabsf(v[i].y)), fmaxf(fabsf(v[i].z), fabsf(v[i].w)))); }
            if (second) m2 = fmaxf(m2, m); else m1 = fmaxf(m1, m);
        }
#pragma unroll
        for (int o = 1; o < 64; o <<= 1) { m1 = fmaxf(m1, __shfl_xor(m1, o)); m2 = fmaxf(m2, __shfl_xor(m2, o)); }
        if (F.lane == 0) { if (NCH1) __hip_atomic_fetch_max((unsigned*)(F.ctl + CW_WMAX), __float_as_uint(m1), RLX_AGENT);
                           if (NCH2) __hip_atomic_fetch_max((unsigned*)(F.ctl + CW_WMAX2), __float_as_uint(m2), RLX_AGENT); }
    }
}
#ifndef DEFER_UP_RUNS
#define DEFER_UP_RUNS 1024
#endif
constexpr int P0_RUN_UP0 = (P0_BLK_IN + 2 * P0_BLK_BR + P0_BLK_OUT) * P0_NBW, P0_RUN_DN0 = P0_RUN_UP0 + P0_BLK_UP * P0_NBW, P0_RUN_END = P0_NBLK * P0_NBW, P0_RUN_SPLIT = P0_RUN_DN0 - DEFER_UP_RUNS;
static_assert(DEFER_UP_RUNS >= 0 && DEFER_UP_RUNS <= P0_BLK_UP * P0_NBW, "deferred w_up runs");
constexpr int P0_RUN_IN1 = P0_BLK_IN * P0_NBW, P0_RUN_OUT0 = (P0_BLK_IN + 2 * P0_BLK_BR) * P0_NBW;
__device__ __forceinline__ void p0_transpose_runs(Frame& F, int qw, int run_lo, int run_hi, bool exact = false, int skip_lo = 0, int skip_hi = 0) {
    LAS float* scr = (LAS float*)(F.lds + RING_OFF + F.wave * 16384);
    const float win_qscale = INPROJ_MODE == 2 ? 127.0f / fmaxf(exact ? wq_range(F, 0) : wq_clip(F, 0), 1e-30f) : 1.0f;
    const float wout_qscale = WOUT_MODE == 2 ? 127.0f / fmaxf(exact ? wq_range(F, 1) : wq_clip(F, 1), 1e-30f) : 1.0f;
    float tm1 = 0.f, tm2 = 0.f;
    int lane = F.lane; asm volatile("" : "+v"(lane));
    const int c = lane & 7;
    for (;;) {
        int run = 0; if (lane == 0) run = (int)__hip_atomic_fetch_add((unsigned*)(F.ctl + qw), 1u, RLX_AGENT);
        run = run_lo + __builtin_amdgcn_readfirstlane(run);
        if (run >= run_hi) break;
        if (run >= skip_lo && run < skip_hi) continue;
        TRun R; p0_run_of(run / P0_NBW, run % P0_NBW, R);
        TItem cur, nxt; float v[32]; float tm = 0.f;
        bool have = p0_decode(F, R.mat, R.kb0, R.nb, cur, win_qscale, wout_qscale); if (have) p0_load(cur, v, lane);
        for (int j = 0; j < P0_KBL; ++j) {
            if (have) {
#pragma unroll
                for (int i = 0; i < 32; ++i) { scr[(2 * i + (lane >> 5)) * 33 + (lane & 31)] = v[i] * cur.scale; tm = fmaxf(tm, fabsf(v[i])); }
                LDS_WAIT(); asm volatile("" ::: "memory"); }
            nxt = cur; const bool more = (j + 1 < P0_KBL) && p0_decode(F, R.mat, R.kb0 + j + 1, R.nb, nxt, win_qscale, wout_qscale);
            if (more) p0_load(nxt, v, lane);
            if (have) {
#pragma unroll
                for (int q = 0; q < 4; ++q) { const int n = (lane >> 3) + 8 * q; const LAS float* sp = scr + (8 * c) * 33 + n;
                    if (cur.fp8 == 2) { v2u o; o.x = pk4_i8(sp[0 * 33], sp[1 * 33], sp[2 * 33], sp[3 * 33]); o.y = pk4_i8(sp[4 * 33], sp[5 * 33], sp[6 * 33], sp[7 * 33]); *(GAS v2u*)(cur.dst + (size_t)n * cur.ldT + 8 * c) = o; }
                    else if (cur.fp8) { v2u o; o.x = pk4_fp8(sp[0 * 33], sp[1 * 33], sp[2 * 33], sp[3 * 33]); o.y = pk4_fp8(sp[4 * 33], sp[5 * 33], sp[6 * 33], sp[7 * 33]); *(GAS v2u*)(cur.dst + (size_t)n * cur.ldT + 8 * c) = o; }
                    else { v4u o; o.x = pk2(sp[0 * 33], sp[1 * 33]); o.y = pk2(sp[2 * 33], sp[3 * 33]); o.z = pk2(sp[4 * 33], sp[5 * 33]); o.w = pk2(sp[6 * 33], sp[7 * 33]); *(GAS v4u*)(cur.dst + (size_t)n * cur.ldT + 16 * c) = o; } }
                LDS_WAIT(); asm volatile("" ::: "memory"); }
            cur = nxt; have = more;
        }
        if (R.mat == 0) tm1 = fmaxf(tm1, tm); else if (R.mat == 3) tm2 = fmaxf(tm2, tm);
    }
    if ((INPROJ_MODE == 2 || WOUT_MODE == 2) && run_lo < P0_RUN_UP0) {
#pragma unroll
        for (int o = 1; o < 64; o <<= 1) { tm1 = fmaxf(tm1, __shfl_xor(tm1, o)); tm2 = fmaxf(tm2, __shfl_xor(tm2, o)); }
        if (lane == 0) { if (INPROJ_MODE == 2 && tm1 > 0.f) __hip_atomic_fetch_max((unsigned*)(F.ctl + CW_TMAX), __float_as_uint(tm1), RLX_AGENT);
                         if (WOUT_MODE == 2 && tm2 > 0.f) __hip_atomic_fetch_max((unsigned*)(F.ctl + CW_TMAX2), __float_as_uint(tm2), RLX_AGENT); }
    }
}

template <int OUT_MODE  , bool HAS_B, int NDELTA = 0>
__device__ __forceinline__ void norm_row(const float* xrow, void* orow, const LAS float* A, const LAS float* B, int lane, void* orow8 = nullptr, float* rs = nullptr, const bf16* d1row = nullptr, const bf16* d2row = nullptr) {
    const GAS f32x4* xr = (const GAS f32x4*)xrow + lane;
    f32x4 v[16]; float s = 0.f;
#pragma unroll
    for (int j = 0; j < 16; ++j) { v[j] = xr[64 * j];
        if (NDELTA >= 1) { const v2u w = ((const GAS v2u*)d1row)[lane + 64 * j]; v[j].x += bf_lo(w.x); v[j].y += bf_hi(w.x); v[j].z += bf_lo(w.y); v[j].w += bf_hi(w.y); }
        if (NDELTA >= 2) { const v2u w = ((const GAS v2u*)d2row)[lane + 64 * j]; v[j].x += bf_lo(w.x); v[j].y += bf_hi(w.x); v[j].z += bf_lo(w.y); v[j].w += bf_hi(w.y); }
        s += (v[j].x * v[j].x + v[j].y * v[j].y) + (v[j].z * v[j].z + v[j].w * v[j].w); }
    const float rstd = 1.0f / sqrtf(wave_sum(s) * (1.0f / D) + EPS);
#pragma unroll
    for (int j = 0; j < 16; ++j) {
        const f32x4 a = ((const LAS f32x4*)A)[lane + 64 * j]; f32x4 o = v[j] * rstd * a;
        if (HAS_B) o += ((const LAS f32x4*)B)[lane + 64 * j];
        if (OUT_MODE == 4) { v[j] = o; continue; }
        if (OUT_MODE == 1 || OUT_MODE == 3) { v2u w; w.x = pk2(o.x, o.y); w.y = pk2(o.z, o.w); ((GAS v2u*)orow)[lane + 64 * j] = w; if (OUT_MODE == 3) ((GAS unsigned*)orow8)[lane + 64 * j] = pk4_fp8(o.x, o.y, o.z, o.w); }
        else if (OUT_MODE == 2) ((GAS unsigned*)orow)[lane + 64 * j] = pk4_fp8(o.x, o.y, o.z, o.w);
        else ((GAS f32x4*)orow)[lane + 64 * j] = o;
    }
    if (OUT_MODE == 4) {
        float m = 0.f;
#pragma unroll
        for (int j = 0; j < 16; ++j) m = fmaxf(m, fmaxf(fmaxf(fabsf(v[j].x), fabsf(v[j].y)), fmaxf(fabsf(v[j].z), fabsf(v[j].w))));
#pragma unroll
        for (int o = 1; o < 64; o <<= 1) m = fmaxf(m, __shfl_xor(m, o));
        const float inv = m > 0.f ? 127.0f / m : 0.f;
#pragma unroll
        for (int j = 0; j < 16; ++j) ((GAS unsigned*)orow)[lane + 64 * j] = pk4_i8(v[j].x * inv, v[j].y * inv, v[j].z * inv, v[j].w * inv);
        if (lane == 0) *rs = m * (1.0f / 127.0f);
    }
}
__device__ __forceinline__ float mod_sum(const float* ada_b, const float* modp, int r, int n) {
    float s = ada_b[n];
#pragma unroll
    for (int kc = 0; kc < MOD_SPLIT; ++kc) s += modp[(size_t)(kc * 5 + r) * MODN + n];
    return s;
}
__device__ __forceinline__ void p1_norm1(Frame& F) {
    LAS float* Al = (LAS float*)(F.lds + RING_OFF); LAS float* Bl = Al + D; LAS float* Ac = Bl + D; LAS float* Bc = Ac + D;
    const int c = blockIdx.x, b = c / 64;
    const float* ada_b = F.ada_b(); const float* modp = F.modp(); const float* n1g = F.norm1_g();
    for (int k = F.tid; k < D; k += NWAVES * 64) { const float g = n1g[k];
        Al[k] = g * (1.0f + mod_sum(ada_b, modp, b, D + k)); Bl[k] = mod_sum(ada_b, modp, b, k); Ac[k] = g * (1.0f + mod_sum(ada_b, modp, 4, D + k)); Bc[k] = mod_sum(ada_b, modp, 4, k); }
    { const int per = (5 * MODN) / 256; if (F.tid < per) { const int i = c * per + F.tid; F.modf()[i] = mod_sum(ada_b, modp, i / MODN, i % MODN); } }
    __syncthreads();
    const float* xp = F.x(); const float* cxp = F.ctx(); unsigned char* h8 = (unsigned char*)F.ACT(); bf16* h16 = F.H(); float* rsh = F.rsh();
    for (int j = F.wave; j < 68; j += NWAVES) {
        if (j < 64) { const size_t row = (size_t)c * 64 + j; if (V_FP8 && INPROJ_MODE == 2) norm_row<4, true>(xp + row * D, h8 + row * D, Al, Bl, F.lane, nullptr, rsh + row); else if (V_FP8) norm_row<2, true>(xp + row * D, h8 + row * D, Al, Bl, F.lane); else norm_row<3, true>(xp + row * D, h16 + row * D, Al, Bl, F.lane, h8 + row * D); }
        else { const size_t row = (size_t)c * 4 + (j - 64); if (V_FP8 && INPROJ_MODE == 2) norm_row<4, true>(cxp + row * D, h8 + ((size_t)M + row) * D, Ac, Bc, F.lane, nullptr, rsh + M + row); else if (V_FP8) norm_row<2, true>(cxp + row * D, h8 + ((size_t)M + row) * D, Ac, Bc, F.lane); else norm_row<3, true>(cxp + row * D, h16 + ((size_t)M + row) * D, Ac, Bc, F.lane, h8 + ((size_t)M + row) * D); }
    }
}
__device__ __forceinline__ void p7_norm2(Frame& F) {
    LAS float* Al = (LAS float*)(F.lds + RING_OFF); LAS float* Bl = Al + D;
    const int c = blockIdx.x, b = c / 64; const float* mb = F.modf() + (size_t)b * MODN;
    const float* n2g = F.norm2_g();
    for (int k = F.tid; k < D; k += NWAVES * 64) { Al[k] = n2g[k] * (1.0f + mb[4 * D + k]); Bl[k] = mb[3 * D + k]; }
    __syncthreads();
    const float* xp = F.x(); const bf16* d1 = F.H(); bf16* h2 = F.QO();
    for (int j = F.wave; j < 64; j += NWAVES) { const size_t row = (size_t)c * 64 + j; norm_row<1, true, 1>(xp + row * D, h2 + row * D, Al, Bl, F.lane, nullptr, nullptr, d1 + row * D); }
}
__device__ __forceinline__ void p11_final(Frame& F, float osc = 1.0f) {
    LAS float* Al = (LAS float*)(F.lds + RING_OFF);
    const int c = blockIdx.x;
    const float* fg = F.final_g(); float* outp = F.out(); const float* xp = F.x(); const bf16* d1 = F.H(); const bf16* d2 = F.QO();
    for (int k = F.tid; k < D; k += NWAVES * 64) Al[k] = fg[k] * osc;
    __syncthreads();
    for (int j = F.wave; j < 64; j += NWAVES) { const size_t row = (size_t)c * 64 + j; norm_row<0, false, 2>(xp + row * D, outp + row * D, Al, Al, F.lane, nullptr, nullptr, d1 + row * D, d2 + row * D); }
}

__device__ __forceinline__ void p6_quant_y(Frame& F) {
    const bf16* Y = F.H(); unsigned char* Y8 = (unsigned char*)F.KB(); float* rsy = F.rsy();
    for (int j = F.wave; j < 64; j += NWAVES) { const size_t row = (size_t)blockIdx.x * 64 + j;
        const GAS v4u* yr = (const GAS v4u*)(Y + row * D) + F.lane; v4u r[8]; float m = 0.f;
#pragma unroll
        for (int q = 0; q < 8; ++q) { r[q] = yr[64 * q]; const unsigned w[4] = {r[q].x, r[q].y, r[q].z, r[q].w};
#pragma unroll
            for (int e = 0; e < 4; ++e) m = fmaxf(m, fmaxf(fabsf(bf_lo(w[e])), fabsf(bf_hi(w[e])))); }
#pragma unroll
        for (int o = 1; o < 64; o <<= 1) m = fmaxf(m, __shfl_xor(m, o));
        const float inv = m > 0.f ? 127.0f / m : 0.f;
#pragma unroll
        for (int q = 0; q < 8; ++q) { v2u o; o.x = pk4_i8(bf_lo(r[q].x) * inv, bf_hi(r[q].x) * inv, bf_lo(r[q].y) * inv, bf_hi(r[q].y) * inv); o.y = pk4_i8(bf_lo(r[q].z) * inv, bf_hi(r[q].z) * inv, bf_lo(r[q].w) * inv, bf_hi(r[q].w) * inv);
            ((GAS v2u*)(Y8 + row * D))[F.lane + 64 * q] = o; }
        if (F.lane == 0) rsy[row] = m * (1.0f / 127.0f);
    }
}

__device__ __forceinline__ void p3_qkfix(Frame& F) {
    constexpr int NPQ = QFIX_ATT ? 0 : M * HA, NPK = M * KVA, NPC = MC * KVA, NP = NPQ + NPK + NPC;
    const int gw = F.vcu * NWAVES + F.wave, NGW = F.G * NWAVES, sub = F.lane & 15;
    bf16* QOp = F.QO(); bf16* KAp = F.KA(); const float* qn = F.qnorm(); const float* kn = F.knorm(); const float2* ropep = F.rope();
    for (int wi = gw; wi < NP / 4; wi += NGW) {
        int p = 4 * wi + (F.lane >> 4); bf16* ptr; const float* gain; int t; bool rope = true;
        if (p < NPQ) { const int row = p >> 4, h = p & 15; ptr = QOp + (size_t)row * 4096 + h * HD; gain = qn; t = row & (S - 1); }
        else if (p < NPQ + NPK) { p -= NPQ; const int row = p >> 2, h = p & 3, b = row >> 12; t = row & (S - 1); ptr = KAp + ((size_t)b * KT + L + t) * 512 + h * HD; gain = kn; }
        else { p -= NPQ + NPK; const int row = p >> 2, h = p & 3, b = row >> 8, j = row & (L - 1); ptr = KAp + ((size_t)b * KT + j) * 512 + h * HD; gain = kn; t = 0; rope = false; }
        const v4u raw = *(const GAS v4u*)(ptr + 8 * sub);
        float v[8] = {bf_lo(raw.x), bf_hi(raw.x), bf_lo(raw.y), bf_hi(raw.y), bf_lo(raw.z), bf_hi(raw.z), bf_lo(raw.w), bf_hi(raw.w)};
        float ss = 0.f;
#pragma unroll
        for (int e = 0; e < 8; ++e) ss += v[e] * v[e];
        ss += __shfl_xor(ss, 1); ss += __shfl_xor(ss, 2); ss += __shfl_xor(ss, 4); ss += __shfl_xor(ss, 8);
        const float rstd = 1.0f / sqrtf(ss * (1.0f / HD) + EPS);
        const f32x4 g0 = *(const GAS f32x4*)(gain + 8 * sub), g1 = *(const GAS f32x4*)(gain + 8 * sub + 4);
        v[0] *= rstd * g0.x; v[1] *= rstd * g0.y; v[2] *= rstd * g0.z; v[3] *= rstd * g0.w; v[4] *= rstd * g1.x; v[5] *= rstd * g1.y; v[6] *= rstd * g1.z; v[7] *= rstd * g1.w;
        const int pos = (sub < 8) ? (t >> 6) : (t & 63); const float2* rp = ropep + pos * 32 + 8 * (sub & 3);
        float o[8];
#pragma unroll
        for (int e = 0; e < 8; ++e) { const float q = __shfl_xor(v[e], 4); const float2 cs = rp[e]; o[e] = rope ? ((sub & 4) ? (v[e] * cs.x + q * cs.y) : (v[e] * cs.x - q * cs.y)) : v[e]; }
        v4u w; w.x = pk2(o[0], o[1]); w.y = pk2(o[2], o[3]); w.z = pk2(o[4], o[5]); w.w = pk2(o[6], o[7]);
        *(GAS v4u*)(ptr + 8 * sub) = w;
    }
}

__device__ __forceinline__ void ld8f(const float* p, float (&v)[8]) { const f32x4 a = *(const GAS f32x4*)p, b = *(const GAS f32x4*)(p + 4); v[0] = a.x; v[1] = a.y; v[2] = a.z; v[3] = a.w; v[4] = b.x; v[5] = b.y; v[6] = b.z; v[7] = b.w; }
__device__ __forceinline__ void p10_convfix(Frame& F) {
    constexpr int NFG = DFF / 8, NBD = NB * 15;
    const int gt = F.vcu * (NWAVES * 64) + F.tid, NT_ = F.G * NWAVES * 64;
    const float* cw = F.conv_w(); const float* cbp_ = F.conv_b(); const float* halo = (const float*)F.Win(); bf16* actp = F.ACT();
    for (int item = gt; item < NFG * NBD; item += NT_) {
        const int fg = item % NFG, bd = item / NFG, pm = (bd / 15) * 16 + (bd % 15), f0 = 8 * fg, cg = 256 * (f0 >> 7) + (f0 & 127);
        float w[3][8], bb[8], r254[8], r255[8], r0[8], r1[8], og[2][8], ov[2][8];
#pragma unroll
        for (int half = 0; half < 2; ++half) {
            const int fo = half * DFF + f0, co = cg + half * 128;
#pragma unroll
            for (int j = 0; j < 3; ++j) ld8f(cw + j * F2 + fo, w[j]);
            ld8f(cbp_ + fo, bb);
            ld8f(halo + ((size_t)pm * 4 + 2) * F2 + co, r254); ld8f(halo + ((size_t)pm * 4 + 3) * F2 + co, r255);
            ld8f(halo + ((size_t)(pm + 1) * 4 + 0) * F2 + co, r0); ld8f(halo + ((size_t)(pm + 1) * 4 + 1) * F2 + co, r1);
#pragma unroll
            for (int e = 0; e < 8; ++e) { const float a = r254[e] * w[0][e] + r255[e] * w[1][e] + r0[e] * w[2][e] + bb[e], b = r255[e] * w[0][e] + r0[e] * w[1][e] + r1[e] * w[2][e] + bb[e];
                if (half == 0) { og[0][e] = a; og[1][e] = b; } else { ov[0][e] = a; ov[1][e] = b; } }
        }
#pragma unroll
        for (int rr = 0; rr < 2; ++rr) { float o[8];
#pragma unroll
            for (int e = 0; e < 8; ++e) o[e] = og[rr][e] * sigmoid_f(og[rr][e]) * ov[rr][e];
            v4u wv; wv.x = pk2(o[0], o[1]); wv.y = pk2(o[2], o[3]); wv.z = pk2(o[4], o[5]); wv.w = pk2(o[6], o[7]);
            *(GAS v4u*)(actp + (size_t)(pm * 256 + 255 + rr) * DFF + f0) = wv; }
    }
}

namespace att {
using bf16x8 = __attribute__((ext_vector_type(8))) short;
using s16x4  = __attribute__((ext_vector_type(4))) short;
using f32x16 = __attribute__((ext_vector_type(16))) float;
using u32x4  = __attribute__((ext_vector_type(4))) unsigned;
constexpr int AD = 128, NW = 8, QBLK = 32, KVBLK = 64;
constexpr float THR = 8.f;
constexpr size_t SHM_V = KVBLK * AD * 2, SHM_K = KVBLK * AD * 2, SHM_ATTN = 2 * SHM_V + 2 * SHM_K + NW * 64 * 4;
constexpr int BIAS_OFF = (int)SHM_ATTN;
constexpr int ATT_LDS = BIAS_OFF + 2048;
#define KSWZ(row, colB) ((row) * 256 + ((colB) ^ (((row) & 7) << 4)))
#define SBAR() __builtin_amdgcn_sched_barrier(0)
__device__ __forceinline__ int crow(int r, int hi) { return (r & 3) + 8 * (r >> 2) + 4 * hi; }
__device__ __forceinline__ unsigned cvtpk(float lo, float hi) { unsigned r; asm volatile("v_cvt_pk_bf16_f32 %0, %1, %2" : "=v"(r) : "v"(lo), "v"(hi)); return r; }
template <int FIXM = 0>
__device__ __forceinline__ void partialSM(f32x16& p0, f32x16& p1, float& m_reg, float& mn, float& alpha, float m0c = 0.f) {
  constexpr float C = SCALE * 1.4426950408889634f;
  if (FIXM == 2) { alpha = 1.f; mn = 0.f;
    for (int r = 0; r < 16; ++r) p0[r] = __builtin_amdgcn_exp2f(p0[r]);
    return; }
  if (FIXM == 1) { alpha = 1.f; mn = 0.f;
    for (int r = 0; r < 16; ++r) p0[r] = fmaf(p0[r], C, -m0c); for (int r = 0; r < 16; ++r) p1[r] = fmaf(p1[r], C, -m0c);
    for (int r = 0; r < 16; ++r) p0[r] = __builtin_amdgcn_exp2f(p0[r]);
    return; }
  float pmax = p0[0]; for (int r = 1; r < 16; ++r) pmax = fmaxf(pmax, p0[r]); for (int r = 0; r < 16; ++r) pmax = fmaxf(pmax, p1[r]);
  { auto rr = __builtin_amdgcn_permlane32_swap(__float_as_uint(pmax), __float_as_uint(pmax), false, false);
    pmax = fmaxf(__uint_as_float(rr[0]), __uint_as_float(rr[1])); }
  if (__builtin_expect(__all(pmax - m_reg <= THR / SCALE), 1)) { mn = m_reg; alpha = 1.f; }
  else { mn = fmaxf(m_reg, pmax); alpha = __builtin_amdgcn_exp2f((m_reg - mn) * C); m_reg = mn; }
  float mnC = -mn * C;
  for (int r = 0; r < 16; ++r) p0[r] = fmaf(p0[r], C, mnC); for (int r = 0; r < 16; ++r) p1[r] = fmaf(p1[r], C, mnC);
  for (int r = 0; r < 16; ++r) p0[r] = __builtin_amdgcn_exp2f(p0[r]);
}
__device__ __forceinline__ void finishSM(f32x16& p0, f32x16& p1, float alpha, float& l_reg, bf16x8& pa0, bf16x8& pa1, bf16x8& pa2, bf16x8& pa3) {
  for (int r = 0; r < 16; ++r) p1[r] = __builtin_amdgcn_exp2f(p1[r]);
  float ps = 0; for (int r = 0; r < 16; ++r) ps += p0[r]; for (int r = 0; r < 16; ++r) ps += p1[r];
  { auto rr = __builtin_amdgcn_permlane32_swap(__float_as_uint(ps), __float_as_uint(ps), false, false);
    ps = __uint_as_float(rr[0]) + __uint_as_float(rr[1]); }
  l_reg = l_reg * alpha + ps;
#define PK4(P, BASE, OUT) do { unsigned a0 = cvtpk(P[BASE + 0], P[BASE + 1]), a1 = cvtpk(P[BASE + 2], P[BASE + 3]);   \
    unsigned b0 = cvtpk(P[BASE + 4], P[BASE + 5]), b1 = cvtpk(P[BASE + 6], P[BASE + 7]);                              \
    auto r0 = __builtin_amdgcn_permlane32_swap(a0, b0, false, false); auto r1 = __builtin_amdgcn_permlane32_swap(a1, b1, false, false); \
    u32x4 w = {r0[0], r1[0], r0[1], r1[1]}; OUT = *reinterpret_cast<bf16x8*>(&w); } while (0)
  PK4(p0, 0, pa0); PK4(p0, 8, pa1); PK4(p1, 0, pa2); PK4(p1, 8, pa3);
#undef PK4
}
__device__ __forceinline__ void qkt(f32x16& p0, f32x16& p1, const char* Ks, const bf16x8* qr, int r32, int hi) {
  p0 = f32x16{}; p1 = f32x16{};
  for (int d0 = 0; d0 < 8; ++d0) { int cb = (d0 * 16 + hi * 8) * 2;
    bf16x8 b0 = *reinterpret_cast<const bf16x8*>(Ks + KSWZ(r32, cb));
    bf16x8 b1 = *reinterpret_cast<const bf16x8*>(Ks + KSWZ(32 + r32, cb));
    p0 = __builtin_amdgcn_mfma_f32_32x32x16_bf16(b0, qr[d0], p0, 0, 0, 0);
    p1 = __builtin_amdgcn_mfma_f32_32x32x16_bf16(b1, qr[d0], p1, 0, 0, 0); }
}
__device__ __forceinline__ int v_st(int k, int c) { const int kk = (k & ~0xC) | ((k & 4) << 1) | ((k & 8) >> 1); return ((kk >> 3) * 4 + (c >> 5)) * 512 + ((kk & 7) * 32 + (c & 31)) * 2; }
__device__ __forceinline__ int v_rd_base(int lane) { return ((lane & 3) << 3) | (((lane >> 2) & 3) << 6) | (((lane >> 4) & 1) << 5) | (((lane >> 5) & 1) << 8); }
constexpr int v_rd_off(int d0, int ks, int half) { return d0 * 512 + ks * 4096 + half * 2048; }
template <int OFF> __device__ __forceinline__ s16x4 tr_read(int vb) {
  s16x4 r; asm volatile("ds_read_b64_tr_b16 %0, %1 offset:%2" : "=&v"(r) : "v"(vb), "i"(OFF) : "memory"); return r;
}
template <int D0> __device__ __forceinline__ void pv_one(f32x16& od, int vb, bf16x8 pa0, bf16x8 pa1, bf16x8 pa2, bf16x8 pa3) {
  const s16x4 l0 = tr_read<v_rd_off(D0, 0, 0)>(vb), h0 = tr_read<v_rd_off(D0, 0, 1)>(vb), l1 = tr_read<v_rd_off(D0, 1, 0)>(vb), h1 = tr_read<v_rd_off(D0, 1, 1)>(vb);
  const s16x4 l2 = tr_read<v_rd_off(D0, 2, 0)>(vb), h2 = tr_read<v_rd_off(D0, 2, 1)>(vb), l3 = tr_read<v_rd_off(D0, 3, 0)>(vb), h3 = tr_read<v_rd_off(D0, 3, 1)>(vb);
  asm volatile("s_waitcnt lgkmcnt(0)" ::: "memory"); SBAR();
#define PK(L, H) (bf16x8){L[0], L[1], L[2], L[3], H[0], H[1], H[2], H[3]}
  od = __builtin_amdgcn_mfma_f32_32x32x16_bf16(pa0, PK(l0, h0), od, 0, 0, 0);
  od = __builtin_amdgcn_mfma_f32_32x32x16_bf16(pa1, PK(l1, h1), od, 0, 0, 0);
  od = __builtin_amdgcn_mfma_f32_32x32x16_bf16(pa2, PK(l2, h2), od, 0, 0, 0);
  od = __builtin_amdgcn_mfma_f32_32x32x16_bf16(pa3, PK(l3, h3), od, 0, 0, 0);
#undef PK
}
__device__ __forceinline__ void pv_d0(f32x16* o, int vb, bf16x8 pa0, bf16x8 pa1, bf16x8 pa2, bf16x8 pa3) {
  pv_one<0>(o[0], vb, pa0, pa1, pa2, pa3); pv_one<1>(o[1], vb, pa0, pa1, pa2, pa3); pv_one<2>(o[2], vb, pa0, pa1, pa2, pa3); pv_one<3>(o[3], vb, pa0, pa1, pa2, pa3);
}
struct NatGeo { int R_lo, nloc, qr, rs, qc, cs; };
__device__ __forceinline__ void nat_mask(f32x16& p0, f32x16& p1, int kr, const NatGeo& g, const float* btab, int hi) {
  const float ninf = -__builtin_inff();
  const float* tb = btab + (kr - g.qr + 7) * 31 + 15 - g.qc + 4 * hi;
#pragma unroll
  for (int q = 0; q < 4; ++q) {
    float bb[8];
#pragma unroll
    for (int e = 0; e < 4; ++e) { bb[e] = tb[8 * q + e]; bb[4 + e] = tb[32 + 8 * q + e]; }
#pragma unroll
    for (int e = 0; e < 4; ++e) { const int r = 4 * q + e, k0 = 8 * q + e + 4 * hi, k1 = k0 + 32;
      p0[r] = ((unsigned)(k0 - g.cs) < 16u) ? p0[r] + bb[e] : ninf; p1[r] = ((unsigned)(k1 - g.cs) < 16u) ? p1[r] + bb[4 + e] : ninf; }
    asm volatile("" ::: "memory");
  }
}
template <int LDQ, int LDK, int LDO, int FIXM = 0, bool QFIX = false>
__device__ __forceinline__ void attn_body(const bf16* Qb, const bf16* __restrict__ Kh, const bf16* __restrict__ Vh, bf16* Ob, int NT, char* lds, unsigned char* Ob8 = nullptr, float oscale8 = 1.f, float m0c = 0.f,
                                          const float* qg = nullptr, const float2* ropet = nullptr, int t0 = 0) {
  int tid_o = threadIdx.x; asm volatile("" : "+v"(tid_o));
  const int tid = tid_o, wid = tid >> 6, lane = tid & 63, r32 = lane & 31, hi = lane >> 5;
  char* V_lds = lds; char* K_lds = lds + 2 * SHM_V;
  float* ws = (float*)(lds + 2 * SHM_V + 2 * SHM_K) + wid * 64; float* li_l = ws; float* al_l = ws + 32;
  float m_reg = -1e30f, l_reg = 0; f32x16 o[4] = {}; bf16x8 qr[8];
  const bf16* Qw = Qb + (long)(wid * QBLK + r32) * LDQ + hi * 8;
#pragma unroll
  for (int d0 = 0; d0 < 8; ++d0) qr[d0] = *reinterpret_cast<const bf16x8*>(Qw + d0 * 16);
  if (QFIX) {
    float x[8][8]; float ss = 0.f;
#pragma unroll
    for (int d0 = 0; d0 < 8; ++d0) { const u32x4 w = *reinterpret_cast<const u32x4*>(&qr[d0]);
      x[d0][0] = bf_lo(w.x); x[d0][1] = bf_hi(w.x); x[d0][2] = bf_lo(w.y); x[d0][3] = bf_hi(w.y); x[d0][4] = bf_lo(w.z); x[d0][5] = bf_hi(w.z); x[d0][6] = bf_lo(w.w); x[d0][7] = bf_hi(w.w);
#pragma unroll
      for (int e = 0; e < 8; ++e) ss += x[d0][e] * x[d0][e]; }
    { auto rr = __builtin_amdgcn_permlane32_swap(__float_as_uint(ss), __float_as_uint(ss), false, false); ss = __uint_as_float(rr[0]) + __uint_as_float(rr[1]); }
    const float rstd = (FIXM == 2 ? SCALE * 1.4426950408889634f : 1.0f) / sqrtf(ss * (1.0f / AD) + EPS);
#pragma unroll
    for (int d0 = 0; d0 < 8; ++d0) { const f32x4 g0 = *reinterpret_cast<const f32x4*>(qg + d0 * 16 + hi * 8), g1 = *reinterpret_cast<const f32x4*>(qg + d0 * 16 + hi * 8 + 4);
      x[d0][0] *= rstd * g0.x; x[d0][1] *= rstd * g0.y; x[d0][2] *= rstd * g0.z; x[d0][3] *= rstd * g0.w; x[d0][4] *= rstd * g1.x; x[d0][5] *= rstd * g1.y; x[d0][6] *= rstd * g1.z; x[d0][7] *= rstd * g1.w; }
    const int tok = t0 + wid * QBLK + r32;
#pragma unroll
    for (int half = 0; half < 2; ++half) { const float2* rp = ropet + (half == 0 ? (tok >> 6) : (tok & 63)) * 32 + hi * 8;
#pragma unroll
      for (int dd = 0; dd < 2; ++dd)
#pragma unroll
        for (int e = 0; e < 8; ++e) { const float2 cs = rp[dd * 16 + e]; const float a = x[4 * half + dd][e], b = x[4 * half + dd + 2][e];
          x[4 * half + dd][e] = a * cs.x - b * cs.y; x[4 * half + dd + 2][e] = b * cs.x + a * cs.y; } }
#pragma unroll
    for (int d0 = 0; d0 < 8; ++d0) { u32x4 w = {cvtpk(x[d0][0], x[d0][1]), cvtpk(x[d0][2], x[d0][3]), cvtpk(x[d0][4], x[d0][5]), cvtpk(x[d0][6], x[d0][7])}; qr[d0] = *reinterpret_cast<bf16x8*>(&w); }
  }
  const int sr = tid >> 4, sc = (tid & 15) * 8, vst0 = v_st(sr, sc), vst1 = v_st(32 + sr, sc);
  const int vb0 = (int)(uintptr_t)V_lds + v_rd_base(lane);
  struct { bf16x8 vs0, vs1, ks0, ks1; } sr_[2];
#define TROW(j) (64 * (j))
#define SLOAD(i, j) do { const long k0_ = TROW(j); sr_[i].vs0 = *reinterpret_cast<const bf16x8*>(&Vh[(k0_ + sr) * LDK + sc]); sr_[i].vs1 = *reinterpret_cast<const bf16x8*>(&Vh[(k0_ + 32 + sr) * LDK + sc]); \
    sr_[i].ks0 = *reinterpret_cast<const bf16x8*>(&Kh[(k0_ + sr) * LDK + sc]); sr_[i].ks1 = *reinterpret_cast<const bf16x8*>(&Kh[(k0_ + 32 + sr) * LDK + sc]); } while (0)
#define SWRITE(b, i) do { *(bf16x8*)(V_lds + (b) * SHM_V + vst0) = sr_[i].vs0;          \
    *(bf16x8*)(V_lds + (b) * SHM_V + vst1) = sr_[i].vs1; int kc = sc * 2;               \
    *(bf16x8*)(K_lds + (b) * SHM_K + KSWZ(sr, kc)) = sr_[i].ks0;                       \
    *(bf16x8*)(K_lds + (b) * SHM_K + KSWZ(32 + sr, kc)) = sr_[i].ks1; } while (0)
#define SWAIT() asm volatile("s_waitcnt vmcnt(4)" ::: "memory")
#define RESC(a) do { if (__any((a) < 1.f)) { if (hi == 0) al_l[r32] = (a); asm volatile("s_waitcnt lgkmcnt(0)" ::: "memory"); \
    for (int d = 0; d < 4; ++d) for (int r = 0; r < 16; ++r) o[d][r] *= al_l[crow(r, hi)]; } } while (0)
#define MASK(P0, P1, j) do { } while (0)
  f32x16 pA0, pA1, pB0, pB1; float mnA, mnB, alA, alB; bf16x8 pa0, pa1, pa2, pa3;
  constexpr int SE = 0, SO = 1;
  SLOAD(SE, 0); asm volatile("s_waitcnt vmcnt(0)" ::: "memory"); SWRITE(0, SE); __syncthreads();
  qkt(pA0, pA1, K_lds, qr, r32, hi); MASK(pA0, pA1, 0); partialSM<FIXM>(pA0, pA1, m_reg, mnA, alA, m0c);
  SLOAD(SO, 1); if (2 < NT) SLOAD(SE, 2);
  SWAIT(); SWRITE(1, SO); __syncthreads();
  for (int j = 1; j + 1 < NT; j += 2) {
    SBAR(); qkt(pB0, pB1, K_lds + SHM_K, qr, r32, hi);
    finishSM(pA0, pA1, alA, l_reg, pa0, pa1, pa2, pa3); SBAR();
    SLOAD(SO, j + 2); SBAR();
    pv_d0(o, vb0, pa0, pa1, pa2, pa3); MASK(pB0, pB1, j); partialSM<FIXM>(pB0, pB1, m_reg, mnB, alB, m0c);
    __syncthreads(); SWAIT(); SWRITE(0, SE);
    RESC(alB); __syncthreads();
    SBAR(); qkt(pA0, pA1, K_lds, qr, r32, hi);
    finishSM(pB0, pB1, alB, l_reg, pa0, pa1, pa2, pa3); SBAR();
    if (j + 3 < NT) SLOAD(SE, j + 3); SBAR();
    pv_d0(o, vb0 + (int)SHM_V, pa0, pa1, pa2, pa3); MASK(pA0, pA1, j + 1); partialSM<FIXM>(pA0, pA1, m_reg, mnA, alA, m0c);
    __syncthreads(); SWAIT(); SWRITE(1, SO);
    RESC(alA); __syncthreads();
  }
  SBAR(); qkt(pB0, pB1, K_lds + SHM_K, qr, r32, hi);
  finishSM(pA0, pA1, alA, l_reg, pa0, pa1, pa2, pa3); SBAR();
  pv_d0(o, vb0, pa0, pa1, pa2, pa3); MASK(pB0, pB1, NT - 1); partialSM<FIXM>(pB0, pB1, m_reg, mnB, alB, m0c);
  __syncthreads(); RESC(alB);
  finishSM(pB0, pB1, alB, l_reg, pa0, pa1, pa2, pa3); SBAR();
  pv_d0(o, vb0 + (int)SHM_V, pa0, pa1, pa2, pa3);
  if (hi == 0) li_l[r32] = l_reg; asm volatile("s_waitcnt lgkmcnt(0)" ::: "memory");
  float rli[16];
#pragma unroll
  for (int r = 0; r < 16; ++r) rli[r] = __builtin_amdgcn_rcpf(li_l[crow(r, hi)]);
  bf16* Ow = Ob + (long)(wid * QBLK) * LDO;
#pragma unroll
  for (int r = 0; r < 16; ++r) { int orow = crow(r, hi);
    if (BR_FP8) { unsigned char* Ow8 = Ob8 + (long)(wid * QBLK + orow) * LDO;
      for (int d0 = 0; d0 < 4; ++d0) Ow8[d0 * 32 + r32] = (unsigned char)(pk4_fp8(o[d0][r] * rli[r] * oscale8, 0.f, 0.f, 0.f) & 0xffu); }
    else for (int d0 = 0; d0 < 4; ++d0) Ow[(long)orow * LDO + d0 * 32 + r32] = (bf16)(cvtpk(o[d0][r] * rli[r], 0.f) & 0xffffu); }
#undef TROW
#undef SLOAD
#undef SWRITE
#undef SWAIT
#undef RESC
#undef MASK
}

template <int LDQ, int LDK, int LDO>
__device__ __forceinline__ void nat_body(const bf16* Qb, const bf16* __restrict__ Kh, const bf16* __restrict__ Vh, bf16* Ob, const NatGeo g, char* lds, unsigned char* Ob8 = nullptr, float oscale8 = 1.f) {
  int tid_o = threadIdx.x; asm volatile("" : "+v"(tid_o));
  const int tid = tid_o, wid = tid >> 6, lane = tid & 63, r32 = lane & 31, hi = lane >> 5;
  char* V_lds = lds; char* K_lds = lds + 2 * SHM_V;
  float* ws = (float*)(lds + 2 * SHM_V + 2 * SHM_K) + wid * 64; float* li_l = ws; float* al_l = ws + 32;
  const float* btab = (const float*)(lds + BIAS_OFF);
  float m_reg = -1e30f, l_reg = 0; f32x16 o[4] = {}; bf16x8 qr[8];
  const bf16* Qw = Qb + (long)(wid * QBLK + r32) * LDQ + hi * 8;
#pragma unroll
  for (int d0 = 0; d0 < 8; ++d0) qr[d0] = *reinterpret_cast<const bf16x8*>(Qw + d0 * 16);
  const int sr = tid >> 4, sc = (tid & 15) * 8, vst0 = v_st(sr, sc), vst1 = v_st(32 + sr, sc);
  const int vb0 = (int)(uintptr_t)V_lds + v_rd_base(lane);
  bf16x8 vs0, vs1, ks0, ks1;
#define TROW(j) ((j) < 4 ? 64 * (j) : L + 64 * (g.R_lo + (j) - 4))
#define SLOAD(j) do { const long k0_ = TROW(j); vs0 = *reinterpret_cast<const bf16x8*>(&Vh[(k0_ + sr) * LDK + sc]); vs1 = *reinterpret_cast<const bf16x8*>(&Vh[(k0_ + 32 + sr) * LDK + sc]); \
    ks0 = *reinterpret_cast<const bf16x8*>(&Kh[(k0_ + sr) * LDK + sc]); ks1 = *reinterpret_cast<const bf16x8*>(&Kh[(k0_ + 32 + sr) * LDK + sc]); } while (0)
#define SWRITE(b) do { *(bf16x8*)(V_lds + (b) * SHM_V + vst0) = vs0; *(bf16x8*)(V_lds + (b) * SHM_V + vst1) = vs1; int kc = sc * 2;               \
    *(bf16x8*)(K_lds + (b) * SHM_K + KSWZ(sr, kc)) = ks0; *(bf16x8*)(K_lds + (b) * SHM_K + KSWZ(32 + sr, kc)) = ks1; } while (0)
  const int NT = 4 + g.nloc;
  SLOAD(0); asm volatile("s_waitcnt vmcnt(0)" ::: "memory"); SWRITE(0); __syncthreads();
  for (int j = 0; j < NT; ++j) {
    const int b = j & 1;
    if (j + 1 < NT) SLOAD(j + 1);
    const int kr = g.R_lo + j - 4;
    const bool skip = (j >= 4) && ((unsigned)(kr - g.rs) >= 8u);
    if (!skip) {
      f32x16 p0, p1; float mn, al; bf16x8 pa0, pa1, pa2, pa3;
      qkt(p0, p1, K_lds + b * SHM_K, qr, r32, hi);
      if (j >= 4) nat_mask(p0, p1, kr, g, btab, hi);
      partialSM(p0, p1, m_reg, mn, al);
      if (__any(al < 1.f)) { if (hi == 0) al_l[r32] = al; asm volatile("s_waitcnt lgkmcnt(0)" ::: "memory");
        for (int d = 0; d < 4; ++d) for (int r = 0; r < 16; ++r) o[d][r] *= al_l[crow(r, hi)]; }
      finishSM(p0, p1, al, l_reg, pa0, pa1, pa2, pa3); SBAR();
      pv_d0(o, vb0 + b * (int)SHM_V, pa0, pa1, pa2, pa3);
    }
    if (j + 1 < NT) { asm volatile("s_waitcnt vmcnt(0)" ::: "memory"); SWRITE(b ^ 1); }
    __syncthreads();
  }
  if (hi == 0) li_l[r32] = l_reg; asm volatile("s_waitcnt lgkmcnt(0)" ::: "memory");
  float rli[16];
#pragma unroll
  for (int r = 0; r < 16; ++r) rli[r] = __builtin_amdgcn_rcpf(li_l[crow(r, hi)]);
  bf16* Ow = Ob + (long)(wid * QBLK) * LDO;
#pragma unroll
  for (int r = 0; r < 16; ++r) { int orow = crow(r, hi);
    if (BR_FP8) { unsigned char* Ow8 = Ob8 + (long)(wid * QBLK + orow) * LDO;
      for (int d0 = 0; d0 < 4; ++d0) Ow8[d0 * 32 + r32] = (unsigned char)(pk4_fp8(o[d0][r] * rli[r] * oscale8, 0.f, 0.f, 0.f) & 0xffu); }
    else for (int d0 = 0; d0 < 4; ++d0) Ow[(long)orow * LDO + d0 * 32 + r32] = (bf16)(cvtpk(o[d0][r] * rli[r], 0.f) & 0xffffu); }
#undef TROW
#undef SLOAD
#undef SWRITE
}
}

__device__ __forceinline__ void p4_attention(Frame& F) {
    char* lds = (char*)(F.lds + RING_OFF);
    bf16* QOp = F.QO(); const bf16* KAp = F.KA(); const bf16* VAp = F.VA(); const bf16* KBp = F.KB(); const bf16* VBp = F.VB(); const float* rpbp = F.rpb(); bf16* scrp = F.ACT(); unsigned char* o8p = (unsigned char*)F.ACT(); const float* qgp = F.qnorm(); const float2* ropep = F.rope();
    float m0c, m0c_raw; { const float gq = fmaxf(fabsf(F.qnorm()[F.lane]), fabsf(F.qnorm()[64 + F.lane])), gk = fmaxf(fabsf(F.knorm()[F.lane]), fabsf(F.knorm()[64 + F.lane])); float a = gq, b = gk;
#pragma unroll
      for (int o = 1; o < 64; o <<= 1) { a = fmaxf(a, __shfl_xor(a, o)); b = fmaxf(b, __shfl_xor(b, o)); }
      m0c_raw = __uint_as_float(__builtin_amdgcn_readfirstlane(__float_as_uint(128.0f * 1.01f * a * b * SCALE * 1.4426950408889634f))); m0c = fminf(m0c_raw, 60.0f); }
#ifndef ATT_NO_A
    for (int u = F.vcu; u < NB * KVA * GQ * (S / 256); u += F.G) {
        const int grp = u >> 6, j = u & 63, b = grp >> 2, kvh = grp & 3, gq = j >> 4, qblk = j & 15;
        bf16* Q = QOp + ((size_t)(b * S + qblk * 256)) * 4096 + (kvh * GQ + gq) * HD;
        const bf16* K = KAp + (size_t)b * KT * 512 + kvh * HD; const bf16* V = VAp + (size_t)b * KT * 512 + kvh * HD;
        __syncthreads();
#if defined(ATT_PROBE) && (ATT_PROBE & 1)
        att::attn_body<4096, 512, 4096>(Q, K, V, scrp + (Q - QOp), KT / 64, lds); __syncthreads();
#endif
        if (QFIX_ATT && m0c_raw <= 40.0f) att::attn_body<4096, 512, 4096, 2, QFIX_ATT>(Q, K, V, Q, KT / 64, lds, o8p + (Q - QOp), SC_OA, 0.f, qgp, ropep, qblk * 256);
        else att::attn_body<4096, 512, 4096, 1, QFIX_ATT>(Q, K, V, Q, KT / 64, lds, o8p + (Q - QOp), SC_OA, m0c, qgp, ropep, qblk * 256);
    }
#endif
#ifndef ATT_NO_B
    for (int u = F.vcu; u < NB * HB * (S / 256); u += F.G) {
        const int pair = u >> 4, rblk = u & 15, b = pair >> 4, h = pair & 15, r0 = 4 * rblk;
        bf16* Q = QOp + ((size_t)(b * S + r0 * GW)) * 4096 + 2048 + h * HD;
        const bf16* K = KBp + (size_t)b * KT * 2048 + h * HD; const bf16* V = VBp + (size_t)b * KT * 2048 + h * HD;
        int R_lo = r0 - 4; R_lo = R_lo < 0 ? 0 : (R_lo > GW - 8 ? GW - 8 : R_lo);
        int R_hi = r0 + 3 - 4; R_hi = (R_hi < 0 ? 0 : (R_hi > GW - 8 ? GW - 8 : R_hi)) + 7;
        att::NatGeo g; g.R_lo = R_lo; g.nloc = R_hi - R_lo + 1; g.qr = r0 + (F.wave >> 1); g.qc = 32 * (F.wave & 1) + (F.lane & 31);
        g.rs = g.qr - 4; g.rs = g.rs < 0 ? 0 : (g.rs > GW - 8 ? GW - 8 : g.rs); g.cs = g.qc - 8; g.cs = g.cs < 0 ? 0 : (g.cs > GW - 16 ? GW - 16 : g.cs);
        __syncthreads();
        if (F.tid < 15 * 31) ((LAS float*)(F.lds + RING_OFF + att::BIAS_OFF))[F.tid] = rpbp[h * (15 * 31) + F.tid] * (1.0f / SCALE);
        __syncthreads();
#if defined(ATT_PROBE) && (ATT_PROBE & 2)
        att::nat_body<4096, 2048, 4096>(Q, K, V, scrp + (Q - QOp), g, lds); __syncthreads();
#endif
        att::nat_body<4096, 2048, 4096>(Q, K, V, Q, g, lds, o8p + (Q - QOp), SC_OB);
    }
#endif
    __syncthreads();
}

typedef const f32x4 (&AccRef)[2][2][4][2];
__device__ __forceinline__ v4u pack8(const f32x4 v0, const f32x4 v1) { v4u w; w.x = pk2(v0[0], v0[1]); w.y = pk2(v0[2], v0[3]); w.z = pk2(v1[0], v1[1]); w.w = pk2(v1[2], v1[3]); return w; }
template <bool FP8C> struct EpiInProj {
    static constexpr bool PERM = true, AFTER_DRAIN = false, MIDK = false;
    bf16 *QO, *KA, *VA, *KB, *VB, *GA, *GB; const float* rsh; float wscale;
    __device__ __forceinline__ void operator()(AccRef acc, const pg8::Unit& u, int wr, int wc, int fr, int fq) const {
        constexpr bool I8 = FP8C && INPROJ_MODE == 2;
        const int pm = u.pm, pn = inproj_global_tile(FP8C, u.pn); const bool ctx = pm >= 64; const float osc = FP8C ? 1.0f / SC_WIN : 1.0f; const int b = ctx ? pm - 64 : pm >> 4; const size_t krow0 = (size_t)b * KT + (ctx ? 0 : L + (pm & 15) * 256);
        bf16* tile; int ldc; bool sig = false;
        if (pn < 8) { tile = QO + (size_t)pm * 256 * 4096 + pn * 256; ldc = 4096; }
        else if (pn < 10) { tile = KA + krow0 * 512 + (pn - 8) * 256; ldc = 512; }
        else if (pn < 12) { tile = VA + krow0 * 512 + (pn - 10) * 256; ldc = 512; }
        else if (pn < 20) { tile = QO + (size_t)pm * 256 * 4096 + 2048 + (pn - 12) * 256; ldc = 4096; }
        else if (pn < 28) { tile = KB + krow0 * 2048 + (pn - 20) * 256; ldc = 2048; }
        else if (pn < 36) { tile = VB + krow0 * 2048 + (pn - 28) * 256; ldc = 2048; }
        else { tile = QO; ldc = 4096; sig = true; }
        unsigned char* gt = (unsigned char*)(pn < 52 ? GA : GB) + (size_t)pm * 256 * 4096 + (pn - (pn < 52 ? 36 : 52)) * 256;
#pragma unroll
        for (int ai = 0; ai < 2; ++ai)
#pragma unroll
            for (int m = 0; m < 4; ++m) { bf16* rowp = tile + (size_t)(ai * 128 + wr * 64 + m * 16 + fr) * ldc + wc * 32 + 8 * fq;
                const float rsc = I8 ? rsh[pm * 256 + ai * 128 + wr * 64 + m * 16 + fr] * wscale : osc;
#pragma unroll
                for (int bj = 0; bj < 2; ++bj) { f32x4 v0, v1;
                    if (I8) { typedef int i32x4_ __attribute__((ext_vector_type(4)));
                        const f32x4 a0 = acc[ai][bj][m][0], a1 = acc[ai][bj][m][1];
                        v0 = __builtin_convertvector(__builtin_bit_cast(i32x4_, a0), f32x4) * rsc; v1 = __builtin_convertvector(__builtin_bit_cast(i32x4_, a1), f32x4) * rsc; }
                    else { v0 = acc[ai][bj][m][0] * rsc; v1 = acc[ai][bj][m][1] * rsc; }
                    if (sig) {
#pragma unroll
                        for (int e = 0; e < 4; ++e) { v0[e] = 255.0f * sigmoid_f(v0[e]); v1[e] = 255.0f * sigmoid_f(v1[e]); }
                        v2u w; w.x = pk4_u8(v0[0], v0[1], v0[2], v0[3]); w.y = pk4_u8(v1[0], v1[1], v1[2], v1[3]);
                        *(GAS v2u*)(gt + (size_t)(ai * 128 + wr * 64 + m * 16 + fr) * 4096 + wc * 32 + 8 * fq + bj * 128) = w; }
                    else *(GAS v4u*)(rowp + bj * 128) = pack8(v0, v1); } }
    }
};
struct EpiPlain {
    static constexpr bool PERM = true, AFTER_DRAIN = false, MIDK = false;
    bf16* O; int ldc; int pad;
    __device__ __forceinline__ void operator()(AccRef acc, const pg8::Unit& u, int wr, int wc, int fr, int fq) const {
        bf16* tile = O + (size_t)u.pm * 256 * ldc + u.pn * 256;
#pragma unroll
        for (int ai = 0; ai < 2; ++ai)
#pragma unroll
            for (int m = 0; m < 4; ++m) { bf16* rowp = tile + (size_t)(ai * 128 + wr * 64 + m * 16 + fr) * ldc + wc * 32 + 8 * fq;
#pragma unroll
                for (int bj = 0; bj < 2; ++bj) *(GAS v4u*)(rowp + bj * 128) = pack8(acc[ai][bj][m][0], acc[ai][bj][m][1]); }
    }
};
template <bool ACCUM> struct EpiGate {
    static constexpr bool PERM = true, AFTER_DRAIN = false, MIDK = false;
    bf16* Y; const bf16* G; unsigned char* Y8;
    __device__ __forceinline__ void operator()(AccRef acc, const pg8::Unit& u, int wr, int wc, int fr, int fq) const {
        const size_t t0 = (size_t)u.pm * 256 * 4096 + u.pn * 256;
#pragma unroll
        for (int ai = 0; ai < 2; ++ai)
#pragma unroll
            for (int m = 0; m < 4; ++m) { const size_t ro = t0 + (size_t)(ai * 128 + wr * 64 + m * 16 + fr) * 4096 + wc * 32 + 8 * fq;
#pragma unroll
                for (int bj = 0; bj < 2; ++bj) { const v4u g = *(const GAS v4u*)(G + ro + bj * 128); f32x4 v0 = acc[ai][bj][m][0], v1 = acc[ai][bj][m][1];
                    v0[0] *= bf_lo(g.x); v0[1] *= bf_hi(g.x); v0[2] *= bf_lo(g.y); v0[3] *= bf_hi(g.y); v1[0] *= bf_lo(g.z); v1[1] *= bf_hi(g.z); v1[2] *= bf_lo(g.w); v1[3] *= bf_hi(g.w);
                    if (ACCUM) { const v4u y = *(const GAS v4u*)(Y + ro + bj * 128);
                        v0[0] += bf_lo(y.x); v0[1] += bf_hi(y.x); v0[2] += bf_lo(y.y); v0[3] += bf_hi(y.y); v1[0] += bf_lo(y.z); v1[1] += bf_hi(y.z); v1[2] += bf_lo(y.w); v1[3] += bf_hi(y.w); }
                    if (ACCUM && WOUT_FP8) { v0 = v0 * SC_Y; v1 = v1 * SC_Y; v2u w; w.x = pk4_fp8(v0[0], v0[1], v0[2], v0[3]); w.y = pk4_fp8(v1[0], v1[1], v1[2], v1[3]); *(GAS v2u*)(Y8 + ro + bj * 128) = w; }
                    else *(GAS v4u*)(Y + ro + bj * 128) = pack8(v0, v1); } }
    }
};
struct EpiGateMerged {
    static constexpr bool PERM = true, AFTER_DRAIN = false, MIDK = true;
    static constexpr float MIDS = BR_FP8 ? SC_OB / SC_OA : 1.0f, ENDS = BR_FP8 ? 1.0f / (SC_OB * SC_WBR) : 1.0f;
    bf16* Y; const unsigned char* GA; const unsigned char* GB; unsigned char* Y8;
    __device__ __forceinline__ void mid(f32x4 (&acc)[2][2][4][2], const pg8::Unit& u, int wr, int wc, int fr, int fq) const {
        size_t rb = (size_t)u.pm * 256 * 4096 + u.pn * 256 + (size_t)(wr * 64 + fr) * 4096 + wc * 32 + 8 * fq;
        asm volatile("" : "+v"(rb));
#pragma unroll
        for (int ai = 0; ai < 2; ++ai)
#pragma unroll
            for (int m = 0; m < 4; ++m) { const size_t ro = rb + (size_t)(ai * 128 + m * 16) * 4096;
#pragma unroll
                for (int bj = 0; bj < 2; ++bj) { const v2u a = *(const GAS v2u*)(GA + ro + bj * 128), b = *(const GAS v2u*)(GB + ro + bj * 128);
                    const unsigned aw[2] = {a.x, a.y}, bw[2] = {b.x, b.y};
#pragma unroll
                    for (int n = 0; n < 2; ++n)
#pragma unroll
                        for (int e = 0; e < 4; ++e) acc[ai][bj][m][n][e] *= ub(aw[n], e) * MIDS * __builtin_amdgcn_rcpf(fmaxf(ub(bw[n], e), 1e-20f));
                    asm volatile("" : "+v"(acc[ai][bj][m][0]), "+v"(acc[ai][bj][m][1])); }
                __builtin_amdgcn_sched_barrier(0); }
    }
    __device__ __forceinline__ void operator()(AccRef acc, const pg8::Unit& u, int wr, int wc, int fr, int fq) const {
        size_t rb = (size_t)u.pm * 256 * 4096 + u.pn * 256 + (size_t)(wr * 64 + fr) * 4096 + wc * 32 + 8 * fq;
        asm volatile("" : "+v"(rb));
#pragma unroll
        for (int ai = 0; ai < 2; ++ai)
#pragma unroll
            for (int m = 0; m < 4; ++m) { const size_t ro = rb + (size_t)(ai * 128 + m * 16) * 4096;
#pragma unroll
                for (int bj = 0; bj < 2; ++bj) { const v2u g = *(const GAS v2u*)(GB + ro + bj * 128); f32x4 v0 = acc[ai][bj][m][0], v1 = acc[ai][bj][m][1];
#pragma unroll
                    for (int e = 0; e < 4; ++e) { v0[e] *= (ENDS / 255.0f) * fmaxf(ub(g.x, e), 1e-20f); v1[e] *= (ENDS / 255.0f) * fmaxf(ub(g.y, e), 1e-20f); }
                    if (WOUT_FP8) { v0 = v0 * SC_Y; v1 = v1 * SC_Y; v2u w; w.x = pk4_fp8(v0[0], v0[1], v0[2], v0[3]); w.y = pk4_fp8(v1[0], v1[1], v1[2], v1[3]); *(GAS v2u*)(Y8 + ro + bj * 128) = w; }
                    else *(GAS v4u*)(Y + ro + bj * 128) = pack8(v0, v1); } }
    }
};
struct EpiDelta {
    static constexpr bool PERM = true, AFTER_DRAIN = false, MIDK = false;
    bf16* dout; const float* gate; float oscale; int pad;
    __device__ __forceinline__ void operator()(AccRef acc, const pg8::Unit& u, int wr, int wc, int fr, int fq) const {
        const float* gb = gate + (size_t)(u.pm >> 4) * MODN + u.pn * 256 + wc * 32 + 8 * fq;
        f32x4 gv[2][2];
#pragma unroll
        for (int bj = 0; bj < 2; ++bj)
#pragma unroll
            for (int n = 0; n < 2; ++n) gv[bj][n] = *(const GAS f32x4*)(gb + bj * 128 + n * 4) * oscale;
#pragma unroll
        for (int ai = 0; ai < 2; ++ai)
#pragma unroll
            for (int m = 0; m < 4; ++m) { bf16* rowp = dout + (size_t)(u.pm * 256 + ai * 128 + wr * 64 + m * 16 + fr) * D + u.pn * 256 + wc * 32 + 8 * fq;
#pragma unroll
                for (int bj = 0; bj < 2; ++bj) *(GAS v4u*)(rowp + bj * 128) = pack8(gv[bj][0] * acc[ai][bj][m][0], gv[bj][1] * acc[ai][bj][m][1]); }
    }
};
struct EpiDeltaI8 {
    static constexpr bool PERM = true, AFTER_DRAIN = false, MIDK = false;
    bf16* dout; const float* gate; const float* rs; float wscale; int pad;
    __device__ __forceinline__ void operator()(AccRef acc, const pg8::Unit& u, int wr, int wc, int fr, int fq) const {
        typedef int i32x4_ __attribute__((ext_vector_type(4)));
        const float* gb = gate + (size_t)(u.pm >> 4) * MODN + u.pn * 256 + wc * 32 + 8 * fq;
        f32x4 gv[2][2]; float rsc[2][4];
#pragma unroll
        for (int bj = 0; bj < 2; ++bj)
#pragma unroll
            for (int n = 0; n < 2; ++n) gv[bj][n] = *(const GAS f32x4*)(gb + bj * 128 + n * 4) * wscale;
#pragma unroll
        for (int ai = 0; ai < 2; ++ai)
#pragma unroll
            for (int m = 0; m < 4; ++m) rsc[ai][m] = rs[u.pm * 256 + ai * 128 + wr * 64 + m * 16 + fr];
#pragma unroll
        for (int ai = 0; ai < 2; ++ai)
#pragma unroll
            for (int m = 0; m < 4; ++m) { bf16* rowp = dout + (size_t)(u.pm * 256 + ai * 128 + wr * 64 + m * 16 + fr) * D + u.pn * 256 + wc * 32 + 8 * fq;
#pragma unroll
                for (int bj = 0; bj < 2; ++bj) { const f32x4 a0 = acc[ai][bj][m][0], a1 = acc[ai][bj][m][1];
                    *(GAS v4u*)(rowp + bj * 128) = pack8(gv[bj][0] * (__builtin_convertvector(__builtin_bit_cast(i32x4_, a0), f32x4) * rsc[ai][m]), gv[bj][1] * (__builtin_convertvector(__builtin_bit_cast(i32x4_, a1), f32x4) * rsc[ai][m])); } }
    }
};
#ifndef RESID_BATCH
#define RESID_BATCH 2
#endif
#ifndef RESID_NT
#define RESID_NT 0
#endif
#if RESID_NT
#define NT_LOAD(p) __builtin_nontemporal_load(p)
#define NT_STORE(v, p) __builtin_nontemporal_store(v, p)
#else
#define NT_LOAD(p) (*(p))
#define NT_STORE(v, p) (*(p) = (v))
#endif
struct EpiResid {
    static constexpr bool PERM = true, AFTER_DRAIN = false, MIDK = false;
    float* out; const float* base; const float* gate; float oscale; int pad;
    __device__ __forceinline__ void operator()(AccRef acc, const pg8::Unit& u, int wr, int wc, int fr, int fq) const {
        const float* gb = gate + (size_t)(u.pm >> 4) * MODN + u.pn * 256 + wc * 32 + 8 * fq;
        f32x4 gv[2][2];
#pragma unroll
        for (int bj = 0; bj < 2; ++bj)
#pragma unroll
            for (int n = 0; n < 2; ++n) gv[bj][n] = *(const GAS f32x4*)(gb + bj * 128 + n * 4) * oscale;
#pragma unroll
        for (int q = 0; q < 2 * (4 / RESID_BATCH); ++q) { const int ai = q / (4 / RESID_BATCH), m0 = (q % (4 / RESID_BATCH)) * RESID_BATCH;
            const size_t r0 = (size_t)(u.pm * 256 + ai * 128 + wr * 64 + m0 * 16 + fr) * D + u.pn * 256 + wc * 32 + 8 * fq; f32x4 bs[RESID_BATCH][2][2];
#pragma unroll
            for (int m = 0; m < RESID_BATCH; ++m)
#pragma unroll
                for (int bj = 0; bj < 2; ++bj)
#pragma unroll
                    for (int n = 0; n < 2; ++n) bs[m][bj][n] = NT_LOAD((const GAS f32x4*)(base + r0 + (size_t)(m * 16) * D + bj * 128 + n * 4));
#pragma unroll
            for (int m = 0; m < RESID_BATCH; ++m)
#pragma unroll
                for (int bj = 0; bj < 2; ++bj)
#pragma unroll
                    for (int n = 0; n < 2; ++n) NT_STORE(bs[m][bj][n] + gv[bj][n] * acc[ai][bj][m0 + m][n], (GAS f32x4*)(out + r0 + (size_t)(m * 16) * D + bj * 128 + n * 4)); }
    }
};
__device__ __forceinline__ float dpp_f(float old, float src, const int ctrl_sel) {
    const int o = __builtin_bit_cast(int, old), x = __builtin_bit_cast(int, src); int r;
    if (ctrl_sel == 0) r = __builtin_amdgcn_update_dpp(o, x, 0x111, 0xf, 0xf, false);
    else if (ctrl_sel == 1) r = __builtin_amdgcn_update_dpp(o, x, 0x101, 0xf, 0xf, false);
    else if (ctrl_sel == 2) r = __builtin_amdgcn_update_dpp(o, x, 0x121, 0xf, 0xf, false);
    else r = __builtin_amdgcn_update_dpp(o, x, 0x12F, 0xf, 0xf, false);
    return __builtin_bit_cast(float, r);
}
template <int SEL> __device__ __forceinline__ f32x4 dpp4(const f32x4 old, const f32x4 src) { f32x4 r; r.x = dpp_f(old.x, src.x, SEL); r.y = dpp_f(old.y, src.y, SEL); r.z = dpp_f(old.z, src.z, SEL); r.w = dpp_f(old.w, src.w, SEL); return r; }
constexpr int XCH_OFF = LDSCTL_OFF + 1024;
static_assert(XCH_OFF + 8192 <= LDS_BYTES, "LDS map");
struct EpiConvAct {
    static constexpr bool PERM = true, AFTER_DRAIN = false, MIDK = false;
    bf16* ACT; float* HALO; const float* cw; const float* cb; LAS f32x4* xch;
    __device__ __forceinline__ void operator()(f32x4 (&acc)[2][2][4][2], const pg8::Unit& u, int wr, int wc, int fr, int fq) const {
        const int wid = wr * 4 + wc, fbase = 128 * u.pn + 32 * wc + 8 * fq;
        const f32x4 zero4 = {0.f, 0.f, 0.f, 0.f};
        f32x4 W0[2][2], W1[2][2], W2[2][2], Bb[2][2];
#pragma unroll
        for (int bj = 0; bj < 2; ++bj)
#pragma unroll
            for (int n = 0; n < 2; ++n) { const int fo = bj * DFF + fbase + 4 * n; W0[bj][n] = *(const GAS f32x4*)(cw + fo); W1[bj][n] = *(const GAS f32x4*)(cw + F2 + fo); W2[bj][n] = *(const GAS f32x4*)(cw + 2 * F2 + fo); Bb[bj][n] = *(const GAS f32x4*)(cb + fo); }
        LAS f32x4* mine = xch + wid * 64;
        if (fr == 0) {
#pragma unroll
            for (int ai = 0; ai < 2; ++ai)
#pragma unroll
                for (int bj = 0; bj < 2; ++bj)
#pragma unroll
                    for (int n = 0; n < 2; ++n) mine[((ai * 2 + 0) * 4 + fq) * 4 + bj * 2 + n] = acc[ai][bj][0][n]; }
        if (fr == 15) {
#pragma unroll
            for (int ai = 0; ai < 2; ++ai)
#pragma unroll
                for (int bj = 0; bj < 2; ++bj)
#pragma unroll
                    for (int n = 0; n < 2; ++n) mine[((ai * 2 + 1) * 4 + fq) * 4 + bj * 2 + n] = acc[ai][bj][3][n]; }
        { const int slot = wr == 0 ? fr : fr - 12;
          if ((wr == 0 && fr < 2) || (wr == 1 && fr >= 14)) { float* hp = HALO + ((size_t)u.pm * 4 + slot) * F2 + 256 * u.pn + 32 * wc + 8 * fq;
#pragma unroll
              for (int bj = 0; bj < 2; ++bj)
#pragma unroll
                  for (int n = 0; n < 2; ++n) *(GAS f32x4*)(hp + bj * 128 + 4 * n) = wr == 0 ? acc[0][bj][0][n] : acc[1][bj][3][n]; } }
        asm volatile("s_waitcnt vmcnt(0) lgkmcnt(0)" ::: "memory"); __builtin_amdgcn_s_barrier(); asm volatile("" ::: "memory");
#pragma unroll
        for (int bj = 0; bj < 2; ++bj)
#pragma unroll
            for (int n = 0; n < 2; ++n) asm volatile("" : "+v"(W0[bj][n]), "+v"(W1[bj][n]), "+v"(W2[bj][n]), "+v"(Bb[bj][n]));
        __builtin_amdgcn_sched_barrier(0);
#pragma unroll
        for (int bj = 0; bj < 2; ++bj) {
#pragma unroll
            for (int ai = 0; ai < 2; ++ai) {
                const int rho = 2 * ai + wr;
                f32x4 carry[2], eN[2];
#pragma unroll
                for (int n = 0; n < 2; ++n) {
                    carry[n] = rho > 0 ? xch[(((rho - 1) & 1) * 4 + wc) * 64 + ((((rho - 1) >> 1) * 2 + 1) * 4 + fq) * 4 + bj * 2 + n] : zero4;
                    eN[n] = rho < 3 ? xch[(((rho + 1) & 1) * 4 + wc) * 64 + ((((rho + 1) >> 1) * 2 + 0) * 4 + fq) * 4 + bj * 2 + n] : zero4; }
#pragma unroll
                for (int m = 0; m < 4; ++m)
#pragma unroll
                    for (int n = 0; n < 2; ++n) {
                        const f32x4 cur = acc[ai][bj][m][n];
                        const f32x4 prv = dpp4<0>(carry[n], cur);
                        const f32x4 tn = m < 3 ? dpp4<3>(zero4, acc[ai][bj][m < 3 ? m + 1 : 3][n]) : eN[n];
                        const f32x4 nxt = dpp4<1>(tn, cur);
                        carry[n] = dpp4<2>(zero4, cur);
                        acc[ai][bj][m][n] = W0[bj][n] * prv + W1[bj][n] * cur + W2[bj][n] * nxt + Bb[bj][n];
                        asm volatile("" : "+v"(acc[ai][bj][m][n]));
                        __builtin_amdgcn_sched_barrier(0);
                    }
            }
        }
#pragma unroll
        for (int ai = 0; ai < 2; ++ai)
#pragma unroll
            for (int m = 0; m < 4; ++m) { bf16* rowp = ACT + (size_t)(u.pm * 256 + ai * 128 + wr * 64 + m * 16 + fr) * DFF + fbase;
                f32x4 o[2];
#pragma unroll
                for (int n = 0; n < 2; ++n) { const f32x4 g = acc[ai][0][m][n], v = acc[ai][1][m][n];
#pragma unroll
                    for (int e = 0; e < 4; ++e) o[n][e] = g[e] * sigmoid_f(g[e]) * v[e]; }
                *(GAS v4u*)rowp = pack8(o[0], o[1]); __builtin_amdgcn_sched_barrier(0); }
    }
};
struct EpiResidI8 {
    static constexpr bool PERM = true, AFTER_DRAIN = false, MIDK = false;
    float* out; const float* base; const float* gate; const float* rs; float wscale; int pad;
    __device__ __forceinline__ void operator()(AccRef acc, const pg8::Unit& u, int wr, int wc, int fr, int fq) const {
        typedef int i32x4_ __attribute__((ext_vector_type(4)));
        const float* gb = gate + (size_t)(u.pm >> 4) * MODN + u.pn * 256 + wc * 32 + 8 * fq;
        f32x4 gv[2][2];
#pragma unroll
        for (int bj = 0; bj < 2; ++bj)
#pragma unroll
            for (int n = 0; n < 2; ++n) gv[bj][n] = *(const GAS f32x4*)(gb + bj * 128 + n * 4) * wscale;
#pragma unroll
        for (int q = 0; q < 2 * (4 / RESID_BATCH); ++q) { const int ai = q / (4 / RESID_BATCH), m0 = (q % (4 / RESID_BATCH)) * RESID_BATCH;
            const int g0 = u.pm * 256 + ai * 128 + wr * 64 + m0 * 16 + fr; const size_t r0 = (size_t)g0 * D + u.pn * 256 + wc * 32 + 8 * fq; f32x4 bs[RESID_BATCH][2][2]; float rsc[RESID_BATCH];
#pragma unroll
            for (int m = 0; m < RESID_BATCH; ++m) { rsc[m] = rs[g0 + m * 16];
#pragma unroll
                for (int bj = 0; bj < 2; ++bj)
#pragma unroll
                    for (int n = 0; n < 2; ++n) bs[m][bj][n] = NT_LOAD((const GAS f32x4*)(base + r0 + (size_t)(m * 16) * D + bj * 128 + n * 4)); }
#pragma unroll
            for (int m = 0; m < RESID_BATCH; ++m)
#pragma unroll
                for (int bj = 0; bj < 2; ++bj)
#pragma unroll
                    for (int n = 0; n < 2; ++n) { const f32x4 a = acc[ai][bj][m0 + m][n];
                        NT_STORE(bs[m][bj][n] + gv[bj][n] * (__builtin_convertvector(__builtin_bit_cast(i32x4_, a), f32x4) * rsc[m]), (GAS f32x4*)(out + r0 + (size_t)(m * 16) * D + bj * 128 + n * 4)); } }
    }
};
template <bool FP8C> struct InProjOrder {
    static constexpr int NT = FP8C ? NT_IN8 : NT_IN16;
    pg8::StaticOrder base; int G, c;
    __device__ __forceinline__ void init(int G_, int c_) { base.init(M, NT * 256, G_, c_); G = G_; c = c_; }
    __device__ __forceinline__ bool next(int i, pg8::Unit& u) const {
        if (base.next(i, u)) return true;
        constexpr int NCT = V_FP8 ? (FP8C ? 20 : 0) : 10;
        const long e = (long)i * G + c - (long)(M / 256) * NT; if (e < 0 || e >= 4 * NCT) return false;
        u.pm = 64 + (int)(e & 3); const int j = (int)(e >> 2); u.pn = V_FP8 ? (j < 4 ? 8 + j : 16 + j) : (FP8C ? (j < 2 ? 8 + j : 16 + j) : j); return true;
    }
    __device__ __forceinline__ void a_ready(const pg8::Unit&) const {}
    __device__ __forceinline__ void done(const pg8::Unit&) const {}
};

struct EpiNullProbe {
    static constexpr bool PERM = true, AFTER_DRAIN = false, MIDK = false;
    float* O; int flag; int pad;
    __device__ __forceinline__ void operator()(AccRef acc, const pg8::Unit& u, int wr, int wc, int fr, int fq) const {
        f32x4 t = {0.f, 0.f, 0.f, 0.f};
#pragma unroll
        for (int ai = 0; ai < 2; ++ai)
#pragma unroll
            for (int bj = 0; bj < 2; ++bj)
#pragma unroll
                for (int m = 0; m < 4; ++m) t += acc[ai][bj][m][0] + acc[ai][bj][m][1];
        if (flag) O[threadIdx.x] = (t[0] + t[1]) + (t[2] + t[3]);
    }
};
template <int SAME> struct ProbeOrder { pg8::StaticOrder base;
    __device__ __forceinline__ bool next(int i, pg8::Unit& u) const { const bool ok = base.next(i, u); if (SAME & 1) u.pm = 0; if (SAME & 2) u.pn = 0; return ok; }
    __device__ __forceinline__ void a_ready(const pg8::Unit&) const {}
    __device__ __forceinline__ void done(const pg8::Unit&) const {} };
#ifndef P11_WGM
#define P11_WGM 8
#endif
#ifndef TUNE_ALIGN
#define TUNE_ALIGN true
#endif
#ifndef TUNE_SP2
#define TUNE_SP2 true
#endif
static_assert(sizeof(Args) == 22 * 8 + 16, "kernarg layout");
__global__ void __launch_bounds__(NWAVES * 64, 2) fwd(Args args) {
    extern __shared__ __attribute__((aligned(16))) unsigned char lds[];
    Frame F;
    F.lds = (LAS unsigned char*)lds;
    F.MISC = (volatile LAS unsigned*)(F.lds + MISC_OFF);
    F.tid = threadIdx.x; F.lane = F.tid & 63; F.wave = __builtin_amdgcn_readfirstlane(F.tid >> 6);
    F.G = gridDim.x; { const int bx = blockIdx.x; F.vcu = (F.G % 8 == 0) ? (bx % 8) * (F.G / 8) + bx / 8 : bx; }
    F.ctl = (gu32*)(args.ws + WS_CTL);
    for (int u = F.tid; u < (LDS_BYTES - LDSCTL_OFF) / 4; u += NWAVES * 64) ((LAS unsigned*)(F.lds + LDSCTL_OFF))[u] = 0u;
    __syncthreads();
    XcdBarrier bar; bar.bar = (unsigned*)(F.ctl + CW_BAR); bar.x = 0; bar.st = nullptr;
    if (N_LAUNCHES == 1) bar = xcd_barrier_post((unsigned*)(F.ctl + CW_BAR), F.MISC + 8);
#ifdef TPROBE_LO
    unsigned long long t_lo = 0, t_hi = 0; int tcnt = 0;
    if (TPROBE_LO == 0) t_lo = __builtin_amdgcn_s_memrealtime();
#define TSTAMP() do { ++tcnt; const unsigned long long tn = __builtin_amdgcn_s_memrealtime(); if (tcnt == TPROBE_LO) t_lo = tn; if (tcnt == TPROBE_HI) t_hi = tn; } while (0)
#else
#define TSTAMP() do { } while (0)
#endif
#define GRID_BAR() do { if (N_LAUNCHES == 1) xcd_barrier(bar); TSTAMP(); } while (0)
    const int lo = args.ph_lo, hi = args.ph_hi;
#ifndef PH_MASK
#define PH_MASK 0x1fff
#endif
#define IN(k) (((PH_MASK >> (k)) & 1) && lo <= (k) && (k) < hi)
#define BOTH(k) (IN(k) && IN((k) + 1))
#ifndef REP2
#define REP2 0
#endif
#define NREP(k) (((REP2 >> (k)) & 1) ? 2 : 1)
    LAS unsigned char* ring = F.lds + RING_OFF;
    typedef const pg8::bf16_t* cbp;

    if (IN(0)) { p0a_prologue(F); GRID_BAR();
                 p1_norm1(F); __syncthreads(); p0_transpose_runs(F, CW_QUEUE, 0, P0_RUN_SPLIT);
                 if (BOTH(0)) GRID_BAR();
                 if ((INPROJ_MODE == 2 && wq_true(F, 0) > wq_clip(F, 0)) || (WOUT_MODE == 2 && wq_true(F, 1) > wq_clip(F, 1))) {
                     p0_transpose_runs(F, CW_QUEUE5, 0, P0_RUN_UP0, true, P0_RUN_IN1, P0_RUN_OUT0); if (BOTH(0)) GRID_BAR(); } }
    if (IN(2)) { for (int rep = 0; rep < NREP(2); ++rep) {
        { pg8::Gemm g = pg8::gemm_rowmajor((cbp)F.H(), (cbp)F.Win(), M + MC, NT_IN16 * 256, D, D, D); InProjOrder<false> Sd; Sd.init(F.G, (int)blockIdx.x);
          EpiInProj<false> E{F.QO(), F.KA(), F.VA(), F.KB(), F.VB(), F.GA(), F.GB(), nullptr, 1.0f};
          pg8::gemm_phase<EpiInProj<false>, InProjOrder<false>, true, true, 0>(ring, g, Sd, E); }
        { pg8::Gemm g = pg8::gemm_rowmajor((cbp)F.ACT(), (cbp)((unsigned char*)F.Win() + WIN8_OFF), M + MC, NT_IN8 * 256, D / 2, D / 2, D / 2); InProjOrder<true> Sd; Sd.init(F.G, F.G - 1 - (int)blockIdx.x);
          EpiInProj<true> E{F.QO(), F.KA(), F.VA(), F.KB(), F.VB(), F.GA(), F.GB(), F.rsh(), wq_range(F, 0) * (1.0f / 127.0f)};
          pg8::gemm_phase<EpiInProj<true>, InProjOrder<true>, true, true, INPROJ_MODE>(ring, g, Sd, E); }
        if (DEFER_UP_RUNS > 0) { __syncthreads(); p0_transpose_runs(F, CW_QUEUE3, P0_RUN_SPLIT, P0_RUN_DN0); }
        if (BOTH(2)) GRID_BAR();
    } }
    if (IN(3)) { p3_qkfix(F); if (BOTH(3)) GRID_BAR(); }
    if (IN(4)) { p4_attention(F); if (BOTH(4)) GRID_BAR(); }
    if (IN(5)) { for (int rep = 0; rep < NREP(5); ++rep) {
        pg8::Gemm g = BR_FP8 ? pg8::gemm_rowmajor((cbp)F.ACT(), (cbp)F.Wbr(), M, D, 2048, 2048, 2048) : pg8::gemm_rowmajor((cbp)F.QO(), (cbp)F.Wbr(), M, D, 4096, 4096, 4096);
        pg8::StaticOrder Sd; Sd.init(M, D, F.G, (int)blockIdx.x);
        EpiGateMerged E{F.H(), (const unsigned char*)F.GA(), (const unsigned char*)F.GB(), (unsigned char*)F.KB()};
        pg8::gemm_phase<EpiGateMerged, pg8::StaticOrder, true, true, BR_FP8 ? 1 : 0>(ring, g, Sd, E);
        if (BOTH(5)) GRID_BAR();
    } }
    if (IN(6) && WOUT_MODE == 2) { p6_quant_y(F); if (BOTH(6)) GRID_BAR(); }
    static_assert(WOUT_MODE == 2, "the residual-delta scheme below is wired for the int8 w_out GEMM");
    if (IN(7)) { for (int rep = 0; rep < NREP(7); ++rep) {
        pg8::StaticOrder Sd; Sd.init(M, D, F.G, (int)blockIdx.x);
        if constexpr (WOUT_MODE == 2) { pg8::Gemm g = pg8::gemm_rowmajor((cbp)F.KB(), (cbp)F.Wout(), M, D, D / 2, D / 2, D / 2);
            EpiDeltaI8 E{F.H(), F.modf() + 2 * D, F.rsy(), wq_range(F, 1) * (1.0f / 127.0f), 0};
            pg8::gemm_phase<EpiDeltaI8, pg8::StaticOrder, true, true, 2>(ring, g, Sd, E); }
        else if constexpr (WOUT_FP8) { pg8::Gemm g = pg8::gemm_rowmajor((cbp)F.KB(), (cbp)F.Wout(), M, D, D / 2, D / 2, D / 2);
            EpiResid E{F.out(), F.x(), F.modf() + 2 * D, 1.0f / (SC_WOUT * SC_Y), 0};
            pg8::gemm_phase<EpiResid, pg8::StaticOrder, true, true, 1>(ring, g, Sd, E); }
        else { pg8::Gemm g = pg8::gemm_rowmajor((cbp)F.H(), (cbp)F.Wout(), M, D, D, D, D);
            EpiResid E{F.out(), F.x(), F.modf() + 2 * D, 1.0f, 0};
            pg8::gemm_phase<EpiResid, pg8::StaticOrder, true, true, 0>(ring, g, Sd, E); }
        if (BOTH(7)) GRID_BAR();
    } }
    if (IN(8)) { for (int rep = 0; rep < NREP(8); ++rep) { p7_norm2(F); if (BOTH(8)) GRID_BAR(); } }
#ifdef GEMM_PROBE
    if (IN(9)) { pg8::Gemm g = pg8::gemm_rowmajor((cbp)F.QO(), (cbp)F.Wup(), M, F2, D, D, D); ProbeOrder<GEMM_PROBE & 3> Sd; Sd.base.init(M, F2, F.G, (int)blockIdx.x);
        EpiNullProbe E{(float*)F.ACT(), args.pad, 0};
        pg8::gemm_phase<EpiNullProbe, ProbeOrder<GEMM_PROBE & 3>, true, true>(ring, g, Sd, E); GRID_BAR(); }
#endif
    if (IN(9)) { for (int rep = 0; rep < NREP(9); ++rep) {
        pg8::Gemm g = pg8::gemm_rowmajor((cbp)F.QO(), (cbp)F.Wup(), M, F2, D, D, D);
        pg8::StaticOrder Sd; Sd.init(M, F2, F.G, (int)blockIdx.x);
        EpiConvAct E{F.ACT(), (float*)F.Win(), F.conv_w(), F.conv_b(), (LAS f32x4*)(F.lds + XCH_OFF)};
        pg8::gemm_phase<EpiConvAct, pg8::StaticOrder, true, TUNE_SP2>(ring, g, Sd, E);
        __syncthreads(); p0_transpose_runs(F, CW_QUEUE4, P0_RUN_DN0, P0_RUN_END);
        if (BOTH(9)) GRID_BAR();
    } }
    if (IN(10)) { for (int rep = 0; rep < NREP(10); ++rep) { p10_convfix(F); if (BOTH(10)) GRID_BAR(); } }
    if (IN(11)) {
        pg8::Gemm g = pg8::gemm_rowmajor((cbp)F.ACT(), (cbp)F.Wdn(), M, D, DFF, DFF, DFF); pg8::StaticOrder Sd; Sd.init(M, D, F.G, (int)blockIdx.x, P11_WGM);
        EpiDelta E{F.QO(), F.modf() + 5 * D, 1.0f, 0};
        pg8::gemm_phase<EpiDelta, pg8::StaticOrder, TUNE_ALIGN, TUNE_SP2>(ring, g, Sd, E);
        if (BOTH(11)) GRID_BAR();
    }
#ifdef TPROBE_LO
    if (IN(12)) { const float us = (float)(long long)(t_hi - t_lo) * 0.01f - (float)TPROBE_OFF; p11_final(F, 1.0f + sqrtf(fmaxf(us, 0.f) * 1e-7f)); }
#else
    if (IN(12)) { p11_final(F); }
#endif
#undef IN
#undef BOTH
#undef GRID_BAR
}

extern "C" void kernel_launch(void* const* d_in, const int* in_sizes, int n_in, void* d_out, int out_size, void* d_ws, size_t ws_size, hipStream_t stream) {
    static int grid = 0;
    if (grid == 0) {
        if (n_in != 20 || in_sizes[0] != M * D || out_size != M * D || ws_size < WS_END) { fprintf(stderr, "kernel_launch: unexpected shapes (n_in %d, in0 %d, out %d, ws %zu < %zu?)\n", n_in, n_in > 0 ? in_sizes[0] : -1, out_size, ws_size, (size_t)WS_END); grid = -1; return; }
        int dev = 0, cus = 0, per_cu = 0;
        if (hipGetDevice(&dev) != hipSuccess || hipDeviceGetAttribute(&cus, hipDeviceAttributeMultiprocessorCount, dev) != hipSuccess) { grid = -1; return; }
        if (hipFuncSetAttribute((const void*)fwd, hipFuncAttributeMaxDynamicSharedMemorySize, LDS_BYTES) != hipSuccess) { fprintf(stderr, "kernel_launch: hipFuncSetAttribute failed\n"); grid = -1; return; }
        if (hipOccupancyMaxActiveBlocksPerMultiprocessor(&per_cu, (const void*)fwd, NWAVES * 64, LDS_BYTES) != hipSuccess || per_cu < 1) fprintf(stderr, "kernel_launch: occupancy query reports %d\n", per_cu);
        (void)hipGetLastError();
        grid = cus < 256 ? cus : 256;
    }
    if (grid < 0) return;
    if (hipMemsetAsync((char*)d_ws + WS_CTL, 0, CTL_ZERO_BYTES, stream) != hipSuccess) return;
    Args a{};
    for (int i = 0; i < 20; ++i) a.in[i] = (const float*)d_in[i];
    a.out = (float*)d_out; a.ws = (unsigned char*)d_ws;
    for (int li = 0; li < N_LAUNCHES; ++li) {
        if (N_LAUNCHES == 1) { a.ph_lo = 0; a.ph_hi = N_PHASES; } else { a.ph_lo = li; a.ph_hi = li + 1; }
        a.li = li;
        hipLaunchKernelGGL(fwd, dim3(grid), dim3(NWAVES * 64), LDS_BYTES, stream, a);
        const hipError_t le = hipPeekAtLastError();
        if (le != hipSuccess) { fprintf(stderr, "kernel_launch: launch %d failed: %s\n", li, hipGetErrorName(le)); break; }
    }
}
```
